# Optimizing an MI355X kernel written in HIP

```python
import jax, jax.numpy as jnp
from jax import lax
import numpy as np

D_MODEL = 1024
BATCH = 8
SEQ = 2048
DEPTH = 2
DEC_BATCH = 8
DEC_SEQ = 32
PAST_LEN = 4096

CHUNK = 64
MIX_W = D_MODEL
HEAD_DIM = 64
SG_W = D_MODEL // 4
N_SG_HEADS = SG_W // HEAD_DIM
SG_HEAD_DIM = HEAD_DIM
SG_LEN = 128
SC_W = D_MODEL // 4
CONV_W = 3
ATT_W = D_MODEL // 2
N_HEADS = ATT_W // HEAD_DIM
N_KV = N_HEADS // 2
N_IDX = 8
IDX_DIM = 32
TOPK_MAX = 256
Q_BLOCK = 128
ROPE_THETA = 10000.0
IDX_W_SCALE = (N_IDX * IDX_DIM) ** -0.5
D_FF = 4 * D_MODEL
EPS = 1e-6
PROJ_SIZES = (2 * SG_W, 3 * SC_W, N_HEADS * HEAD_DIM, N_KV * HEAD_DIM, N_KV * HEAD_DIM,
              N_IDX * IDX_DIM, IDX_DIM, N_IDX)
IN_W = sum(PROJ_SIZES)

kernel_name = "hybrid_stream_sg_conv_dsa_step"


def rms_norm(x, g):
    xf = x.astype(jnp.float32)
    y = xf * lax.rsqrt(jnp.mean(xf * xf, axis=-1, keepdims=True) + EPS)
    return (y * g.astype(jnp.float32)).astype(x.dtype)


def rope(x, pos):
    half = x.shape[-1] // 2
    inv_freq = ROPE_THETA ** (-jnp.arange(half, dtype=jnp.float32) / half)
    ang = pos.astype(jnp.float32)[:, None] * inv_freq[None, :]
    cos = jnp.cos(ang)[None, :, None, :]
    sin = jnp.sin(ang)[None, :, None, :]
    xf = x.astype(jnp.float32)
    x1, x2 = xf[..., :half], xf[..., half:]
    return jnp.concatenate([x1 * cos - x2 * sin, x2 * cos + x1 * sin], axis=-1).astype(x.dtype)


def spatial_gate(za, w_s, b_s):
    z = jax.nn.gelu(za)
    u, v = jnp.split(z, 2, axis=-1)
    B, T, _ = v.shape
    n = min(T, SG_LEN)
    vc = v.reshape(B, T // n, n, N_SG_HEADS, SG_HEAD_DIM)
    i = jnp.arange(n)
    mask = (i[None, :] // CHUNK) <= (i[:, None] // CHUNK)
    wm = jnp.where(mask[None], w_s[:, :n, :n], 0.0)
    mixed = jnp.einsum('hij,bcjhd->bcihd', wm, vc) + b_s[:, :n].T[None, None, :, :, None]
    return u * mixed.reshape(B, T, SG_W), v


def short_conv(zb, conv_w, conv_state):
    gb, gc, h_in = jnp.split(zb, 3, axis=-1)
    xc = gc * h_in
    xp = jnp.concatenate([conv_state.astype(xc.dtype), xc], axis=1)
    T = xc.shape[1]
    y = conv_w[0] * xp[:, 0:T]
    for tap in range(1, CONV_W):
        y = y + conv_w[tap] * xp[:, tap:tap + T]
    return gb * y, xp[:, -(CONV_W - 1):]


_gather_rows = jax.vmap(lambda rows, ids: rows[ids])


def sparse_attend(q, qi, wi, k_all, v_all, ki_all, limit, k_top):
    B, Tq = q.shape[:2]
    S = k_all.shape[1]
    logits = jax.nn.relu(jnp.einsum('bqnd,bsd->bqns', qi, ki_all).astype(jnp.float32))
    iscore = jnp.einsum('bqn,bqns->bqs', wi.astype(jnp.float32), logits)
    admissible = jnp.arange(S)[None, :] < limit[:, None]
    iscore = jnp.where(admissible[None], iscore, -jnp.inf)
    _, sel = lax.top_k(iscore, k_top)
    valid = sel < limit[None, :, None]
    k_sel = _gather_rows(k_all, sel)
    v_sel = _gather_rows(v_all, sel)
    qg = q.reshape(B, Tq, N_KV, N_HEADS // N_KV, HEAD_DIM)
    s = jnp.einsum('bqhgd,bqkhd->bqhgk', qg, k_sel).astype(jnp.float32) * (HEAD_DIM ** -0.5)
    s = jnp.where(valid[:, :, None, None, :], s, -jnp.inf)
    p = jax.nn.softmax(s, axis=-1)
    o = jnp.einsum('bqhgk,bqkhd->bqhgd', p.astype(v_sel.dtype), v_sel)
    return o.reshape(B, Tq, N_HEADS * HEAD_DIM)


def sparse_attn_prompt(q, qi, wi, k, v, ki):
    B, T = q.shape[:2]
    k_top = min(TOPK_MAX, T // 4)
    nb = T // Q_BLOCK

    def to_blocks(a):
        return a.reshape((B, nb, Q_BLOCK) + a.shape[2:]).swapaxes(0, 1)

    def one_block(args):
        qb, qib, wib, start = args
        limit = ((start + jnp.arange(Q_BLOCK)) // CHUNK + 1) * CHUNK
        return sparse_attend(qb, qib, wib, k, v, ki, limit, k_top)

    out = lax.map(one_block, (to_blocks(q), to_blocks(qi), to_blocks(wi), jnp.arange(nb) * Q_BLOCK))
    return out.swapaxes(0, 1).reshape(B, T, ATT_W)


def layer(x, pos, conv_state, past_k, past_v, past_ki,
          g_mix, w_in, q_gain, k_gain, w_s, b_s, conv_w, w_out, g_ffn, w_up, w_down):
    B, T, _ = x.shape
    h = rms_norm(x, g_mix)
    z = h @ w_in
    points = np.cumsum(PROJ_SIZES)[:-1].tolist()
    za, zb, q, k, v, qi, ki, wi = jnp.split(z, points, axis=-1)
    y_a, sg_v = spatial_gate(za, w_s, b_s)
    y_b, conv_new = short_conv(zb, conv_w, conv_state)
    q = rope(rms_norm(q.reshape(B, T, N_HEADS, HEAD_DIM), q_gain), pos)
    k = rope(rms_norm(k.reshape(B, T, N_KV, HEAD_DIM), k_gain), pos)
    v = v.reshape(B, T, N_KV, HEAD_DIM)
    qi = rope(qi.reshape(B, T, N_IDX, IDX_DIM), pos)
    ki = rope(ki[:, :, None, :], pos)[:, :, 0, :]
    wi = wi * IDX_W_SCALE
    if past_k is None:
        y_c = sparse_attn_prompt(q, qi, wi, k, v, ki)
    else:
        k_all = jnp.concatenate([past_k.astype(k.dtype), k], axis=1)
        v_all = jnp.concatenate([past_v.astype(v.dtype), v], axis=1)
        ki_all = jnp.concatenate([past_ki.astype(ki.dtype), ki], axis=1)
        L = k_all.shape[1]
        limit = jnp.full((T,), L, dtype=jnp.int32)
        y_c = sparse_attend(q, qi, wi, k_all, v_all, ki_all, limit, min(TOPK_MAX, L // 4))
    x = x + jnp.concatenate([y_a, y_b, y_c], axis=-1) @ w_out
    hf = rms_norm(x, g_ffn)
    x = x + jnp.square(jax.nn.relu(hf @ w_up)) @ w_down
    return x, k, v, ki, conv_new, sg_v


def setup_inputs(seed: int = 0) -> dict:
    key = jax.random.key(seed)
    ks = jax.random.split(key, 20)

    def nrm(k, shape, scale=1.0):
        return jax.random.normal(k, shape, dtype=jnp.float32) * scale

    return {
        "x_prompt": nrm(ks[0], (BATCH, SEQ, D_MODEL)),
        "x_sample": nrm(ks[1], (DEC_BATCH, DEC_SEQ, D_MODEL)),
        "cache_k": nrm(ks[2], (DEPTH, DEC_BATCH, PAST_LEN, N_KV, HEAD_DIM)),
        "cache_v": nrm(ks[3], (DEPTH, DEC_BATCH, PAST_LEN, N_KV, HEAD_DIM)),
        "cache_kidx": nrm(ks[4], (DEPTH, DEC_BATCH, PAST_LEN, IDX_DIM)),
        "state_conv": nrm(ks[5], (DEPTH, DEC_BATCH, CONV_W - 1, SC_W)),
        "g_mix": 1.0 + nrm(ks[6], (DEPTH, D_MODEL), 0.02),
        "w_in": nrm(ks[7], (DEPTH, D_MODEL, IN_W), D_MODEL ** -0.5),
        "q_gain": 1.0 + nrm(ks[8], (DEPTH, HEAD_DIM), 0.02),
        "k_gain": 1.0 + nrm(ks[9], (DEPTH, HEAD_DIM), 0.02),
        "w_s": nrm(ks[10], (DEPTH, N_SG_HEADS, SG_LEN, SG_LEN), 0.05),
        "b_s": 1.0 + nrm(ks[11], (DEPTH, N_SG_HEADS, SG_LEN), 0.02),
        "conv_w": nrm(ks[12], (DEPTH, CONV_W, SC_W), CONV_W ** -0.5),
        "w_out": nrm(ks[13], (DEPTH, MIX_W, D_MODEL), MIX_W ** -0.5),
        "g_ffn": 1.0 + nrm(ks[14], (DEPTH, D_MODEL), 0.02),
        "w_up": nrm(ks[15], (DEPTH, D_MODEL, D_FF), D_MODEL ** -0.5),
        "w_down": nrm(ks[16], (DEPTH, D_FF, D_MODEL), D_FF ** -0.5),
    }


def reference(x_prompt, x_sample, cache_k, cache_v, cache_kidx, state_conv,
              g_mix, w_in, q_gain, k_gain, w_s, b_s, conv_w, w_out, g_ffn, w_up, w_down):
    Bp, Tp, _ = x_prompt.shape
    Ts = x_sample.shape[1]
    past_len = cache_k.shape[2]
    pos_p = jnp.arange(Tp)
    pos_s = past_len + jnp.arange(Ts)
    zero_conv = jnp.zeros((Bp, CONV_W - 1, SC_W), dtype=x_prompt.dtype)
    yp, ys = x_prompt, x_sample
    kp_l, vp_l, kip_l, cp_l = [], [], [], []
    ks_l, vs_l, kis_l, cs_l, sgs_l = [], [], [], [], []
    for l in range(DEPTH):
        params = (g_mix[l], w_in[l], q_gain[l], k_gain[l], w_s[l], b_s[l], conv_w[l],
                  w_out[l], g_ffn[l], w_up[l], w_down[l])
        yp, kp, vp, kip, cp, _ = layer(yp, pos_p, zero_conv, None, None, None, *params)
        ys, kss, vss, kis, cs, sgs = layer(ys, pos_s, state_conv[l], cache_k[l], cache_v[l],
                                           cache_kidx[l], *params)
        kp_l.append(kp); vp_l.append(vp); kip_l.append(kip); cp_l.append(cp)
        ks_l.append(kss); vs_l.append(vss); kis_l.append(kis); cs_l.append(cs); sgs_l.append(sgs)
    new_k_prompt = jnp.stack(kp_l)
    new_v_prompt = jnp.stack(vp_l)
    new_kidx_prompt = jnp.stack(kip_l)
    new_conv_prompt = jnp.stack(cp_l)
    new_k_sample = jnp.stack(ks_l)
    new_v_sample = jnp.stack(vs_l)
    new_kidx_sample = jnp.stack(kis_l)
    new_conv_sample = jnp.stack(cs_l)
    new_sgv_sample = jnp.stack(sgs_l)
    return (yp, ys, new_k_prompt, new_v_prompt, new_kidx_prompt, new_conv_prompt,
            new_k_sample, new_v_sample, new_kidx_sample, new_conv_sample, new_sgv_sample)
```

```cpp
#include <hip/hip_runtime.h>
#include <hip/hip_cooperative_groups.h>
#include <cstdio>
namespace cg = cooperative_groups;
#ifndef N_LAUNCH_MODE
#define N_LAUNCH_MODE 1
#endif
__device__ __forceinline__ int otid() { int t = (int)threadIdx.x; asm volatile("" : "+v"(t)); return t; }
namespace pg8 {
#define PG8_LAS __attribute__((address_space(3)))
typedef unsigned short bf16_t;
typedef short bf16x8 __attribute__((ext_vector_type(8)));
typedef float f32x4 __attribute__((ext_vector_type(4)));
typedef unsigned u32x4 __attribute__((ext_vector_type(4)));
constexpr int BM = 256, BK = 64, HALF = 128, HTB = HALF * BK * 2  , STAGE_BYTES = 8 * HTB, NXCD = 8, WGM = 8;

__host__ __device__ __forceinline__ int lds_byte(int r, int c) { const int st = (r >> 4) * 2 + (c >> 5), rr = r & 15, cc = c & 31, ob = rr * 64 + cc * 2; return st * 1024 + (ob ^ (((ob >> 9) & 1) << 5)); }
__host__ __device__ __forceinline__ void stage_rc(int b, int& R, int& C) { const int st = b / 1024, sb = b % 1024, swz = sb ^ (((sb >> 9) & 1) << 5); R = (st >> 1) * 16 + swz / 64; C = (st & 1) * 32 + (swz % 64) / 2; }
__host__ __device__ __forceinline__ int perm32(int rho) { const int n = rho >> 4, i = rho & 15; return 8 * (i >> 2) + 4 * n + (i & 3); }

struct Unit { int pm, pn; };
struct Gemm { const bf16_t* A; const bf16_t* Bt; int M, N, K; };

struct StaticOrder {
    int nM, nN, nwg, G, c;
    __host__ __device__ void init(int M, int N, int G_, int c_) { nM = M / BM; nN = N / BM; nwg = nM * nN; G = G_; c = c_; }
    __host__ __device__ bool next(int i, Unit& u) const {
        const long L = (long)i * G + c; if (L >= nwg) return false;
        int wgid = (int)L; { const int q = nwg / NXCD, r = nwg % NXCD, xcd = wgid % NXCD, off = wgid / NXCD; wgid = (xcd < r ? xcd * (q + 1) : r * (q + 1) + (xcd - r) * q) + off; }
        const int nig = WGM * nN, gid = wgid / nig, fm = gid * WGM, gsz = (nM - fm) < WGM ? (nM - fm) : WGM;
        u.pm = fm + ((wgid % nig) % gsz); u.pn = (wgid % nig) / gsz; return true;
    }
    __device__ __forceinline__ void a_ready(const Unit&) const {}
    __device__ __forceinline__ void done(const Unit&) const {}
};
template <class Epi, class Sched, bool STAMP = false>
__device__ __forceinline__ void gemm_phase(PG8_LAS unsigned char* lds, const Gemm g, const Sched& S, const Epi& E, unsigned long long* stamps) {
    const int tid = otid(), wid = __builtin_amdgcn_readfirstlane(tid >> 6), lane = tid & 63, wr = wid >> 2, wc = wid & 3, fr = lane & 15, fq = lane >> 4;
    const int K = g.K, nt = K / BK;
    int ts_lo = 0, ts_hi = 0, nts = 0; const unsigned long long rt_entry = STAMP ? (unsigned long long)wall_clock64() : 0ull;
#define PG8_STAMP() do { if (STAMP && wid == 0 && nts < 64) { const unsigned long long _c = (unsigned long long)clock64(); \
        ts_lo = (lane == nts) ? (int)(unsigned)_c : ts_lo; ts_hi = (lane == nts) ? (int)(unsigned)(_c >> 32) : ts_hi; ++nts; } } while (0)
    PG8_STAMP();
    unsigned voffA[2], voffB[2];
#pragma unroll
    for (int i = 0; i < 2; ++i) { int R, C; stage_rc(tid * 16 + i * 8192, R, C); const int Rb = Epi::PERM ? ((R & ~31) + perm32(R & 31)) : R;
        voffA[i] = (unsigned)(R * K + C) * 2u; voffB[i] = (unsigned)(Rb * K + C) * 2u; }
    const size_t kstep = (size_t)(BK * 2);
    const size_t hstep = (size_t)HALF * K * 2;
    const size_t tstep = 2 * hstep;
    const unsigned ldsw = (unsigned)wid * 1024u;
    const int aoff = lds_byte(wr * 64 + fr, fq * 8), boff = lds_byte(wc * 32 + fr, fq * 8);
#define PG8_SA(b, h) (((b) * 2 + (h)) * HTB)
#define PG8_SB(b, h) ((4 + (b) * 2 + (h)) * HTB)
#define PG8_STAGE(bufoff, gbase, voff) do { _Pragma("unroll") for (int _i = 0; _i < 2; ++_i) \
        __builtin_amdgcn_global_load_lds((const unsigned*)((const char*)(gbase) + (voff)[_i]), (PG8_LAS unsigned*)(lds + (bufoff) + ldsw + _i * 8192), 16, 0, 0); } while (0)
#define PG8_LDA(dst, b, h) do { _Pragma("unroll") for (int m = 0; m < 4; ++m) _Pragma("unroll") for (int k = 0; k < 2; ++k) dst[m][k] = *(const PG8_LAS bf16x8*)(lds + PG8_SA(b, h) + aoff + m * 2048 + k * 1024); } while (0)
#define PG8_LDB(dst, b, h) do { _Pragma("unroll") for (int n = 0; n < 2; ++n) _Pragma("unroll") for (int k = 0; k < 2; ++k) dst[n][k] = *(const PG8_LAS bf16x8*)(lds + PG8_SB(b, h) + boff + n * 2048 + k * 1024); } while (0)
#define PG8_MMA(ai, bj, At, Bt) do { __builtin_amdgcn_s_setprio(1); _Pragma("unroll") for (int m = 0; m < 4; ++m) _Pragma("unroll") for (int n = 0; n < 2; ++n) _Pragma("unroll") for (int k = 0; k < 2; ++k) \
        acc[ai][bj][m][n] = __builtin_amdgcn_mfma_f32_16x16x32_bf16(Bt[n][k], At[m][k], acc[ai][bj][m][n], 0, 0, 0); __builtin_amdgcn_s_setprio(0); } while (0)
#define PG8_WAIT_V(n) asm volatile("s_waitcnt vmcnt(" #n ")" ::: "memory")
#define PG8_WAIT_L(n) asm volatile("s_waitcnt lgkmcnt(" #n ")" ::: "memory")
#define PG8_BAR __builtin_amdgcn_s_barrier()
#define PG8_SCHED __builtin_amdgcn_sched_barrier(0)
    Unit cur, nxt; int ui = 0;
    if (!S.next(0, cur)) return;
    f32x4 acc[2][2][4][2];
#pragma unroll
    for (int a = 0; a < 2; ++a)
#pragma unroll
        for (int b = 0; b < 2; ++b)
#pragma unroll
            for (int m = 0; m < 4; ++m)
#pragma unroll
                for (int n = 0; n < 2; ++n) acc[a][b][m][n] = (f32x4){0.f, 0.f, 0.f, 0.f};
    bf16x8 At[4][2], B0[2][2], B1[2][2];
    const char* cA = (const char*)g.A + (size_t)cur.pm * tstep; const char* cB = (const char*)g.Bt + (size_t)cur.pn * tstep;
    S.a_ready(cur);
    PG8_STAGE(PG8_SB(0, 0), cB, voffB); PG8_STAGE(PG8_SA(0, 0), cA, voffA); PG8_STAGE(PG8_SB(0, 1), cB + hstep, voffB); PG8_STAGE(PG8_SA(0, 1), cA + hstep, voffA);
    if (wr == 1) PG8_BAR;
    PG8_WAIT_V(4); PG8_BAR;
    PG8_STAGE(PG8_SB(1, 0), cB + kstep, voffB); PG8_STAGE(PG8_SA(1, 0), cA + kstep, voffA); PG8_STAGE(PG8_SB(1, 1), cB + hstep + kstep, voffB);
    PG8_WAIT_V(6); PG8_BAR;
    PG8_STAMP();
    for (;;) {
        const bool has_next = S.next(ui + 1, nxt);
        const char* nA = has_next ? (const char*)g.A + (size_t)nxt.pm * tstep : cA; const char* nB = has_next ? (const char*)g.Bt + (size_t)nxt.pn * tstep : cB;
        for (int t = 0; t < nt; t += 2) {
            const bool last = (t == nt - 2);
            const char* a1 = cA + (size_t)(t + 1) * kstep;
            const char* a2 = last ? nA : cA + (size_t)(t + 2) * kstep; const char* b2 = last ? nB : cB + (size_t)(t + 2) * kstep;
            const char* a3 = a2 + kstep; const char* b3 = b2 + kstep;
            if (last && has_next) S.a_ready(nxt);
            PG8_LDB(B0, 0, 0); PG8_SCHED; PG8_LDA(At, 0, 0); PG8_STAGE(PG8_SA(1, 1), a1 + hstep, voffA);
            PG8_WAIT_L(8); PG8_BAR; PG8_WAIT_L(0); PG8_MMA(0, 0, At, B0); PG8_BAR; PG8_SCHED;
            PG8_LDB(B1, 0, 1); PG8_STAGE(PG8_SB(0, 0), b2, voffB);
            PG8_BAR; PG8_WAIT_L(0); PG8_MMA(0, 1, At, B1); PG8_BAR;
            PG8_LDA(At, 0, 1); PG8_STAGE(PG8_SA(0, 0), a2, voffA);
            PG8_BAR; PG8_WAIT_L(0); PG8_MMA(1, 0, At, B0); PG8_BAR; PG8_SCHED;
            PG8_STAGE(PG8_SB(0, 1), b2 + hstep, voffB);
            PG8_WAIT_V(6); PG8_BAR; PG8_MMA(1, 1, At, B1); PG8_BAR;
            PG8_LDB(B0, 1, 0); PG8_SCHED; PG8_LDA(At, 1, 0); PG8_STAGE(PG8_SA(0, 1), a2 + hstep, voffA);
            PG8_WAIT_L(8); PG8_BAR; PG8_WAIT_L(0); PG8_MMA(0, 0, At, B0); PG8_BAR; PG8_SCHED;
            PG8_LDB(B1, 1, 1); PG8_STAGE(PG8_SB(1, 0), b3, voffB);
            PG8_BAR; PG8_WAIT_L(0); PG8_MMA(0, 1, At, B1); PG8_BAR;
            PG8_LDA(At, 1, 1); PG8_STAGE(PG8_SA(1, 0), a3, voffA);
            PG8_BAR; PG8_WAIT_L(0); PG8_MMA(1, 0, At, B0); PG8_BAR; PG8_SCHED;
            PG8_STAGE(PG8_SB(1, 1), b3 + hstep, voffB);
            PG8_WAIT_V(6); PG8_BAR; PG8_MMA(1, 1, At, B1); PG8_BAR;
        }
        PG8_STAMP();
        if constexpr (!Epi::AFTER_DRAIN) { E(acc, cur, wr, wc, fr, fq); S.done(cur); }
        PG8_STAMP();
        if (!has_next) break;
#pragma unroll
        for (int a = 0; a < 2; ++a)
#pragma unroll
            for (int b = 0; b < 2; ++b)
#pragma unroll
                for (int m = 0; m < 4; ++m)
#pragma unroll
                    for (int n = 0; n < 2; ++n) acc[a][b][m][n] = (f32x4){0.f, 0.f, 0.f, 0.f};
        cur = nxt; cA = nA; cB = nB; ++ui;
    }
    PG8_WAIT_V(0);
    if (wr == 0) PG8_BAR;
    PG8_BAR;
    if constexpr (Epi::AFTER_DRAIN) { E.fused(acc, cur, wr, wc, fr, fq, lds, wid, lane); S.done(cur); }
    PG8_STAMP();
    if (STAMP && wid == 0) { stamps[lane] = lane < nts ? (((unsigned long long)(unsigned)ts_hi << 32) | (unsigned)ts_lo) : 0ull;
        if (lane == 62) stamps[62] = rt_entry; if (lane == 63) stamps[63] = (unsigned long long)wall_clock64(); }
#undef PG8_STAMP
#undef PG8_SA
#undef PG8_SB
#undef PG8_STAGE
#undef PG8_LDA
#undef PG8_LDB
#undef PG8_MMA
#undef PG8_WAIT_V
#undef PG8_WAIT_L
#undef PG8_BAR
#undef PG8_SCHED
}
}

using pg8::bf16_t; using pg8::bf16x8; using pg8::f32x4; using pg8::u32x4;
typedef float f32x16 __attribute__((ext_vector_type(16)));
typedef unsigned u32x2 __attribute__((ext_vector_type(2)));
typedef unsigned long long u64;
#define DEV __device__ __forceinline__

constexpr int DM = 1024, TP = 2048, NPR = 16384, NSR = 256, MT = 16640, INW = 2600, INWP = 2816, DFF = 4096, PAST = 4096, LS = 4128, LSP = 4160;
constexpr int NTHREADS = 512;
constexpr int LDS_BYTES = 139264;
constexpr size_t O_YP = 0, O_YS = 16777216, O_KP = 17039360, O_VP = 25427968, O_KIP = 33816576, O_CP = 34865152, O_KS = 34873344, O_VS = 35004416, O_KIS = 35135488, O_CS = 35151872, O_SGV = 35160064;
constexpr size_t WS_WIN = 0, SZ_WIN1 = (size_t)INWP * DM * 2;
constexpr size_t WS_WOUT = WS_WIN + 2 * SZ_WIN1, SZ_WOUT1 = (size_t)DM * DM * 2;
constexpr size_t WS_WUP = WS_WOUT + 2 * SZ_WOUT1, SZ_WUP1 = (size_t)DFF * DM * 2;
constexpr size_t WS_WDN = WS_WUP + 2 * SZ_WUP1;
constexpr size_t WS_XB = WS_WDN + 2 * SZ_WUP1;
constexpr size_t WS_SS = WS_XB + (size_t)MT * DM * 2;
constexpr size_t WS_ROPE = WS_SS + (size_t)MT * 16 * 4;
constexpr size_t WS_WI = WS_ROPE + (size_t)2080 * 64 * 4;
constexpr size_t WS_KS = WS_WI + (size_t)MT * 8 * 4, SZ_KS1 = (size_t)8 * 4 * LSP * 64 * 2;
constexpr size_t WS_VTS = WS_KS + 2 * SZ_KS1;
constexpr size_t WS_KIS = WS_VTS + 2 * SZ_KS1, SZ_KIS1 = (size_t)8 * LSP * 32 * 2;
constexpr size_t WS_BMP = WS_KIS + 2 * SZ_KIS1;
constexpr size_t WS_BMS = WS_BMP + (size_t)NPR * 32 * 8;
constexpr size_t WS_MIX = WS_BMS + (size_t)NSR * 72 * 8;
constexpr size_t WS_H = WS_MIX;
constexpr size_t WS_YMIX = WS_MIX;
constexpr size_t WS_ZB = WS_YMIX + (size_t)MT * 1024 * 2;
constexpr size_t WS_QB = WS_ZB + (size_t)MT * 768 * 2;
constexpr size_t WS_ZAU = WS_QB + (size_t)MT * 512 * 2;
constexpr size_t WS_SGVT = WS_ZAU + (size_t)MT * 256 * 2;
constexpr size_t WS_QIB = WS_SGVT + (size_t)MT * 256 * 2;
constexpr size_t WS_KP = WS_QIB + (size_t)MT * 256 * 2;
constexpr size_t WS_VTP = WS_KP + (size_t)8 * 4 * TP * 64 * 2;
constexpr size_t WS_KIP = WS_VTP + (size_t)8 * 4 * TP * 64 * 2;
constexpr size_t WS_MIX_END = WS_KIP + (size_t)8 * TP * 32 * 2;
constexpr size_t WS_END = WS_H + (size_t)MT * DFF * 2;
static_assert(WS_MIX_END <= WS_END, "mixer intermediates must fit inside the H alias");
static_assert(WS_XB % 256 == 0 && WS_SS % 256 == 0 && WS_ROPE % 256 == 0 && WS_WI % 256 == 0 && WS_KS % 256 == 0 && WS_VTS % 256 == 0 && WS_KIS % 256 == 0 && WS_BMP % 256 == 0 && WS_BMS % 256 == 0 && WS_MIX % 256 == 0, "align");
static_assert(WS_ZB % 256 == 0 && WS_QB % 256 == 0 && WS_ZAU % 256 == 0 && WS_SGVT % 256 == 0 && WS_QIB % 256 == 0 && WS_KP % 256 == 0 && WS_VTP % 256 == 0 && WS_KIP % 256 == 0, "align2");

struct Params {
    const float* x_prompt; const float* x_sample; const float* cache_k; const float* cache_v; const float* cache_kidx; const float* state_conv;
    const float* g_mix; const float* w_in; const float* q_gain; const float* k_gain; const float* w_s; const float* b_s; const float* conv_w;
    const float* w_out; const float* g_ffn; const float* w_up; const float* w_down;
    float* out; unsigned char* ws;
    int ph_lo, ph_hi;
};

__constant__ float c_invf[32] = {1.000000000e+00f, 7.498942614e-01f, 5.623413324e-01f, 4.216965139e-01f, 3.162277639e-01f, 2.371373773e-01f, 1.778279394e-01f, 1.333521307e-01f, 1.000000015e-01f, 7.498941571e-02f, 5.623413250e-02f, 4.216965288e-02f, 3.162277490e-02f, 2.371373773e-02f, 1.778279431e-02f, 1.333521493e-02f, 9.999999776e-03f, 7.498941850e-03f, 5.623413250e-03f, 4.216964822e-03f, 3.162277630e-03f, 2.371373586e-03f, 1.778279431e-03f, 1.333521446e-03f, 1.000000047e-03f, 7.498942432e-04f, 5.623413017e-04f, 4.216965172e-04f, 3.162277571e-04f, 2.371373703e-04f, 1.778279402e-04f, 1.333521504e-04f};

DEV float bf2f(unsigned short h) { return __uint_as_float((unsigned)h << 16); }
DEV unsigned pk2(float lo, float hi) { unsigned r; asm("v_cvt_pk_bf16_f32 %0, %1, %2" : "=v"(r) : "v"(lo), "v"(hi)); return r; }
DEV unsigned short f2bf(float x) { return (unsigned short)(pk2(x, 0.f) & 0xffffu); }
DEV u32x4 pack8(const float (&v)[8]) { u32x4 w; w.x = pk2(v[0], v[1]); w.y = pk2(v[2], v[3]); w.z = pk2(v[4], v[5]); w.w = pk2(v[6], v[7]); return w; }
DEV float gelu_tanh(float x) {
    const float y = 0.7978845608028654f * (x + 0.044715f * x * x * x);
    const float e = __builtin_amdgcn_exp2f(-2.0f * 1.4426950408889634f * y);
    return x * __builtin_amdgcn_rcpf(1.0f + e);
}
DEV float wave_sum(float v) {
#pragma unroll
    for (int o = 32; o > 0; o >>= 1) v += __shfl_xor(v, o);
    return v;
}
DEV float wave_max(float v) {
#pragma unroll
    for (int o = 32; o > 0; o >>= 1) v = fmaxf(v, __shfl_xor(v, o));
    return v;
}

DEV float row_rstd(const float* ss, int row) {
    const f32x4* sp = (const f32x4*)(ss + (size_t)row * 16);
    const f32x4 a = sp[0], b = sp[1], c = sp[2], d = sp[3];
    const float t = ((a[0] + a[1]) + (a[2] + a[3])) + ((b[0] + b[1]) + (b[2] + b[3])) + ((c[0] + c[1]) + (c[2] + c[3])) + ((d[0] + d[1]) + (d[2] + d[3]));
    return rsqrtf(t * (1.0f / 1024.0f) + 1e-6f);
}

struct EpiIn {
    static constexpr bool PERM = false, AFTER_DRAIN = false;
    const float* ss; const float* rope; const float* qg; const float* kg; float* out; unsigned char* ws; int layer;
    __device__ __forceinline__ void operator()(const f32x4 (&acc)[2][2][4][2], const pg8::Unit& u, int wr, int wc, int fr, int fq0) const {
        const int pn = u.pn, pm = u.pm;
        const bool samp = (pm == 64);
        bf16_t* ZAU = (bf16_t*)(ws + WS_ZAU); bf16_t* SGVT = (bf16_t*)(ws + WS_SGVT); bf16_t* ZB = (bf16_t*)(ws + WS_ZB); bf16_t* QB = (bf16_t*)(ws + WS_QB);
        bf16_t* QIB = (bf16_t*)(ws + WS_QIB); float* WI = (float*)(ws + WS_WI);
#pragma unroll
        for (int ai = 0; ai < 2; ++ai)
#pragma unroll
            for (int m = 0; m < 4; ++m) {
                int row = pm * 256 + ai * 128 + wr * 64 + m * 16 + fr, fq = fq0;
                asm volatile("" : "+v"(row), "+v"(fq));
                const float rstd = row_rstd(ss, row);
                int b, t, posidx; const int rs = row - NPR;
                if (!samp) { b = row >> 11; t = row & 2047; posidx = t; } else { b = rs >> 5; t = rs & 31; posidx = 2048 + t; }
                float lo[8], hi[8];
#pragma unroll
                for (int bj = 0; bj < 2; ++bj)
#pragma unroll
                    for (int n = 0; n < 2; ++n)
#pragma unroll
                        for (int jp = 0; jp < 2; ++jp) { lo[4 * bj + 2 * n + jp] = acc[ai][bj][m][n][2 * jp] * rstd; hi[4 * bj + 2 * n + jp] = acc[ai][bj][m][n][2 * jp + 1] * rstd; }
                if (pn == 0) {
#pragma unroll
                    for (int e = 0; e < 8; ++e) { lo[e] = gelu_tanh(lo[e]); hi[e] = gelu_tanh(hi[e]); }
                    bf16_t* d = ZAU + (size_t)row * 256 + 64 * wc + 8 * fq;
                    *(u32x4*)d = pack8(lo); *(u32x4*)(d + 32) = pack8(hi);
                } else if (pn == 1) {
#pragma unroll
                    for (int e = 0; e < 8; ++e) { lo[e] = gelu_tanh(lo[e]); hi[e] = gelu_tanh(hi[e]); }
#pragma unroll
                    for (int e = 0; e < 8; ++e) {
                        SGVT[(size_t)(64 * wc + 8 * fq + e) * MT + row] = f2bf(lo[e]);
                        SGVT[(size_t)(64 * wc + 32 + 8 * fq + e) * MT + row] = f2bf(hi[e]);
                    }
                    if (samp) {
                        float* d = out + O_SGV + ((size_t)layer * NSR + rs) * 256 + 64 * wc + 8 * fq;
                        *(f32x4*)d = (f32x4){lo[0], lo[1], lo[2], lo[3]}; *(f32x4*)(d + 4) = (f32x4){lo[4], lo[5], lo[6], lo[7]};
                        *(f32x4*)(d + 32) = (f32x4){hi[0], hi[1], hi[2], hi[3]}; *(f32x4*)(d + 36) = (f32x4){hi[4], hi[5], hi[6], hi[7]};
                    }
                } else if (pn <= 4) {
                    bf16_t* d = ZB + (size_t)row * 768 + 256 * (pn - 2) + 64 * wc + 8 * fq;
                    *(u32x4*)d = pack8(lo); *(u32x4*)(d + 32) = pack8(hi);
                } else if (pn <= 7) {
                    float sq = 0.f;
#pragma unroll
                    for (int e = 0; e < 8; ++e) sq += lo[e] * lo[e] + hi[e] * hi[e];
                    sq += __shfl_xor(sq, 16); sq += __shfl_xor(sq, 32);
                    const float rh = rsqrtf(sq * (1.0f / 64.0f) + 1e-6f);
                    const float* cs = rope + (size_t)posidx * 64 + 8 * fq;
                    const f32x4 c0 = *(const f32x4*)cs, c1 = *(const f32x4*)(cs + 4), s0 = *(const f32x4*)(cs + 32), s1 = *(const f32x4*)(cs + 36);
                    const float* gp = (pn == 7 ? kg : qg) + layer * 64 + 8 * fq;
                    const f32x4 g0 = *(const f32x4*)gp, g1 = *(const f32x4*)(gp + 4), g2 = *(const f32x4*)(gp + 32), g3 = *(const f32x4*)(gp + 36);
                    float ol[8], oh[8];
#pragma unroll
                    for (int e = 0; e < 8; ++e) {
                        const float co = e < 4 ? c0[e & 3] : c1[e & 3], si = e < 4 ? s0[e & 3] : s1[e & 3];
                        const float a = lo[e] * rh * (e < 4 ? g0[e & 3] : g1[e & 3]), bb = hi[e] * rh * (e < 4 ? g2[e & 3] : g3[e & 3]);
                        ol[e] = a * co - bb * si; oh[e] = bb * co + a * si;
                    }
                    if (pn < 7) {
                        bf16_t* d = QB + (size_t)row * 512 + (4 * (pn - 5) + wc) * 64 + 8 * fq;
                        *(u32x4*)d = pack8(ol); *(u32x4*)(d + 32) = pack8(oh);
                    } else {
                        float* d = samp ? out + O_KS + ((size_t)layer * NSR + rs) * 256 + 64 * wc + 8 * fq : out + O_KP + ((size_t)layer * NPR + row) * 256 + 64 * wc + 8 * fq;
                        *(f32x4*)d = (f32x4){ol[0], ol[1], ol[2], ol[3]}; *(f32x4*)(d + 4) = (f32x4){ol[4], ol[5], ol[6], ol[7]};
                        *(f32x4*)(d + 32) = (f32x4){oh[0], oh[1], oh[2], oh[3]}; *(f32x4*)(d + 36) = (f32x4){oh[4], oh[5], oh[6], oh[7]};
                        bf16_t* kb = samp ? (bf16_t*)(ws + WS_KS + (size_t)layer * SZ_KS1) + ((size_t)(b * 4 + wc) * LSP + PAST + t) * 64 + 8 * fq
                                          : (bf16_t*)(ws + WS_KP) + ((size_t)(b * 4 + wc) * TP + t) * 64 + 8 * fq;
                        *(u32x4*)kb = pack8(ol); *(u32x4*)(kb + 32) = pack8(oh);
                    }
                } else if (pn == 8) {
                    float* d = samp ? out + O_VS + ((size_t)layer * NSR + rs) * 256 + 64 * wc + 8 * fq : out + O_VP + ((size_t)layer * NPR + row) * 256 + 64 * wc + 8 * fq;
                    *(f32x4*)d = (f32x4){lo[0], lo[1], lo[2], lo[3]}; *(f32x4*)(d + 4) = (f32x4){lo[4], lo[5], lo[6], lo[7]};
                    *(f32x4*)(d + 32) = (f32x4){hi[0], hi[1], hi[2], hi[3]}; *(f32x4*)(d + 36) = (f32x4){hi[4], hi[5], hi[6], hi[7]};
                    bf16_t* vt; size_t pitch;
                    if (samp) { vt = (bf16_t*)(ws + WS_VTS + (size_t)layer * SZ_KS1) + (size_t)(b * 4 + wc) * 64 * LSP + PAST + t; pitch = LSP; }
                    else { vt = (bf16_t*)(ws + WS_VTP) + (size_t)(b * 4 + wc) * 64 * TP + t; pitch = TP; }
#pragma unroll
                    for (int e = 0; e < 8; ++e) { vt[(size_t)(8 * fq + e) * pitch] = f2bf(lo[e]); vt[(size_t)(32 + 8 * fq + e) * pitch] = f2bf(hi[e]); }
                } else {
                    const float* cs = rope + (size_t)posidx * 64 + 8 * fq;
                    const f32x4 c0 = *(const f32x4*)cs, c1 = *(const f32x4*)(cs + 4), s0 = *(const f32x4*)(cs + 32), s1 = *(const f32x4*)(cs + 36);
                    const float co[4] = {c0[0], c0[2], c1[0], c1[2]}, si[4] = {s0[0], s0[2], s1[0], s1[2]};
                    float ol[8], oh[8];
#pragma unroll
                    for (int e = 0; e < 8; ++e) { ol[e] = lo[e] * co[e & 3] - hi[e] * si[e & 3]; oh[e] = hi[e] * co[e & 3] + lo[e] * si[e & 3]; }
                    if (pn == 9) {
#pragma unroll
                        for (int bj = 0; bj < 2; ++bj) {
                            bf16_t* d = QIB + (size_t)row * 256 + 32 * (2 * wc + bj) + 4 * fq;
                            *(u32x2*)d = (u32x2){pk2(ol[4 * bj], ol[4 * bj + 1]), pk2(ol[4 * bj + 2], ol[4 * bj + 3])};
                            *(u32x2*)(d + 16) = (u32x2){pk2(oh[4 * bj], oh[4 * bj + 1]), pk2(oh[4 * bj + 2], oh[4 * bj + 3])};
                        }
                    } else if (wc == 0) {
                        float* d = samp ? out + O_KIS + ((size_t)layer * NSR + rs) * 32 + 4 * fq : out + O_KIP + ((size_t)layer * NPR + row) * 32 + 4 * fq;
                        *(f32x4*)d = (f32x4){ol[0], ol[1], ol[2], ol[3]}; *(f32x4*)(d + 16) = (f32x4){oh[0], oh[1], oh[2], oh[3]};
                        bf16_t* kb = samp ? (bf16_t*)(ws + WS_KIS + (size_t)layer * SZ_KIS1) + ((size_t)b * LSP + PAST + t) * 32 + 4 * fq
                                          : (bf16_t*)(ws + WS_KIP) + (size_t)row * 32 + 4 * fq;
                        *(u32x2*)kb = (u32x2){pk2(ol[0], ol[1]), pk2(ol[2], ol[3])};
                        *(u32x2*)(kb + 16) = (u32x2){pk2(oh[0], oh[1]), pk2(oh[2], oh[3])};
                        if (fq < 2) *(f32x4*)(WI + (size_t)row * 8 + 4 * fq) = (f32x4){lo[4] * 0.0625f, lo[5] * 0.0625f, lo[6] * 0.0625f, lo[7] * 0.0625f};
                    }
                }
                asm volatile("" ::: "memory");
            }
    }
};

struct EpiRes {
    static constexpr bool PERM = false, AFTER_DRAIN = false;
    float* X; bf16_t* XB; float* ss;
    __device__ __forceinline__ void operator()(const f32x4 (&acc)[2][2][4][2], const pg8::Unit& u, int wr, int wc, int fr, int fq0) const {
#pragma unroll
        for (int ai = 0; ai < 2; ++ai)
#pragma unroll
            for (int m = 0; m < 4; ++m) {
                int row = u.pm * 256 + ai * 128 + wr * 64 + m * 16 + fr, fq = fq0;
                asm volatile("" : "+v"(row), "+v"(fq));
                float sq = 0.f;
#pragma unroll
                for (int bj = 0; bj < 2; ++bj)
#pragma unroll
                    for (int n = 0; n < 2; ++n) {
                        const size_t off = (size_t)row * DM + u.pn * 256 + 128 * bj + 32 * wc + 16 * n + 4 * fq;
                        f32x4 xv = *(const f32x4*)(X + off); xv += acc[ai][bj][m][n];
                        *(f32x4*)(X + off) = xv; *(u32x2*)(XB + off) = (u32x2){pk2(xv[0], xv[1]), pk2(xv[2], xv[3])};
                        sq += (xv[0] * xv[0] + xv[1] * xv[1]) + (xv[2] * xv[2] + xv[3] * xv[3]);
                    }
                sq += __shfl_xor(sq, 16); sq += __shfl_xor(sq, 32);
                if (fq0 == 0) ss[(size_t)row * 16 + u.pn * 4 + wc] = sq;
                asm volatile("" ::: "memory");
            }
    }
};

struct EpiUp {
    static constexpr bool PERM = false, AFTER_DRAIN = false;
    bf16_t* H; const float* ss;
    __device__ __forceinline__ void operator()(const f32x4 (&acc)[2][2][4][2], const pg8::Unit& u, int wr, int wc, int fr, int fq0) const {
#pragma unroll
        for (int ai = 0; ai < 2; ++ai)
#pragma unroll
            for (int m = 0; m < 4; ++m) {
                int row = u.pm * 256 + ai * 128 + wr * 64 + m * 16 + fr, fq = fq0;
                asm volatile("" : "+v"(row), "+v"(fq));
                const float rstd = row_rstd(ss, row);
#pragma unroll
                for (int bj = 0; bj < 2; ++bj)
#pragma unroll
                    for (int n = 0; n < 2; ++n) {
                        const size_t off = (size_t)row * DFF + u.pn * 256 + 128 * bj + 32 * wc + 16 * n + 4 * fq;
                        f32x4 v = acc[ai][bj][m][n] * rstd;
#pragma unroll
                        for (int j = 0; j < 4; ++j) { const float r = fmaxf(v[j], 0.f); v[j] = r * r; }
                        *(u32x2*)(H + off) = (u32x2){pk2(v[0], v[1]), pk2(v[2], v[3])};
                    }
                asm volatile("" ::: "memory");
            }
    }
};

DEV int win_colmap(int cg) {
    const int pn = cg >> 8, r = cg & 255, bj = r >> 7, wc = (r >> 5) & 3, n = (r >> 4) & 1, fq = (r >> 2) & 3, jp = (r >> 1) & 1, s = r & 1;
    int o;
    if (pn < 9) o = 256 * pn + 64 * wc + 32 * s + 8 * fq + 4 * bj + 2 * n + jp;
    else o = 256 * pn + 32 * (2 * wc + bj) + 16 * s + 4 * fq + 2 * n + jp;
    return o < INW ? o : -1;
}
DEV void sincos_acc(float ang, float& c, float& s) {
    const double x = (double)ang, twopi = 6.283185307179586476925287;
    const double k = __builtin_rint(x * (1.0 / twopi));
    const double r = x - k * twopi, r2 = r * r;
    double sp = 1.0, cp = 1.0;
#pragma unroll
    for (int i = 14; i >= 1; --i) { sp = 1.0 - sp * r2 / (double)((2 * i) * (2 * i + 1)); cp = 1.0 - cp * r2 / (double)((2 * i - 1) * (2 * i)); }
    s = (float)(r * sp); c = (float)cp;
}

DEV void transpose_tile(const float* W, int N, int K, const float* gain, bool perm, bf16_t* Bt, int c0, int k0, float* tile) {
    const int tid = otid();
#pragma unroll
    for (int it = 0; it < 8; ++it) {
        const int idx = tid + 512 * it, kk = idx >> 6, cc = idx & 63;
        const int o = perm ? win_colmap(c0 + cc) : (c0 + cc);
        float v = 0.f;
        if (o >= 0) { v = W[(size_t)(k0 + kk) * N + o]; if (gain) v *= gain[k0 + kk]; }
        tile[cc * 65 + kk] = v;
    }
    __syncthreads();
#pragma unroll
    for (int it = 0; it < 4; ++it) {
        const int idx = tid + 512 * it, cc = idx >> 5, kp = idx & 31;
        *(unsigned*)(Bt + (size_t)(c0 + cc) * K + k0 + 2 * kp) = pk2(tile[cc * 65 + 2 * kp], tile[cc * 65 + 2 * kp + 1]);
    }
    __syncthreads();
}

DEV void phase_prologue(const Params& p, unsigned char* lds) {
    const int tid = otid(), lane = tid & 63, G = gridDim.x;
    unsigned char* ws = p.ws;
    {
        bf16_t* XB = (bf16_t*)(ws + WS_XB); float* SS = (float*)(ws + WS_SS);
        for (int row = blockIdx.x * 8 + (tid >> 6); row < MT; row += G * 8) {
            const float* src = row < NPR ? p.x_prompt + (size_t)row * DM : p.x_sample + (size_t)(row - NPR) * DM;
            float* dst = p.out + (size_t)row * DM; bf16_t* xb = XB + (size_t)row * DM;
            float sq = 0.f;
#pragma unroll
            for (int i = 0; i < 4; ++i) {
                const f32x4 v = *(const f32x4*)(src + i * 256 + lane * 4);
                *(f32x4*)(dst + i * 256 + lane * 4) = v;
                *(u32x2*)(xb + i * 256 + lane * 4) = (u32x2){pk2(v[0], v[1]), pk2(v[2], v[3])};
                sq += (v[0] * v[0] + v[1] * v[1]) + (v[2] * v[2] + v[3] * v[3]);
            }
            sq = wave_sum(sq);
            if (lane < 16) SS[(size_t)row * 16 + lane] = lane == 0 ? sq : 0.f;
        }
    }
    const int gtid = blockIdx.x * NTHREADS + tid, gsz = G * NTHREADS;
    {
        float* RT = (float*)(ws + WS_ROPE);
        for (int i = gtid; i < 2080 * 32; i += gsz) {
            const int pi = i >> 5, k = i & 31, pos = pi < 2048 ? pi : PAST + (pi - 2048);
            float c, s; sincos_acc((float)pos * c_invf[k], c, s);
            RT[pi * 64 + k] = c; RT[pi * 64 + 32 + k] = s;
        }
    }
    {
        bf16_t* KS = (bf16_t*)(ws + WS_KS); bf16_t* VTS = (bf16_t*)(ws + WS_VTS); bf16_t* KIS = (bf16_t*)(ws + WS_KIS);
        for (int i = gtid; i < 2 * 8 * PAST * 4 * 8; i += gsz) {
            const int dg = i & 7, hk = (i >> 3) & 3, key = (i >> 5) & 4095, lb = i >> 17;
            const float* src = p.cache_k + (((size_t)lb * PAST + key) * 4 + hk) * 64 + dg * 8;
            const f32x4 a = *(const f32x4*)src, b = *(const f32x4*)(src + 4);
            *(u32x4*)(KS + (((size_t)lb * 4 + hk) * LSP + key) * 64 + dg * 8) = (u32x4){pk2(a[0], a[1]), pk2(a[2], a[3]), pk2(b[0], b[1]), pk2(b[2], b[3])};
        }
        for (int i = gtid; i < 2 * 8 * PAST * 4 * 8; i += gsz) {
            const int key = i & 4095, dg = (i >> 12) & 7, hk = (i >> 15) & 3, lb = i >> 17;
            const float* src = p.cache_v + (((size_t)lb * PAST + key) * 4 + hk) * 64 + dg * 8;
            const f32x4 a = *(const f32x4*)src, b = *(const f32x4*)(src + 4);
            bf16_t* d = VTS + (((size_t)lb * 4 + hk) * 64 + dg * 8) * LSP + key;
#pragma unroll
            for (int e = 0; e < 4; ++e) { d[(size_t)e * LSP] = f2bf(a[e]); d[(size_t)(4 + e) * LSP] = f2bf(b[e]); }
        }
        for (int i = gtid; i < 2 * 8 * PAST * 4; i += gsz) {
            const int dg = i & 3, key = (i >> 2) & 4095, lb = i >> 14;
            const float* src = p.cache_kidx + ((size_t)lb * PAST + key) * 32 + dg * 8;
            const f32x4 a = *(const f32x4*)src, b = *(const f32x4*)(src + 4);
            *(u32x4*)(KIS + ((size_t)lb * LSP + key) * 32 + dg * 8) = (u32x4){pk2(a[0], a[1]), pk2(a[2], a[3]), pk2(b[0], b[1]), pk2(b[2], b[3])};
        }
        for (int i = gtid; i < 64 * 32 * 8; i += gsz) {
            const int dg = i & 7, kk = (i >> 3) & 31, slot = i >> 8;
            *(u32x4*)(KS + ((size_t)slot * LSP + LS + kk) * 64 + dg * 8) = (u32x4){0u, 0u, 0u, 0u};
        }
        for (int i = gtid; i < 4096 * 8; i += gsz) {
            const int c4 = i & 7, r = i >> 3;
            *(u32x2*)(VTS + (size_t)r * LSP + LS + c4 * 4) = (u32x2){0u, 0u};
        }
    }
    {
        float* tile = (float*)lds;
        for (int job = blockIdx.x; job < 6016; job += G) {
            const int l = job / 3008; int r = job % 3008;
            if (r < 704) transpose_tile(p.w_in + (size_t)l * DM * INW, INW, DM, p.g_mix + l * DM, true, (bf16_t*)(ws + WS_WIN + (size_t)l * SZ_WIN1), (r >> 4) * 64, (r & 15) * 64, tile);
            else if (r < 960) { r -= 704; transpose_tile(p.w_out + (size_t)l * DM * DM, DM, DM, nullptr, false, (bf16_t*)(ws + WS_WOUT + (size_t)l * SZ_WOUT1), (r >> 4) * 64, (r & 15) * 64, tile); }
            else if (r < 1984) { r -= 960; transpose_tile(p.w_up + (size_t)l * DM * DFF, DFF, DM, p.g_ffn + l * DM, false, (bf16_t*)(ws + WS_WUP + (size_t)l * SZ_WUP1), (r >> 4) * 64, (r & 15) * 64, tile); }
            else { r -= 1984; transpose_tile(p.w_down + (size_t)l * DFF * DM, DM, DFF, nullptr, false, (bf16_t*)(ws + WS_WDN + (size_t)l * SZ_WUP1), (r >> 6) * 64, (r & 63) * 64, tile); }
        }
    }
}

DEV unsigned sort_key(float f) { const unsigned u = __float_as_uint(f); return (u & 0x80000000u) ? ~u : (u | 0x80000000u); }

DEV void indexer_item(const Params& p, int layer, int item, unsigned char* lds) {
    const int tid = otid(), lane = tid & 63, wave = tid >> 6;
    unsigned char* ws = p.ws;
    int nq, n, row0; const bf16_t* KI; u64* BM; int bmstride;
    if (item < 32) {
        const int b = item >> 2, qt = item & 3;
        nq = 8; n = LS; row0 = NPR + b * 32 + qt * 8;
        KI = (const bf16_t*)(ws + WS_KIS + (size_t)layer * SZ_KIS1) + (size_t)b * LSP * 32;
        BM = (u64*)(ws + WS_BMS) + (size_t)(b * 32 + qt * 8) * 72; bmstride = 72;
    } else {
        const int i2 = item - 32, c = 31 - (i2 >> 5), w = i2 & 31, b = w >> 2, qt = w & 3;
        nq = 16; n = 64 * (c + 1); row0 = b * TP + 64 * c + 16 * qt;
        KI = (const bf16_t*)(ws + WS_KIP) + (size_t)b * TP * 32;
        BM = (u64*)(ws + WS_BMP) + (size_t)row0 * 32; bmstride = 32;
    }
    const int ntile = (n + 63) >> 6;
    if (n <= 256) {
        if (tid < nq * ntile) BM[(size_t)(tid / ntile) * bmstride + (tid % ntile)] = ~0ull;
        return;
    }
    const int npad = ntile * 64;
    float* sc = (float*)lds;
    float* wl = (float*)(lds + 133120);
    const bf16_t* QI = (const bf16_t*)(ws + WS_QIB); const float* WI = (const float*)(ws + WS_WI);
    if (tid < nq * 8) wl[tid] = WI[(size_t)row0 * 8 + tid];
    const int nqb = nq >> 2;
    bf16x8 aq[4][2];
    {
        const int i = lane & 31, a = i >> 3, gi = (i >> 2) & 1, c = i & 3, qin = 2 * gi + (a >> 1), head = 4 * (a & 1) + c;
#pragma unroll
        for (int qb = 0; qb < 4; ++qb)
#pragma unroll
            for (int ks = 0; ks < 2; ++ks) {
                if (qb < nqb) aq[qb][ks] = *(const bf16x8*)(QI + (size_t)(row0 + 4 * qb + qin) * 256 + head * 32 + 8 * (lane >> 5) + 16 * ks);
                else aq[qb][ks] = (bf16x8){0, 0, 0, 0, 0, 0, 0, 0};
            }
    }
    __syncthreads();
    const int g = lane >> 5;
    for (int kb = wave; kb < (n >> 5); kb += 8) {
        const int key = kb * 32 + (lane & 31);
        const bf16x8 b0 = *(const bf16x8*)(KI + (size_t)key * 32 + 8 * g), b1 = *(const bf16x8*)(KI + (size_t)key * 32 + 8 * g + 16);
#pragma unroll
        for (int qb = 0; qb < 4; ++qb) {
            if (qb < nqb) {
                f32x16 acc;
#pragma unroll
                for (int r = 0; r < 16; ++r) acc[r] = 0.f;
                acc = __builtin_amdgcn_mfma_f32_32x32x16_bf16(aq[qb][0], b0, acc, 0, 0, 0);
                acc = __builtin_amdgcn_mfma_f32_32x32x16_bf16(aq[qb][1], b1, acc, 0, 0, 0);
#pragma unroll
                for (int qq = 0; qq < 2; ++qq) {
                    const int ql = 4 * qb + 2 * g + qq;
                    const f32x4 w0 = *(const f32x4*)(wl + ql * 8), w1 = *(const f32x4*)(wl + ql * 8 + 4);
                    float s = 0.f;
#pragma unroll
                    for (int h = 0; h < 4; ++h) { s += w0[h] * fmaxf(acc[8 * qq + h], 0.f); }
#pragma unroll
                    for (int h = 0; h < 4; ++h) { s += w1[h] * fmaxf(acc[8 * qq + 4 + h], 0.f); }
                    s = (s == 0.f) ? 0.f : s;
                    sc[(size_t)ql * npad + key] = s;
                }
            }
        }
    }
    __syncthreads();
    unsigned* scu = (unsigned*)lds;
    const int rpw = nq >> 3;
    for (int rr = 0; rr < rpw; ++rr) {
        const int ql = wave * rpw + rr;
        unsigned* rowk = scu + (size_t)ql * npad;
        for (int j = lane; j < npad; j += 64) rowk[j] = (j < n) ? sort_key(__uint_as_float(rowk[j])) : 0u;
        unsigned T = 0u;
        for (int bit = 31; bit >= 0; --bit) {
            const unsigned cand = T | (1u << bit);
            int cnt = 0;
            for (int j = lane; j < npad; j += 64) cnt += __popcll(__ballot(rowk[j] >= cand));
            if (cnt >= 256) T = cand;
        }
        int cgt = 0;
        for (int j = lane; j < npad; j += 64) cgt += __popcll(__ballot(rowk[j] > T));
        const int need = 256 - cgt;
        int eqbase = 0;
        u64* bmr = BM + (size_t)ql * bmstride;
        for (int kt = 0; kt < ntile; ++kt) {
            const unsigned kv = rowk[kt * 64 + lane];
            const bool eq = (kv == T);
            const u64 be = __ballot(eq);
            const int rank = eqbase + __popcll(be & ((1ull << lane) - 1ull));
            const bool sel = (kv > T) || (eq && rank < need);
            const u64 bs = __ballot(sel);
            eqbase += __popcll(be);
            if (lane == 0) bmr[kt] = bs;
        }
    }
    __syncthreads();
}

DEV void sgate_item(const Params& p, int layer, int item) {
    const int tid = otid(), lane = tid & 63, wave = tid >> 6, fr = lane & 15, quad = lane >> 4;
    unsigned char* ws = p.ws;
    int row0, ni, h;
    if (item < 512) { h = item & 3; row0 = (item >> 2) * 128; ni = 128; } else { const int i2 = item - 512; h = i2 & 3; row0 = NPR + (i2 >> 2) * 32; ni = 32; }
    if (wave * 16 >= ni) return;
    const int ksmax = (ni == 32) ? 1 : (wave < 4 ? 2 : 4);
    const float* W = p.w_s + ((size_t)(layer * 4 + h) * 128 + wave * 16 + fr) * 128;
    const bf16_t* SGVT = (const bf16_t*)(ws + WS_SGVT);
    f32x4 acc[4];
#pragma unroll
    for (int nn = 0; nn < 4; ++nn) acc[nn] = (f32x4){0.f, 0.f, 0.f, 0.f};
    for (int ks = 0; ks < ksmax; ++ks) {
        const f32x4 a0 = *(const f32x4*)(W + 32 * ks + 8 * quad), a1 = *(const f32x4*)(W + 32 * ks + 8 * quad + 4);
        const u32x4 aw = (u32x4){pk2(a0[0], a0[1]), pk2(a0[2], a0[3]), pk2(a1[0], a1[1]), pk2(a1[2], a1[3])};
        const bf16x8 af = __builtin_bit_cast(bf16x8, aw);
#pragma unroll
        for (int nn = 0; nn < 4; ++nn) {
            const bf16x8 bfr = *(const bf16x8*)(SGVT + (size_t)(h * 64 + 16 * nn + fr) * MT + row0 + 32 * ks + 8 * quad);
            acc[nn] = __builtin_amdgcn_mfma_f32_16x16x32_bf16(af, bfr, acc[nn], 0, 0, 0);
        }
    }
    const bf16_t* ZAU = (const bf16_t*)(ws + WS_ZAU); bf16_t* YMIX = (bf16_t*)(ws + WS_YMIX);
#pragma unroll
    for (int j = 0; j < 4; ++j) {
        const int i = wave * 16 + 4 * quad + j;
        const float bias = p.b_s[(layer * 4 + h) * 128 + i];
#pragma unroll
        for (int nn = 0; nn < 4; ++nn) {
            const int d = h * 64 + 16 * nn + fr;
            const float uu = bf2f(ZAU[(size_t)(row0 + i) * 256 + d]);
            YMIX[(size_t)(row0 + i) * 1024 + d] = f2bf(uu * (acc[nn][j] + bias));
        }
    }
}

DEV void conv_all(const Params& p, int layer) {
    unsigned char* ws = p.ws;
    const bf16_t* ZB = (const bf16_t*)(ws + WS_ZB); bf16_t* YMIX = (bf16_t*)(ws + WS_YMIX);
    const int gsz = gridDim.x * NTHREADS;
    for (int i = blockIdx.x * NTHREADS + otid(); i < MT * 32; i += gsz) {
        const int row = i >> 5, ch = (i & 31) * 8;
        const bool samp = row >= NPR; const int rs = row - NPR;
        const int b = samp ? (rs >> 5) : (row >> 11), t = samp ? (rs & 31) : (row & 2047), T = samp ? 32 : TP;
        float xc[3][8];
#pragma unroll
        for (int dt = 0; dt < 3; ++dt) {
            const int tt = t - 2 + dt;
            if (tt >= 0) {
                const bf16_t* zr = ZB + (size_t)(row - 2 + dt) * 768 + ch;
                const u32x4 gc = *(const u32x4*)(zr + 256), hi = *(const u32x4*)(zr + 512);
#pragma unroll
                for (int e = 0; e < 4; ++e) {
                    xc[dt][2 * e] = __uint_as_float(gc[e] << 16) * __uint_as_float(hi[e] << 16);
                    xc[dt][2 * e + 1] = __uint_as_float(gc[e] & 0xffff0000u) * __uint_as_float(hi[e] & 0xffff0000u);
                }
            } else if (samp) {
                const float* st = p.state_conv + (((size_t)layer * 8 + b) * 2 + (tt + 2)) * 256 + ch;
                const f32x4 a = *(const f32x4*)st, c = *(const f32x4*)(st + 4);
#pragma unroll
                for (int e = 0; e < 4; ++e) { xc[dt][e] = a[e]; xc[dt][4 + e] = c[e]; }
            } else {
#pragma unroll
                for (int e = 0; e < 8; ++e) xc[dt][e] = 0.f;
            }
        }
        const u32x4 gb = *(const u32x4*)(ZB + (size_t)row * 768 + ch);
        const float* cw = p.conv_w + (size_t)layer * 3 * 256 + ch;
        float y[8];
#pragma unroll
        for (int e = 0; e < 8; ++e) {
            const float gbe = (e & 1) ? __uint_as_float(gb[e >> 1] & 0xffff0000u) : __uint_as_float(gb[e >> 1] << 16);
            y[e] = gbe * (cw[e] * xc[0][e] + cw[256 + e] * xc[1][e] + cw[512 + e] * xc[2][e]);
        }
        *(u32x4*)(YMIX + (size_t)row * 1024 + 256 + ch) = pack8(y);
        if (t >= T - 2) {
            float* d = p.out + (samp ? O_CS : O_CP) + (((size_t)layer * 8 + b) * 2 + (t - (T - 2))) * 256 + ch;
            *(f32x4*)d = (f32x4){xc[2][0], xc[2][1], xc[2][2], xc[2][3]}; *(f32x4*)(d + 4) = (f32x4){xc[2][4], xc[2][5], xc[2][6], xc[2][7]};
        }
    }
}

DEV void phase_mix_a(const Params& p, int layer, unsigned char* lds) {
    for (int it = blockIdx.x; it < 1056 + 544; it += gridDim.x) {
        if (it < 1056) indexer_item(p, layer, it, lds);
        else sgate_item(p, layer, it - 1056);
    }
    conv_all(p, layer);
}

DEV void attn_wave(const bf16_t* Qrow, const bf16_t* Kb, const bf16_t* VT, int vpitch, const u64* bmrow, int kt0, int kt1, float c1, float c2, f32x4 (&o)[4], float& lsum) {
    const int lane = otid() & 63, fr = lane & 15, quad = lane >> 4;
    const bf16x8 q0 = *(const bf16x8*)(Qrow + 8 * quad), q1 = *(const bf16x8*)(Qrow + 32 + 8 * quad);
    for (int kt = kt0; kt < kt1; ++kt) {
        const u64 mw = bmrow[kt];
        f32x4 st[4];
#pragma unroll
        for (int t = 0; t < 4; ++t) {
            const bf16_t* kr = Kb + (size_t)(kt * 64 + 16 * t + fr) * 64 + 8 * quad;
            const bf16x8 k0 = *(const bf16x8*)kr, k1 = *(const bf16x8*)(kr + 32);
            f32x4 z = (f32x4){0.f, 0.f, 0.f, 0.f};
            z = __builtin_amdgcn_mfma_f32_16x16x32_bf16(k0, q0, z, 0, 0, 0);
            st[t] = __builtin_amdgcn_mfma_f32_16x16x32_bf16(k1, q1, z, 0, 0, 0);
        }
#pragma unroll
        for (int t = 0; t < 4; ++t)
#pragma unroll
            for (int j = 0; j < 4; ++j) {
                const bool on = (mw >> (16 * t + 4 * quad + j)) & 1ull;
                const float pv = on ? __builtin_amdgcn_exp2f(st[t][j] * c1 - c2) : 0.f;
                st[t][j] = pv; lsum += pv;
            }
#pragma unroll
        for (int i = 0; i < 2; ++i) {
            const u32x4 pw = (u32x4){pk2(st[2 * i][0], st[2 * i][1]), pk2(st[2 * i][2], st[2 * i][3]), pk2(st[2 * i + 1][0], st[2 * i + 1][1]), pk2(st[2 * i + 1][2], st[2 * i + 1][3])};
            const bf16x8 pa = __builtin_bit_cast(bf16x8, pw);
#pragma unroll
            for (int nn = 0; nn < 4; ++nn) {
                const bf16_t* vr = VT + (size_t)(16 * nn + fr) * vpitch + kt * 64 + 32 * i + 4 * quad;
                const u32x2 v0 = *(const u32x2*)vr, v1 = *(const u32x2*)(vr + 16);
                const bf16x8 vb = __builtin_bit_cast(bf16x8, (u32x4){v0.x, v0.y, v1.x, v1.y});
                o[nn] = __builtin_amdgcn_mfma_f32_16x16x32_bf16(pa, vb, o[nn], 0, 0, 0);
            }
        }
    }
}

DEV void attn_item(const Params& p, int layer, int item, float c1, float c2, unsigned char* lds) {
    const int tid = otid(), lane = tid & 63, wave = tid >> 6, fr = lane & 15, quad = lane >> 4;
    unsigned char* ws = p.ws;
    const bf16_t* QB = (const bf16_t*)(ws + WS_QB); bf16_t* YMIX = (bf16_t*)(ws + WS_YMIX);
    f32x4 o[4];
#pragma unroll
    for (int nn = 0; nn < 4; ++nn) o[nn] = (f32x4){0.f, 0.f, 0.f, 0.f};
    float lsum = 0.f;
    int rowq, head;
    if (item < 32) {
        const int b = item >> 2, hk = item & 3, rg = wave & 3, half = wave >> 2;
        head = 2 * hk + (rg >> 1); rowq = NPR + b * 32 + 16 * (rg & 1);
        const bf16_t* Kb = (const bf16_t*)(ws + WS_KS + (size_t)layer * SZ_KS1) + (size_t)(b * 4 + hk) * LSP * 64;
        const bf16_t* VT = (const bf16_t*)(ws + WS_VTS + (size_t)layer * SZ_KS1) + (size_t)(b * 4 + hk) * 64 * LSP;
        const u64* bm = (const u64*)(ws + WS_BMS) + (size_t)(b * 32 + 16 * (rg & 1) + fr) * 72;
        attn_wave(QB + (size_t)(rowq + fr) * 512 + head * 64, Kb, VT, LSP, bm, half ? 33 : 0, half ? 65 : 33, c1, c2, o, lsum);
        float* xo = (float*)lds;
        if (half) {
            float* d = xo + ((size_t)rg * 64 + lane) * 17;
#pragma unroll
            for (int nn = 0; nn < 4; ++nn)
#pragma unroll
                for (int j = 0; j < 4; ++j) d[nn * 4 + j] = o[nn][j];
            d[16] = lsum;
        }
        __syncthreads();
        if (!half) {
            const float* d = xo + ((size_t)rg * 64 + lane) * 17;
#pragma unroll
            for (int nn = 0; nn < 4; ++nn)
#pragma unroll
                for (int j = 0; j < 4; ++j) o[nn][j] += d[nn * 4 + j];
            lsum += d[16];
        }
        __syncthreads();
        if (half) return;
    } else {
        const int i2 = item - 32, c = 31 - (i2 >> 5), w = i2 & 31, b = w >> 2, hk = w & 3;
        head = 2 * hk + (wave >> 2); rowq = b * TP + 64 * c + 16 * (wave & 3);
        const bf16_t* Kb = (const bf16_t*)(ws + WS_KP) + (size_t)(b * 4 + hk) * TP * 64;
        const bf16_t* VT = (const bf16_t*)(ws + WS_VTP) + (size_t)(b * 4 + hk) * 64 * TP;
        const u64* bm = (const u64*)(ws + WS_BMP) + (size_t)(rowq + fr) * 32;
        attn_wave(QB + (size_t)(rowq + fr) * 512 + head * 64, Kb, VT, TP, bm, 0, c + 1, c1, c2, o, lsum);
    }
    lsum += __shfl_xor(lsum, 16); lsum += __shfl_xor(lsum, 32);
#pragma unroll
    for (int j = 0; j < 4; ++j) {
        const float l = __shfl(lsum, 4 * quad + j);
        const float inv = 1.0f / l;
#pragma unroll
        for (int nn = 0; nn < 4; ++nn) YMIX[(size_t)(rowq + 4 * quad + j) * 1024 + 512 + head * 64 + 16 * nn + fr] = f2bf(o[nn][j] * inv);
    }
}

DEV void phase_attn(const Params& p, int layer, unsigned char* lds) {
    const int lane = otid() & 63;
    const float gq = wave_max(fabsf(p.q_gain[layer * 64 + lane])), gk = wave_max(fabsf(p.k_gain[layer * 64 + lane]));
    const float bound = 8.0f * gq * gk * 1.02f;
    const float c1 = 0.125f * 1.4426950408889634f, c2 = bound * 1.4426950408889634f;
    for (int it = blockIdx.x; it < 1056; it += gridDim.x) attn_item(p, layer, it, c1, c2, lds);
}

__global__ void __launch_bounds__(NTHREADS) hybrid_fwd(Params p) {
    extern __shared__ __attribute__((aligned(16))) unsigned char lds[];
    cg::grid_group grid = cg::this_grid();
    PG8_LAS unsigned char* l3 = (PG8_LAS unsigned char*)lds;
    unsigned char* ws = p.ws;
    bf16_t* XB = (bf16_t*)(ws + WS_XB); float* SS = (float*)(ws + WS_SS);
    for (int ph = p.ph_lo; ph < p.ph_hi; ++ph) {
        if (ph > p.ph_lo) grid.sync();
        if (ph == 0) {
#ifndef NO_P0
            phase_prologue(p, lds);
#endif
            continue; }
        const int l = (ph - 1) / 6, s = (ph - 1) % 6;
        if (s == 0) {
#ifndef NO_S0
            pg8::Gemm g{XB, (const bf16_t*)(ws + WS_WIN + (size_t)l * SZ_WIN1), MT, INWP, DM};
            pg8::StaticOrder S; S.init(MT, INWP, (int)gridDim.x, (int)blockIdx.x);
            EpiIn E{SS, (const float*)(ws + WS_ROPE), p.q_gain, p.k_gain, p.out, ws, l};
            pg8::gemm_phase<EpiIn, pg8::StaticOrder>(l3, g, S, E, nullptr);
#endif
        } else if (s == 1) {
#ifndef NO_S1
            phase_mix_a(p, l, lds);
#endif
        } else if (s == 2) {
#ifndef NO_S2
            phase_attn(p, l, lds);
#endif
        } else if (s == 3) {
#ifndef NO_S3
            pg8::Gemm g{(const bf16_t*)(ws + WS_YMIX), (const bf16_t*)(ws + WS_WOUT + (size_t)l * SZ_WOUT1), MT, DM, DM};
            pg8::StaticOrder S; S.init(MT, DM, (int)gridDim.x, (int)blockIdx.x);
            EpiRes E{p.out, XB, SS};
            pg8::gemm_phase<EpiRes, pg8::StaticOrder>(l3, g, S, E, nullptr);
#endif
        } else if (s == 4) {
#ifndef NO_S4
            pg8::Gemm g{XB, (const bf16_t*)(ws + WS_WUP + (size_t)l * SZ_WUP1), MT, DFF, DM};
            pg8::StaticOrder S; S.init(MT, DFF, (int)gridDim.x, (int)blockIdx.x);
            EpiUp E{(bf16_t*)(ws + WS_H), SS};
            pg8::gemm_phase<EpiUp, pg8::StaticOrder>(l3, g, S, E, nullptr);
#endif
        } else {
#ifndef NO_S5
            pg8::Gemm g{(const bf16_t*)(ws + WS_H), (const bf16_t*)(ws + WS_WDN + (size_t)l * SZ_WUP1), MT, DM, DFF};
            pg8::StaticOrder S; S.init(MT, DM, (int)gridDim.x, (int)blockIdx.x);
            EpiRes E{p.out, XB, SS};
            pg8::gemm_phase<EpiRes, pg8::StaticOrder>(l3, g, S, E, nullptr);
#endif
        }
    }
}

extern "C" void kernel_launch(void* const* d_in, const int* in_sizes, int n_in, void* d_out, int out_size, void* d_ws, size_t ws_size, hipStream_t stream) {
    static int grid = 0;
    if (grid == 0) {
        if (n_in != 17 || out_size != 35291136 || ws_size < WS_END) { fprintf(stderr, "kernel_launch: unexpected shapes (n_in %d, out %d, ws %zu, need %zu)\n", n_in, out_size, ws_size, (size_t)WS_END); grid = -1; return; }
        int dev = 0, cus = 0, per_cu = 0;
        hipGetDevice(&dev);
        hipDeviceGetAttribute(&cus, hipDeviceAttributeMultiprocessorCount, dev);
        if (hipFuncSetAttribute((const void*)hybrid_fwd, hipFuncAttributeMaxDynamicSharedMemorySize, LDS_BYTES) != hipSuccess) { fprintf(stderr, "kernel_launch: hipFuncSetAttribute failed\n"); grid = -1; return; }
        if (hipOccupancyMaxActiveBlocksPerMultiprocessor(&per_cu, (const void*)hybrid_fwd, NTHREADS, LDS_BYTES) != hipSuccess || per_cu < 1) { fprintf(stderr, "kernel_launch: occupancy query says %d blocks per CU\n", per_cu); grid = -1; return; }
        grid = cus;
        if (per_cu * cus < grid) grid = per_cu * cus;
    }
    if (grid < 0) return;
    Params p{};
    p.x_prompt = (const float*)d_in[0]; p.x_sample = (const float*)d_in[1]; p.cache_k = (const float*)d_in[2]; p.cache_v = (const float*)d_in[3];
    p.cache_kidx = (const float*)d_in[4]; p.state_conv = (const float*)d_in[5]; p.g_mix = (const float*)d_in[6]; p.w_in = (const float*)d_in[7];
    p.q_gain = (const float*)d_in[8]; p.k_gain = (const float*)d_in[9]; p.w_s = (const float*)d_in[10]; p.b_s = (const float*)d_in[11];
    p.conv_w = (const float*)d_in[12]; p.w_out = (const float*)d_in[13]; p.g_ffn = (const float*)d_in[14]; p.w_up = (const float*)d_in[15]; p.w_down = (const float*)d_in[16];
    p.out = (float*)d_out; p.ws = (unsigned char*)d_ws;
#if N_LAUNCH_MODE == 1
    p.ph_lo = 0; p.ph_hi = 13;
    void* args[] = {&p};
    hipError_t e = hipLaunchCooperativeKernel((const void*)hybrid_fwd, dim3(grid), dim3(NTHREADS), args, LDS_BYTES, stream);
    if (e != hipSuccess) fprintf(stderr, "kernel_launch: cooperative launch failed: %s (grid %d)\n", hipGetErrorString(e), grid);
#else
    for (int ph = 0; ph < 13; ++ph) {
        p.ph_lo = ph; p.ph_hi = ph + 1;
        hipLaunchKernelGGL(hybrid_fwd, dim3(grid), dim3(NTHREADS), LDS_BYTES, stream, p);
    }
#endif
}
```

```cpp
#include <hip/hip_runtime.h>
#include <hip/hip_cooperative_groups.h>
#include <cstdio>
namespace cg = cooperative_groups;
#ifndef N_LAUNCH_MODE
#define N_LAUNCH_MODE 1
#endif
__device__ __forceinline__ int otid() { int t = (int)threadIdx.x; asm volatile("" : "+v"(t)); return t; }

namespace pg8 {
#define PG8_LAS __attribute__((address_space(3)))
typedef unsigned short bf16_t;
typedef short bf16x8 __attribute__((ext_vector_type(8)));
typedef float f32x4 __attribute__((ext_vector_type(4)));
typedef unsigned u32x4 __attribute__((ext_vector_type(4)));
constexpr int BM = 256, BK = 64, HALF = 128, HTB = HALF * BK * 2  , STAGE_BYTES = 8 * HTB, NXCD = 8, WGM = 8;

__host__ __device__ __forceinline__ int lds_byte(int r, int c) { const int st = (r >> 4) * 2 + (c >> 5), rr = r & 15, cc = c & 31, ob = rr * 64 + cc * 2; return st * 1024 + (ob ^ (((ob >> 9) & 1) << 5)); }
__host__ __device__ __forceinline__ void stage_rc(int b, int& R, int& C) { const int st = b / 1024, sb = b % 1024, swz = sb ^ (((sb >> 9) & 1) << 5); R = (st >> 1) * 16 + swz / 64; C = (st & 1) * 32 + (swz % 64) / 2; }
__host__ __device__ __forceinline__ int perm32(int rho) { const int n = rho >> 4, i = rho & 15; return 8 * (i >> 2) + 4 * n + (i & 3); }

struct Unit { int pm, pn; };
struct Gemm { const bf16_t* A; const bf16_t* Bt; int M, N, K; };

struct StaticOrder {
    int nM, nN, nwg, G, c;
    __host__ __device__ void init(int M, int N, int G_, int c_) { nM = M / BM; nN = N / BM; nwg = nM * nN; G = G_; c = c_; }
    __host__ __device__ bool next(int i, Unit& u) const {
        const long L = (long)i * G + c; if (L >= nwg) return false;
        int wgid = (int)L; { const int q = nwg / NXCD, r = nwg % NXCD, xcd = wgid % NXCD, off = wgid / NXCD; wgid = (xcd < r ? xcd * (q + 1) : r * (q + 1) + (xcd - r) * q) + off; }
        const int nig = WGM * nN, gid = wgid / nig, fm = gid * WGM, gsz = (nM - fm) < WGM ? (nM - fm) : WGM;
        u.pm = fm + ((wgid % nig) % gsz); u.pn = (wgid % nig) / gsz; return true;
    }
    __device__ __forceinline__ void a_ready(const Unit&) const {}
    __device__ __forceinline__ void done(const Unit&) const {}
};
template <class Epi, class Sched, bool STAMP = false>
__device__ __forceinline__ void gemm_phase(PG8_LAS unsigned char* lds, const Gemm g, const Sched& S, const Epi& E, unsigned long long* stamps) {
    const int tid = otid(), wid = __builtin_amdgcn_readfirstlane(tid >> 6), lane = tid & 63, wr = wid >> 2, wc = wid & 3, fr = lane & 15, fq = lane >> 4;
    const int K = g.K, nt = K / BK;
    int ts_lo = 0, ts_hi = 0, nts = 0; const unsigned long long rt_entry = STAMP ? (unsigned long long)wall_clock64() : 0ull;
#define PG8_STAMP() do { if (STAMP && wid == 0 && nts < 64) { const unsigned long long _c = (unsigned long long)clock64(); \
        ts_lo = (lane == nts) ? (int)(unsigned)_c : ts_lo; ts_hi = (lane == nts) ? (int)(unsigned)(_c >> 32) : ts_hi; ++nts; } } while (0)
    PG8_STAMP();
    unsigned voffA[2], voffB[2];
#pragma unroll
    for (int i = 0; i < 2; ++i) { int R, C; stage_rc(tid * 16 + i * 8192, R, C); const int Rb = Epi::PERM ? ((R & ~31) + perm32(R & 31)) : R;
        voffA[i] = (unsigned)(R * K + C) * 2u; voffB[i] = (unsigned)(Rb * K + C) * 2u; }
    const size_t kstep = (size_t)(BK * 2);
    const size_t hstep = (size_t)HALF * K * 2;
    const size_t tstep = 2 * hstep;
    const unsigned ldsw = (unsigned)wid * 1024u;
    const int aoff = lds_byte(wr * 64 + fr, fq * 8), boff = lds_byte(wc * 32 + fr, fq * 8);
#define PG8_SA(b, h) (((b) * 2 + (h)) * HTB)
#define PG8_SB(b, h) ((4 + (b) * 2 + (h)) * HTB)
#define PG8_STAGE(bufoff, gbase, voff) do { _Pragma("unroll") for (int _i = 0; _i < 2; ++_i) \
        __builtin_amdgcn_global_load_lds((const unsigned*)((const char*)(gbase) + (voff)[_i]), (PG8_LAS unsigned*)(lds + (bufoff) + ldsw + _i * 8192), 16, 0, 0); } while (0)
#define PG8_LDA(dst, b, h) do { _Pragma("unroll") for (int m = 0; m < 4; ++m) _Pragma("unroll") for (int k = 0; k < 2; ++k) dst[m][k] = *(const PG8_LAS bf16x8*)(lds + PG8_SA(b, h) + aoff + m * 2048 + k * 1024); } while (0)
#define PG8_LDB(dst, b, h) do { _Pragma("unroll") for (int n = 0; n < 2; ++n) _Pragma("unroll") for (int k = 0; k < 2; ++k) dst[n][k] = *(const PG8_LAS bf16x8*)(lds + PG8_SB(b, h) + boff + n * 2048 + k * 1024); } while (0)
#define PG8_MMA(ai, bj, At, Bt) do { __builtin_amdgcn_s_setprio(1); _Pragma("unroll") for (int m = 0; m < 4; ++m) _Pragma("unroll") for (int n = 0; n < 2; ++n) _Pragma("unroll") for (int k = 0; k < 2; ++k) \
        acc[ai][bj][m][n] = __builtin_amdgcn_mfma_f32_16x16x32_bf16(Bt[n][k], At[m][k], acc[ai][bj][m][n], 0, 0, 0); __builtin_amdgcn_s_setprio(0); } while (0)
#define PG8_WAIT_V(n) asm volatile("s_waitcnt vmcnt(" #n ")" ::: "memory")
#define PG8_WAIT_L(n) asm volatile("s_waitcnt lgkmcnt(" #n ")" ::: "memory")
#define PG8_BAR __builtin_amdgcn_s_barrier()
#define PG8_SCHED __builtin_amdgcn_sched_barrier(0)
    Unit cur, nxt; int ui = 0;
    if (!S.next(0, cur)) return;
    f32x4 acc[2][2][4][2];
#pragma unroll
    for (int a = 0; a < 2; ++a)
#pragma unroll
        for (int b = 0; b < 2; ++b)
#pragma unroll
            for (int m = 0; m < 4; ++m)
#pragma unroll
                for (int n = 0; n < 2; ++n) acc[a][b][m][n] = (f32x4){0.f, 0.f, 0.f, 0.f};
    bf16x8 At[4][2], B0[2][2], B1[2][2];
    const char* cA = (const char*)g.A + (size_t)cur.pm * tstep; const char* cB = (const char*)g.Bt + (size_t)cur.pn * tstep;
    S.a_ready(cur);
    PG8_STAGE(PG8_SB(0, 0), cB, voffB); PG8_STAGE(PG8_SA(0, 0), cA, voffA); PG8_STAGE(PG8_SB(0, 1), cB + hstep, voffB); PG8_STAGE(PG8_SA(0, 1), cA + hstep, voffA);
    if (wr == 1) PG8_BAR;
    PG8_WAIT_V(4); PG8_BAR;
    PG8_STAGE(PG8_SB(1, 0), cB + kstep, voffB); PG8_STAGE(PG8_SA(1, 0), cA + kstep, voffA); PG8_STAGE(PG8_SB(1, 1), cB + hstep + kstep, voffB);
    PG8_WAIT_V(6); PG8_BAR;
    PG8_STAMP();
    for (;;) {
        const bool has_next = S.next(ui + 1, nxt);
        const char* nA = has_next ? (const char*)g.A + (size_t)nxt.pm * tstep : cA; const char* nB = has_next ? (const char*)g.Bt + (size_t)nxt.pn * tstep : cB;
        for (int t = 0; t < nt; t += 2) {
            const bool last = (t == nt - 2);
            const char* a1 = cA + (size_t)(t + 1) * kstep;
            const char* a2 = last ? nA : cA + (size_t)(t + 2) * kstep; const char* b2 = last ? nB : cB + (size_t)(t + 2) * kstep;
            const char* a3 = a2 + kstep; const char* b3 = b2 + kstep;
            if (last && has_next) S.a_ready(nxt);
            PG8_LDB(B0, 0, 0); PG8_SCHED; PG8_LDA(At, 0, 0); PG8_STAGE(PG8_SA(1, 1), a1 + hstep, voffA);
            PG8_WAIT_L(8); PG8_BAR; PG8_WAIT_L(0); PG8_MMA(0, 0, At, B0); PG8_BAR; PG8_SCHED;
            PG8_LDB(B1, 0, 1); PG8_STAGE(PG8_SB(0, 0), b2, voffB);
            PG8_BAR; PG8_WAIT_L(0); PG8_MMA(0, 1, At, B1); PG8_BAR;
            PG8_LDA(At, 0, 1); PG8_STAGE(PG8_SA(0, 0), a2, voffA);
            PG8_BAR; PG8_WAIT_L(0); PG8_MMA(1, 0, At, B0); PG8_BAR; PG8_SCHED;
            PG8_STAGE(PG8_SB(0, 1), b2 + hstep, voffB);
            PG8_WAIT_V(6); PG8_BAR; PG8_MMA(1, 1, At, B1); PG8_BAR;
            PG8_LDB(B0, 1, 0); PG8_SCHED; PG8_LDA(At, 1, 0); PG8_STAGE(PG8_SA(0, 1), a2 + hstep, voffA);
            PG8_WAIT_L(8); PG8_BAR; PG8_WAIT_L(0); PG8_MMA(0, 0, At, B0); PG8_BAR; PG8_SCHED;
            PG8_LDB(B1, 1, 1); PG8_STAGE(PG8_SB(1, 0), b3, voffB);
            PG8_BAR; PG8_WAIT_L(0); PG8_MMA(0, 1, At, B1); PG8_BAR;
            PG8_LDA(At, 1, 1); PG8_STAGE(PG8_SA(1, 0), a3, voffA);
            PG8_BAR; PG8_WAIT_L(0); PG8_MMA(1, 0, At, B0); PG8_BAR; PG8_SCHED;
            PG8_STAGE(PG8_SB(1, 1), b3 + hstep, voffB);
            PG8_WAIT_V(6); PG8_BAR; PG8_MMA(1, 1, At, B1); PG8_BAR;
        }
        PG8_STAMP();
        if constexpr (!Epi::AFTER_DRAIN) { E(acc, cur, wr, wc, fr, fq); S.done(cur); }
        PG8_STAMP();
        if (!has_next) break;
#pragma unroll
        for (int a = 0; a < 2; ++a)
#pragma unroll
            for (int b = 0; b < 2; ++b)
#pragma unroll
                for (int m = 0; m < 4; ++m)
#pragma unroll
                    for (int n = 0; n < 2; ++n) acc[a][b][m][n] = (f32x4){0.f, 0.f, 0.f, 0.f};
        cur = nxt; cA = nA; cB = nB; ++ui;
    }
    PG8_WAIT_V(0);
    if (wr == 0) PG8_BAR;
    PG8_BAR;
    if constexpr (Epi::AFTER_DRAIN) { E.fused(acc, cur, wr, wc, fr, fq, lds, wid, lane); S.done(cur); }
    PG8_STAMP();
    if (STAMP && wid == 0) { stamps[lane] = lane < nts ? (((unsigned long long)(unsigned)ts_hi << 32) | (unsigned)ts_lo) : 0ull;
        if (lane == 62) stamps[62] = rt_entry; if (lane == 63) stamps[63] = (unsigned long long)wall_clock64(); }
#undef PG8_STAMP
#undef PG8_SA
#undef PG8_SB
#undef PG8_STAGE
#undef PG8_LDA
#undef PG8_LDB
#undef PG8_MMA
#undef PG8_WAIT_V
#undef PG8_WAIT_L
#undef PG8_BAR
#undef PG8_SCHED
}
}

using pg8::bf16_t; using pg8::bf16x8; using pg8::f32x4; using pg8::u32x4;
typedef float f32x16 __attribute__((ext_vector_type(16)));
typedef unsigned u32x2 __attribute__((ext_vector_type(2)));
typedef unsigned long long u64;
#define DEV __device__ __forceinline__

constexpr int DM = 1024, TP = 2048, NPR = 16384, NSR = 256, MT = 16640, INW = 2600, INWP = 2816, DFF = 4096, PAST = 4096, LS = 4128, LSP = 4160, TPV = 2112;
constexpr int NTHREADS = 512;
constexpr int LDS_BYTES = 139264;
constexpr size_t O_YP = 0, O_YS = 16777216, O_KP = 17039360, O_VP = 25427968, O_KIP = 33816576, O_CP = 34865152, O_KS = 34873344, O_VS = 35004416, O_KIS = 35135488, O_CS = 35151872, O_SGV = 35160064;
constexpr size_t WS_WIN = 0, SZ_WIN1 = (size_t)INWP * DM * 2;
constexpr size_t WS_WOUT = WS_WIN + 2 * SZ_WIN1, SZ_WOUT1 = (size_t)DM * DM * 2;
constexpr size_t WS_WUP = WS_WOUT + 2 * SZ_WOUT1, SZ_WUP1 = (size_t)DFF * DM * 2;
constexpr size_t WS_WDN = WS_WUP + 2 * SZ_WUP1;
constexpr size_t WS_XB = WS_WDN + 2 * SZ_WUP1;
constexpr size_t WS_SS = WS_XB + (size_t)MT * DM * 2;
constexpr size_t WS_ROPE = WS_SS + (size_t)MT * 16 * 4;
constexpr size_t WS_WI = WS_ROPE + (size_t)2080 * 64 * 4;
constexpr size_t WS_KS = WS_WI + (size_t)MT * 8 * 4, SZ_KS1 = (size_t)8 * 4 * LSP * 64 * 2;
constexpr size_t WS_VTS = WS_KS + 2 * SZ_KS1;
constexpr size_t WS_KIS = WS_VTS + 2 * SZ_KS1, SZ_KIS1 = (size_t)8 * LSP * 32 * 2;
constexpr size_t WS_BMP = WS_KIS + 2 * SZ_KIS1;
constexpr size_t WS_BMS = WS_BMP + (size_t)NPR * 32 * 8;
constexpr size_t WS_BAR = WS_BMS + (size_t)NSR * 72 * 8;
constexpr size_t WS_PART = WS_BAR + 16384;
constexpr size_t SZ_PARTO = (size_t)8 * 4 * 4 * 64 * 64 * 4;
constexpr size_t WS_MIX = WS_PART + SZ_PARTO + (size_t)8 * 4 * 4 * 64 * 4;
constexpr size_t WS_H = WS_MIX;
constexpr size_t WS_YMIX = WS_MIX;
constexpr size_t WS_ZB = WS_YMIX + (size_t)MT * 1024 * 2;
constexpr size_t WS_QB = WS_ZB + (size_t)MT * 768 * 2;
constexpr size_t WS_ZAU = WS_QB + (size_t)MT * 512 * 2;
constexpr size_t WS_SGVT = WS_ZAU + (size_t)MT * 256 * 2;
constexpr size_t WS_QIB = WS_SGVT + (size_t)MT * 256 * 2;
constexpr size_t WS_KP = WS_QIB + (size_t)MT * 256 * 2;
constexpr size_t WS_VTP = WS_KP + (size_t)8 * 4 * TP * 64 * 2;
constexpr size_t WS_KIP = WS_VTP + (size_t)8 * 4 * TPV * 64 * 2;
constexpr size_t WS_MIX_END = WS_KIP + (size_t)8 * TP * 32 * 2;
constexpr size_t WS_END = WS_H + (size_t)MT * DFF * 2;
static_assert(WS_MIX_END <= WS_END, "mixer intermediates must fit inside the H alias");
static_assert(WS_XB % 256 == 0 && WS_SS % 256 == 0 && WS_ROPE % 256 == 0 && WS_WI % 256 == 0 && WS_KS % 256 == 0 && WS_VTS % 256 == 0 && WS_KIS % 256 == 0 && WS_BMP % 256 == 0 && WS_BMS % 256 == 0 && WS_MIX % 256 == 0, "align");
static_assert(WS_ZB % 256 == 0 && WS_QB % 256 == 0 && WS_ZAU % 256 == 0 && WS_SGVT % 256 == 0 && WS_QIB % 256 == 0 && WS_KP % 256 == 0 && WS_VTP % 256 == 0 && WS_KIP % 256 == 0, "align2");

struct Params {
    const float* x_prompt; const float* x_sample; const float* cache_k; const float* cache_v; const float* cache_kidx; const float* state_conv;
    const float* g_mix; const float* w_in; const float* q_gain; const float* k_gain; const float* w_s; const float* b_s; const float* conv_w;
    const float* w_out; const float* g_ffn; const float* w_up; const float* w_down;
    float* out; unsigned char* ws;
    int ph_lo, ph_hi;
};

__constant__ float c_invf[32] = {1.000000000e+00f, 7.498942614e-01f, 5.623413324e-01f, 4.216965139e-01f, 3.162277639e-01f, 2.371373773e-01f, 1.778279394e-01f, 1.333521307e-01f, 1.000000015e-01f, 7.498941571e-02f, 5.623413250e-02f, 4.216965288e-02f, 3.162277490e-02f, 2.371373773e-02f, 1.778279431e-02f, 1.333521493e-02f, 9.999999776e-03f, 7.498941850e-03f, 5.623413250e-03f, 4.216964822e-03f, 3.162277630e-03f, 2.371373586e-03f, 1.778279431e-03f, 1.333521446e-03f, 1.000000047e-03f, 7.498942432e-04f, 5.623413017e-04f, 4.216965172e-04f, 3.162277571e-04f, 2.371373703e-04f, 1.778279402e-04f, 1.333521504e-04f};

DEV float bf2f(unsigned short h) { return __uint_as_float((unsigned)h << 16); }
typedef __bf16 bf16v2_t __attribute__((ext_vector_type(2)));
typedef float f32v2_t __attribute__((ext_vector_type(2)));
DEV unsigned pk2(float lo, float hi) { return __builtin_bit_cast(unsigned, __builtin_convertvector((f32v2_t){lo, hi}, bf16v2_t)); }
DEV unsigned short f2bf(float x) { return (unsigned short)(pk2(x, 0.f) & 0xffffu); }
DEV u32x4 pack8(const float (&v)[8]) { u32x4 w; w.x = pk2(v[0], v[1]); w.y = pk2(v[2], v[3]); w.z = pk2(v[4], v[5]); w.w = pk2(v[6], v[7]); return w; }
DEV float gelu_tanh(float x) {
    const float y = 0.7978845608028654f * (x + 0.044715f * x * x * x);
    const float e = __builtin_amdgcn_exp2f(-2.0f * 1.4426950408889634f * y);
    return x * __builtin_amdgcn_rcpf(1.0f + e);
}
DEV float wave_sum(float v) {
#pragma unroll
    for (int o = 32; o > 0; o >>= 1) v += __shfl_xor(v, o);
    return v;
}
DEV float wave_max(float v) {
#pragma unroll
    for (int o = 32; o > 0; o >>= 1) v = fmaxf(v, __shfl_xor(v, o));
    return v;
}

#define XB_TMO      128
#define XB_XCNT(j)  (256  + 64 * (j))
#define XB_XSUB(j)  (1280 + 64 * (j))
#define XB_XGEN(j)  (2304 + 64 * (j))
#define XB_TOP      3328
#define XB_TOPGEN   3392
#define XCD_BAR_WORDS 3456
#define XB_SPIN_CAP (1u << 18)
#define LAS __attribute__((address_space(3)))

__device__ __forceinline__ unsigned xb_ld(unsigned* p)              { return __hip_atomic_load(p, __ATOMIC_RELAXED, __HIP_MEMORY_SCOPE_AGENT); }
__device__ __forceinline__ unsigned xb_add(unsigned* p, unsigned v) { return __hip_atomic_fetch_add(p, v, __ATOMIC_RELAXED, __HIP_MEMORY_SCOPE_AGENT); }
__device__ __forceinline__ unsigned xb_xcc_id() { return (unsigned)__builtin_amdgcn_s_getreg((3 << 11) | 20) & 0xFu; }
#define XB_SPIN(cond, bar) do { unsigned _sp = 0; while (cond) { __builtin_amdgcn_s_sleep(1); \
    if ((++_sp & 255u) == 0u) { if (xb_ld(&(bar)[XB_TMO])) break; if (_sp > XB_SPIN_CAP) { atomicAdd(&(bar)[XB_TMO], 1u); break; } } } } while (0)

struct XcdBarrier {
    unsigned* bar; unsigned x;
    volatile LAS unsigned* st;
};

__device__ __forceinline__ XcdBarrier xcd_barrier_post(unsigned* bar, volatile LAS unsigned* st) {
    XcdBarrier b; b.bar = bar; b.x = xb_xcc_id(); b.st = st;
    if (threadIdx.x == 0) (void)xb_add(&bar[XB_XCNT(b.x)], 1u);
    return b;
}
__device__ __forceinline__ void xcd_barrier_complete(unsigned* bar, unsigned x, unsigned& nloc, unsigned& nx) {
    const unsigned G = gridDim.x * gridDim.y * gridDim.z;
    unsigned sum, cnt, mine, sp = 0u;
    for (;;) {
        sum = 0u; cnt = 0u; mine = 0u;
#pragma unroll
        for (unsigned j = 0; j < 16; ++j) { const unsigned c = xb_ld(&bar[XB_XCNT(j)]); sum += c; cnt += (c > 0u) ? 1u : 0u; mine = (j == x) ? c : mine; }
        if (sum == G) break;
        __builtin_amdgcn_s_sleep(1);
        if ((++sp & 255u) == 0u) { if (xb_ld(&bar[XB_TMO])) break; if (sp > XB_SPIN_CAP) { atomicAdd(&bar[XB_TMO], 1u); break; } }
    }
    nloc = mine > 0u ? mine : 1u; nx = cnt > 0u ? cnt : 1u;
}

__device__ __forceinline__ void xcd_barrier(const XcdBarrier& b) {
    asm volatile("s_waitcnt vmcnt(0)" ::: "memory");
    __syncthreads();
    if (threadIdx.x == 0) {
        unsigned* bar = b.bar;
        __builtin_amdgcn_s_waitcnt(0);
        unsigned nloc = b.st[0], nx = b.st[1];
        if (nloc == 0u) { xcd_barrier_complete(bar, b.x, nloc, nx); b.st[0] = nloc; b.st[1] = nx; }
        const unsigned old = xb_add(&bar[XB_XSUB(b.x)], 1u);
        const unsigned gen = old / nloc;
        if (old + 1u == (gen + 1u) * nloc) {
            __builtin_amdgcn_fence(__ATOMIC_RELEASE, "agent");
            asm volatile("s_waitcnt vmcnt(0)" ::: "memory");
            const unsigned og = xb_add(&bar[XB_TOP], 1u);
            const unsigned tg = og / nx;
            if (og + 1u == (tg + 1u) * nx) xb_add(&bar[XB_TOPGEN], 1u);
            else XB_SPIN(xb_ld(&bar[XB_TOPGEN]) == tg, bar);
            __builtin_amdgcn_fence(__ATOMIC_ACQUIRE, "agent");
            xb_add(&bar[XB_XGEN(b.x)], 1u);
            asm volatile("s_waitcnt vmcnt(0)" ::: "memory");
        } else {
            XB_SPIN(xb_ld(&bar[XB_XGEN(b.x)]) == gen, bar);
            __builtin_amdgcn_fence(__ATOMIC_ACQUIRE, "agent");
            asm volatile("s_waitcnt vmcnt(0)" ::: "memory");
        }
    }
    __syncthreads();
}


DEV float row_rstd(const float* ss, int row) {
    const f32x4* sp = (const f32x4*)(ss + (size_t)row * 16);
    const f32x4 a = sp[0], b = sp[1], c = sp[2], d = sp[3];
    const float t = ((a[0] + a[1]) + (a[2] + a[3])) + ((b[0] + b[1]) + (b[2] + b[3])) + ((c[0] + c[1]) + (c[2] + c[3])) + ((d[0] + d[1]) + (d[2] + d[3]));
    return rsqrtf(t * (1.0f / 1024.0f) + 1e-6f);
}

struct EpiIn {
    static constexpr bool PERM = false, AFTER_DRAIN = false;
    const float* ss; const float* rope; const float* qg; const float* kg; float* out; unsigned char* ws; int layer;
    __device__ __forceinline__ void operator()(const f32x4 (&acc)[2][2][4][2], const pg8::Unit& u, int wr, int wc, int fr, int fq0) const {
        const int pn = u.pn, pm = u.pm;
        const bool samp = (pm == 64);
        bf16_t* ZAU = (bf16_t*)(ws + WS_ZAU); bf16_t* SGVT = (bf16_t*)(ws + WS_SGVT); bf16_t* ZB = (bf16_t*)(ws + WS_ZB); bf16_t* QB = (bf16_t*)(ws + WS_QB);
        bf16_t* QIB = (bf16_t*)(ws + WS_QIB); float* WI = (float*)(ws + WS_WI);
#pragma unroll
        for (int ai = 0; ai < 2; ++ai)
#pragma unroll
            for (int m = 0; m < 4; ++m) {
                int row = pm * 256 + ai * 128 + wr * 64 + m * 16 + fr, fq = fq0;
                asm volatile("" : "+v"(row), "+v"(fq));
                const float rstd = row_rstd(ss, row);
                int b, t, posidx; const int rs = row - NPR;
                if (!samp) { b = row >> 11; t = row & 2047; posidx = t; } else { b = rs >> 5; t = rs & 31; posidx = 2048 + t; }
                float lo[8], hi[8];
#pragma unroll
                for (int bj = 0; bj < 2; ++bj)
#pragma unroll
                    for (int n = 0; n < 2; ++n)
#pragma unroll
                        for (int jp = 0; jp < 2; ++jp) { lo[4 * bj + 2 * n + jp] = acc[ai][bj][m][n][2 * jp] * rstd; hi[4 * bj + 2 * n + jp] = acc[ai][bj][m][n][2 * jp + 1] * rstd; }
                if (pn == 0) {
#pragma unroll
                    for (int e = 0; e < 8; ++e) { lo[e] = gelu_tanh(lo[e]); hi[e] = gelu_tanh(hi[e]); }
                    bf16_t* d = ZAU + (size_t)row * 256 + 64 * wc + 8 * fq;
                    *(u32x4*)d = pack8(lo); *(u32x4*)(d + 32) = pack8(hi);
                } else if (pn == 1) {
#pragma unroll
                    for (int e = 0; e < 8; ++e) { lo[e] = gelu_tanh(lo[e]); hi[e] = gelu_tanh(hi[e]); }
#pragma unroll
                    for (int e = 0; e < 8; ++e) {
                        SGVT[(size_t)(64 * wc + 8 * fq + e) * MT + row] = f2bf(lo[e]);
                        SGVT[(size_t)(64 * wc + 32 + 8 * fq + e) * MT + row] = f2bf(hi[e]);
                    }
                    if (samp) {
                        float* d = out + O_SGV + ((size_t)layer * NSR + rs) * 256 + 64 * wc + 8 * fq;
                        *(f32x4*)d = (f32x4){lo[0], lo[1], lo[2], lo[3]}; *(f32x4*)(d + 4) = (f32x4){lo[4], lo[5], lo[6], lo[7]};
                        *(f32x4*)(d + 32) = (f32x4){hi[0], hi[1], hi[2], hi[3]}; *(f32x4*)(d + 36) = (f32x4){hi[4], hi[5], hi[6], hi[7]};
                    }
                } else if (pn <= 4) {
                    bf16_t* d = ZB + (size_t)row * 768 + 256 * (pn - 2) + 64 * wc + 8 * fq;
                    *(u32x4*)d = pack8(lo); *(u32x4*)(d + 32) = pack8(hi);
                } else if (pn <= 7) {
                    float sq = 0.f;
#pragma unroll
                    for (int e = 0; e < 8; ++e) sq += lo[e] * lo[e] + hi[e] * hi[e];
                    sq += __shfl_xor(sq, 16); sq += __shfl_xor(sq, 32);
                    const float rh = rsqrtf(sq * (1.0f / 64.0f) + 1e-6f);
                    const float* cs = rope + (size_t)posidx * 64 + 8 * fq;
                    const f32x4 c0 = *(const f32x4*)cs, c1 = *(const f32x4*)(cs + 4), s0 = *(const f32x4*)(cs + 32), s1 = *(const f32x4*)(cs + 36);
                    const float* gp = (pn == 7 ? kg : qg) + layer * 64 + 8 * fq;
                    const f32x4 g0 = *(const f32x4*)gp, g1 = *(const f32x4*)(gp + 4), g2 = *(const f32x4*)(gp + 32), g3 = *(const f32x4*)(gp + 36);
                    float ol[8], oh[8];
#pragma unroll
                    for (int e = 0; e < 8; ++e) {
                        const float co = e < 4 ? c0[e & 3] : c1[e & 3], si = e < 4 ? s0[e & 3] : s1[e & 3];
                        const float a = lo[e] * rh * (e < 4 ? g0[e & 3] : g1[e & 3]), bb = hi[e] * rh * (e < 4 ? g2[e & 3] : g3[e & 3]);
                        ol[e] = a * co - bb * si; oh[e] = bb * co + a * si;
                    }
                    if (pn < 7) {
#pragma unroll
                        for (int e = 0; e < 8; ++e) { ol[e] *= 0.125f * 1.4426950408889634f; oh[e] *= 0.125f * 1.4426950408889634f; }
                        bf16_t* d = QB + (size_t)row * 512 + (4 * (pn - 5) + wc) * 64 + 8 * fq;
                        *(u32x4*)d = pack8(ol); *(u32x4*)(d + 32) = pack8(oh);
                    } else {
                        float* d = samp ? out + O_KS + ((size_t)layer * NSR + rs) * 256 + 64 * wc + 8 * fq : out + O_KP + ((size_t)layer * NPR + row) * 256 + 64 * wc + 8 * fq;
                        *(f32x4*)d = (f32x4){ol[0], ol[1], ol[2], ol[3]}; *(f32x4*)(d + 4) = (f32x4){ol[4], ol[5], ol[6], ol[7]};
                        *(f32x4*)(d + 32) = (f32x4){oh[0], oh[1], oh[2], oh[3]}; *(f32x4*)(d + 36) = (f32x4){oh[4], oh[5], oh[6], oh[7]};
                        if (!samp) {
                            bf16_t* kb = (bf16_t*)(ws + WS_KP) + ((size_t)(b * 4 + wc) * TP + t) * 64 + 8 * fq;
                            *(u32x4*)kb = pack8(ol); *(u32x4*)(kb + 32) = pack8(oh);
                        }
                    }
                } else if (pn == 8) {
                    float* d = samp ? out + O_VS + ((size_t)layer * NSR + rs) * 256 + 64 * wc + 8 * fq : out + O_VP + ((size_t)layer * NPR + row) * 256 + 64 * wc + 8 * fq;
                    *(f32x4*)d = (f32x4){lo[0], lo[1], lo[2], lo[3]}; *(f32x4*)(d + 4) = (f32x4){lo[4], lo[5], lo[6], lo[7]};
                    *(f32x4*)(d + 32) = (f32x4){hi[0], hi[1], hi[2], hi[3]}; *(f32x4*)(d + 36) = (f32x4){hi[4], hi[5], hi[6], hi[7]};
                    if (!samp) {
                        bf16_t* vt = (bf16_t*)(ws + WS_VTP) + (size_t)(b * 4 + wc) * 64 * TPV + t;
#pragma unroll
                        for (int e = 0; e < 8; ++e) { vt[(size_t)(8 * fq + e) * TPV] = f2bf(lo[e]); vt[(size_t)(32 + 8 * fq + e) * TPV] = f2bf(hi[e]); }
                    }
                } else {
                    const float* cs = rope + (size_t)posidx * 64 + 8 * fq;
                    const f32x4 c0 = *(const f32x4*)cs, c1 = *(const f32x4*)(cs + 4), s0 = *(const f32x4*)(cs + 32), s1 = *(const f32x4*)(cs + 36);
                    const float co[4] = {c0[0], c0[2], c1[0], c1[2]}, si[4] = {s0[0], s0[2], s1[0], s1[2]};
                    float ol[8], oh[8];
#pragma unroll
                    for (int e = 0; e < 8; ++e) { ol[e] = lo[e] * co[e & 3] - hi[e] * si[e & 3]; oh[e] = hi[e] * co[e & 3] + lo[e] * si[e & 3]; }
                    if (pn == 9) {
#pragma unroll
                        for (int bj = 0; bj < 2; ++bj) {
                            bf16_t* d = QIB + (size_t)row * 256 + 32 * (2 * wc + bj) + 4 * fq;
                            *(u32x2*)d = (u32x2){pk2(ol[4 * bj], ol[4 * bj + 1]), pk2(ol[4 * bj + 2], ol[4 * bj + 3])};
                            *(u32x2*)(d + 16) = (u32x2){pk2(oh[4 * bj], oh[4 * bj + 1]), pk2(oh[4 * bj + 2], oh[4 * bj + 3])};
                        }
                    } else if (wc == 0) {
                        float* d = samp ? out + O_KIS + ((size_t)layer * NSR + rs) * 32 + 4 * fq : out + O_KIP + ((size_t)layer * NPR + row) * 32 + 4 * fq;
                        *(f32x4*)d = (f32x4){ol[0], ol[1], ol[2], ol[3]}; *(f32x4*)(d + 16) = (f32x4){oh[0], oh[1], oh[2], oh[3]};
                        bf16_t* kb = samp ? (bf16_t*)(ws + WS_KIS + (size_t)layer * SZ_KIS1) + ((size_t)b * LSP + PAST + t) * 32 + 4 * fq
                                          : (bf16_t*)(ws + WS_KIP) + (size_t)row * 32 + 4 * fq;
                        *(u32x2*)kb = (u32x2){pk2(ol[0], ol[1]), pk2(ol[2], ol[3])};
                        *(u32x2*)(kb + 16) = (u32x2){pk2(oh[0], oh[1]), pk2(oh[2], oh[3])};
                        if (fq < 2) *(f32x4*)(WI + (size_t)row * 8 + 4 * fq) = (f32x4){lo[4] * 0.0625f, lo[5] * 0.0625f, lo[6] * 0.0625f, lo[7] * 0.0625f};
                    }
                }
                asm volatile("" ::: "memory");
            }
    }
};

struct EpiRes {
    static constexpr bool PERM = true, AFTER_DRAIN = false;
    float* Y; bf16_t* XB; float* ss; int last; int live;
    __device__ __forceinline__ void operator()(const f32x4 (&acc)[2][2][4][2], const pg8::Unit& u, int wr, int wc, int fr, int fq0) const {
        if (!live) return;
#pragma unroll
        for (int ai = 0; ai < 2; ++ai)
#pragma unroll
            for (int m = 0; m < 4; ++m) {
                int row = u.pm * 256 + ai * 128 + wr * 64 + m * 16 + fr, fq = fq0;
                asm volatile("" : "+v"(row), "+v"(fq));
                float sq = 0.f;
#pragma unroll
                for (int bj = 0; bj < 2; ++bj) {
                    const size_t off = (size_t)row * DM + u.pn * 256 + 128 * bj + 32 * wc + 8 * fq;
                    const u32x4 xb = *(const u32x4*)(XB + off);
                    f32x4 x0 = (f32x4){__uint_as_float(xb[0] << 16), __uint_as_float(xb[0] & 0xffff0000u), __uint_as_float(xb[1] << 16), __uint_as_float(xb[1] & 0xffff0000u)};
                    f32x4 x1 = (f32x4){__uint_as_float(xb[2] << 16), __uint_as_float(xb[2] & 0xffff0000u), __uint_as_float(xb[3] << 16), __uint_as_float(xb[3] & 0xffff0000u)};
                    x0 += acc[ai][bj][m][0]; x1 += acc[ai][bj][m][1];
                    if (last) { *(f32x4*)(Y + off) = x0; *(f32x4*)(Y + off + 4) = x1; }
                    else {
                        *(u32x4*)(XB + off) = (u32x4){pk2(x0[0], x0[1]), pk2(x0[2], x0[3]), pk2(x1[0], x1[1]), pk2(x1[2], x1[3])};
                        sq += ((x0[0] * x0[0] + x0[1] * x0[1]) + (x0[2] * x0[2] + x0[3] * x0[3])) + ((x1[0] * x1[0] + x1[1] * x1[1]) + (x1[2] * x1[2] + x1[3] * x1[3]));
                    }
                }
                if (!last) {
                    sq += __shfl_xor(sq, 16); sq += __shfl_xor(sq, 32);
                    if (fq0 == 0) ss[(size_t)row * 16 + u.pn * 4 + wc] = sq;
                }
                asm volatile("" ::: "memory");
            }
    }
};

struct EpiUp {
    static constexpr bool PERM = true, AFTER_DRAIN = false;
    bf16_t* H; const float* ss;
    __device__ __forceinline__ void operator()(const f32x4 (&acc)[2][2][4][2], const pg8::Unit& u, int wr, int wc, int fr, int fq0) const {
#pragma unroll
        for (int ai = 0; ai < 2; ++ai)
#pragma unroll
            for (int m = 0; m < 4; ++m) {
                int row = u.pm * 256 + ai * 128 + wr * 64 + m * 16 + fr, fq = fq0;
                asm volatile("" : "+v"(row), "+v"(fq));
                const float rstd = row_rstd(ss, row);
#pragma unroll
                for (int bj = 0; bj < 2; ++bj) {
                    const size_t off = (size_t)row * DFF + u.pn * 256 + 128 * bj + 32 * wc + 8 * fq;
                    float v[8];
#pragma unroll
                    for (int j = 0; j < 4; ++j) { const float r0 = fmaxf(acc[ai][bj][m][0][j] * rstd, 0.f), r1 = fmaxf(acc[ai][bj][m][1][j] * rstd, 0.f); v[j] = r0 * r0; v[4 + j] = r1 * r1; }
                    *(u32x4*)(H + off) = pack8(v);
                }
                asm volatile("" ::: "memory");
            }
    }
};

DEV int win_colmap(int cg) {
    const int pn = cg >> 8, r = cg & 255, bj = r >> 7, wc = (r >> 5) & 3, n = (r >> 4) & 1, fq = (r >> 2) & 3, jp = (r >> 1) & 1, s = r & 1;
    int o;
    if (pn < 9) o = 256 * pn + 64 * wc + 32 * s + 8 * fq + 4 * bj + 2 * n + jp;
    else o = 256 * pn + 32 * (2 * wc + bj) + 16 * s + 4 * fq + 2 * n + jp;
    return o < INW ? o : -1;
}
DEV void sincos_acc(float ang, float& c, float& s) {
    const double x = (double)ang, twopi = 6.283185307179586476925287;
    const double k = __builtin_rint(x * (1.0 / twopi));
    const double r = x - k * twopi, r2 = r * r;
    double sp = 1.0, cp = 1.0;
#pragma unroll
    for (int i = 14; i >= 1; --i) { sp = 1.0 - sp * r2 / (double)((2 * i) * (2 * i + 1)); cp = 1.0 - cp * r2 / (double)((2 * i - 1) * (2 * i)); }
    s = (float)(r * sp); c = (float)cp;
}

struct TJob { const float* W; const float* gain; bf16_t* Bt; int N, K, c0, k0, perm; };
DEV TJob tjob_decode(const Params& p, int job) {
    unsigned char* ws = p.ws;
    const int l = job / 3008; int r = job % 3008; TJob j;
    if (r < 704) { j.W = p.w_in + (size_t)l * DM * INW; j.gain = p.g_mix + l * DM; j.Bt = (bf16_t*)(ws + WS_WIN + (size_t)l * SZ_WIN1); j.N = INW; j.K = DM; j.c0 = (r >> 4) * 64; j.k0 = (r & 15) * 64; j.perm = 1; }
    else if (r < 960) { r -= 704; j.W = p.w_out + (size_t)l * DM * DM; j.gain = nullptr; j.Bt = (bf16_t*)(ws + WS_WOUT + (size_t)l * SZ_WOUT1); j.N = DM; j.K = DM; j.c0 = (r >> 4) * 64; j.k0 = (r & 15) * 64; j.perm = 0; }
    else if (r < 1984) { r -= 960; j.W = p.w_up + (size_t)l * DM * DFF; j.gain = p.g_ffn + l * DM; j.Bt = (bf16_t*)(ws + WS_WUP + (size_t)l * SZ_WUP1); j.N = DFF; j.K = DM; j.c0 = (r >> 4) * 64; j.k0 = (r & 15) * 64; j.perm = 0; }
    else { r -= 1984; j.W = p.w_down + (size_t)l * DFF * DM; j.gain = nullptr; j.Bt = (bf16_t*)(ws + WS_WDN + (size_t)l * SZ_WUP1); j.N = DM; j.K = DFF; j.c0 = (r >> 6) * 64; j.k0 = (r & 63) * 64; j.perm = 0; }
    return j;
}
DEV void tjob_load(const TJob& j, float (&v)[8], int tid) {
    if (j.perm) {
#pragma unroll
        for (int it = 0; it < 8; ++it) {
            const int idx = tid + 512 * it, kk = idx >> 6, cc = idx & 63, o = win_colmap(j.c0 + cc);
            v[it] = (o >= 0) ? j.W[(size_t)(j.k0 + kk) * j.N + o] * j.gain[j.k0 + kk] : 0.f;
        }
    } else {
#pragma unroll
        for (int it = 0; it < 2; ++it) {
            const int idx = tid + 512 * it, kk = idx >> 4, c4 = idx & 15;
            const f32x4 x = *(const f32x4*)(j.W + (size_t)(j.k0 + kk) * j.N + j.c0 + 4 * c4);
            const float g = j.gain ? j.gain[j.k0 + kk] : 1.f;
#pragma unroll
            for (int e = 0; e < 4; ++e) v[4 * it + e] = x[e] * g;
        }
    }
}
DEV void tjob_lds(const TJob& j, const float (&v)[8], float* tile, int tid) {
    if (j.perm) {
#pragma unroll
        for (int it = 0; it < 8; ++it) { const int idx = tid + 512 * it; tile[(idx & 63) * 65 + (idx >> 6)] = v[it]; }
    } else {
#pragma unroll
        for (int it = 0; it < 2; ++it) {
            const int idx = tid + 512 * it, kk = idx >> 4, c4 = idx & 15;
#pragma unroll
            for (int e = 0; e < 4; ++e) tile[(4 * c4 + e) * 65 + kk] = v[4 * it + e];
        }
    }
}
DEV void tjob_flush(const TJob& j, const float* tile, int tid) {
    const int cc = tid >> 3, kg = tid & 7;
    float v[8];
#pragma unroll
    for (int i = 0; i < 8; ++i) v[i] = tile[cc * 65 + 8 * kg + i];
    *(u32x4*)(j.Bt + (size_t)(j.c0 + cc) * j.K + j.k0 + 8 * kg) = pack8(v);
}

DEV void transpose_jobs(const Params& p, unsigned char* lds, int j0, int j1, int me, int nblk);
DEV void phase_prologue(const Params& p, unsigned char* lds) {
    const int tid = otid(), lane = tid & 63, G = gridDim.x;
    unsigned char* ws = p.ws;
    {
        bf16_t* XB = (bf16_t*)(ws + WS_XB); float* SS = (float*)(ws + WS_SS);
        for (int row0 = blockIdx.x * 8 + (tid >> 6); row0 < MT; row0 += G * 16) {
            f32x4 v[2][4]; int rows[2];
#pragma unroll
            for (int h = 0; h < 2; ++h) {
                const int row = row0 + h * G * 8; rows[h] = row;
                if (row < MT) {
                    const float* src = row < NPR ? p.x_prompt + (size_t)row * DM : p.x_sample + (size_t)(row - NPR) * DM;
#pragma unroll
                    for (int i = 0; i < 4; ++i) v[h][i] = *(const f32x4*)(src + i * 256 + lane * 4);
                }
            }
#pragma unroll
            for (int h = 0; h < 2; ++h) {
                const int row = rows[h];
                if (row < MT) {
                    bf16_t* xb = XB + (size_t)row * DM;
                    float sq = 0.f;
#pragma unroll
                    for (int i = 0; i < 4; ++i) {
                        const f32x4 x = v[h][i];
                        *(u32x2*)(xb + i * 256 + lane * 4) = (u32x2){pk2(x[0], x[1]), pk2(x[2], x[3])};
                        sq += (x[0] * x[0] + x[1] * x[1]) + (x[2] * x[2] + x[3] * x[3]);
                    }
                    sq = wave_sum(sq);
                    if (lane < 16) SS[(size_t)row * 16 + lane] = lane == 0 ? sq : 0.f;
                }
            }
        }
    }
    const int gtid = blockIdx.x * NTHREADS + tid, gsz = G * NTHREADS;
    {
        float* RT = (float*)(ws + WS_ROPE);
        for (int i = gtid; i < 2080 * 32; i += gsz) {
            const int pi = i >> 5, k = i & 31, pos = pi < 2048 ? pi : PAST + (pi - 2048);
            float c, s; sincos_acc((float)pos * c_invf[k], c, s);
            RT[pi * 64 + k] = c; RT[pi * 64 + 32 + k] = s;
        }
    }
    {
        bf16_t* KIS = (bf16_t*)(ws + WS_KIS);
        for (int i = gtid; i < 2 * 8 * PAST * 4; i += gsz) {
            const int dg = i & 3, key = (i >> 2) & 4095, lb = i >> 14;
            const float* src = p.cache_kidx + ((size_t)lb * PAST + key) * 32 + dg * 8;
            const f32x4 a = *(const f32x4*)src, b = *(const f32x4*)(src + 4);
            *(u32x4*)(KIS + ((size_t)lb * LSP + key) * 32 + dg * 8) = (u32x4){pk2(a[0], a[1]), pk2(a[2], a[3]), pk2(b[0], b[1]), pk2(b[2], b[3])};
        }
    }
    transpose_jobs(p, lds, 0, 6016, blockIdx.x, G);
}
DEV void transpose_jobs(const Params& p, unsigned char* lds, int j0, int j1, int me, int nblk) {
    const int tid = otid();
    {
        float* tile = (float*)lds;
        for (int jb = j0 + me * 4; jb < j1; jb += nblk * 4) {
            float v[4][8];
#pragma unroll
            for (int u = 0; u < 4; ++u) { const TJob j = tjob_decode(p, jb + u); tjob_load(j, v[u], tid); }
#pragma unroll
            for (int u = 0; u < 4; ++u) { const TJob j = tjob_decode(p, jb + u); tjob_lds(j, v[u], tile + u * 4160, tid); }
            __syncthreads();
#pragma unroll
            for (int u = 0; u < 4; ++u) { const TJob j = tjob_decode(p, jb + u); tjob_flush(j, tile + u * 4160, tid); }
            __syncthreads();
        }
    }
}

DEV unsigned sort_key(float f) { const unsigned u = __float_as_uint(f); return (u & 0x80000000u) ? ~u : (u | 0x80000000u); }

DEV int wave_isum(int v) {
    v += __builtin_amdgcn_update_dpp(0, v, 0x111, 0xf, 0xf, true);
    v += __builtin_amdgcn_update_dpp(0, v, 0x112, 0xf, 0xf, true);
    v += __builtin_amdgcn_update_dpp(0, v, 0x114, 0xf, 0xf, true);
    v += __builtin_amdgcn_update_dpp(0, v, 0x118, 0xf, 0xf, true);
    v += __builtin_amdgcn_update_dpp(0, v, 0x142, 0xa, 0xf, false);
    v += __builtin_amdgcn_update_dpp(0, v, 0x143, 0xc, 0xf, false);
    return __builtin_amdgcn_readlane(v, 63);
}
template <int NCH, int NR> DEV void select_rows(const float* rowf, int npad, int nch, u64* bmr, int bmstride, int lane) {
    asm volatile("" : "+s"(nch));
    unsigned kreg[NR][NCH];
#pragma unroll
    for (int r = 0; r < NR; ++r)
#pragma unroll
        for (int c = 0; c < NCH; ++c) {
            const unsigned k = sort_key(rowf[(size_t)r * npad + c * 64 + lane]);
            kreg[r][c] = (c < nch) ? k : 0u;
        }
    unsigned T[NR]; bool done[NR];
#pragma unroll
    for (int r = 0; r < NR; ++r) { T[r] = 0u; done[r] = false; }
    for (int bit = 31; bit >= 0; --bit) {
        unsigned cand[NR]; int cnt[NR];
#pragma unroll
        for (int r = 0; r < NR; ++r) { cand[r] = T[r] | (1u << bit); cnt[r] = 0; }
#pragma unroll
        for (int c = 0; c < NCH; ++c) {
            if ((c & 7) == 0 && c >= nch) break;
#pragma unroll
            for (int r = 0; r < NR; ++r) cnt[r] += (kreg[r][c] >= cand[r]) ? 1 : 0;
        }
        bool alldone = true;
#pragma unroll
        for (int r = 0; r < NR; ++r) {
            const int tot = wave_isum(cnt[r]);
            if (tot >= 256) T[r] = cand[r];
            if (tot == 256) done[r] = true;
            alldone = alldone && done[r];
        }
        if (alldone) break;
    }
#pragma unroll
    for (int r = 0; r < NR; ++r) {
        int cg = 0;
#pragma unroll
        for (int c = 0; c < NCH; ++c) { if ((c & 7) == 0 && c >= nch) break; cg += (kreg[r][c] > T[r]) ? 1 : 0; }
        const int need = 256 - wave_isum(cg);
        int eqbase = 0;
#pragma unroll
        for (int c = 0; c < NCH; ++c) {
            if (c < nch) {
                const unsigned kv = kreg[r][c];
                const bool eq = (kv == T[r]);
                const u64 be = __ballot(eq);
                const int rank = eqbase + __popcll(be & ((1ull << lane) - 1ull));
                const bool sel = (kv > T[r]) || (eq && rank < need);
                const u64 bs = __ballot(sel);
                eqbase += __popcll(be);
                if (lane == 0) bmr[(size_t)r * bmstride + c] = bs;
            }
        }
    }
}

struct IdxItem { int nq, n, row0, bmstride; const bf16_t* KI; u64* BM; };
DEV IdxItem idx_decode(const Params& p, int layer, int item) {
    unsigned char* ws = p.ws; IdxItem I;
    if (item < 32) {
        const int b = item >> 2, qt = item & 3;
        I.nq = 8; I.n = LS; I.row0 = NPR + b * 32 + qt * 8;
        I.KI = (const bf16_t*)(ws + WS_KIS + (size_t)layer * SZ_KIS1) + (size_t)b * LSP * 32;
        I.BM = (u64*)(ws + WS_BMS) + (size_t)(b * 32 + qt * 8) * 72; I.bmstride = 72;
    } else {
        const int i2 = item - 32, c = 31 - (i2 >> 5), w = i2 & 31, b = w >> 2, qt = w & 3;
        I.nq = 16; I.n = 64 * (c + 1); I.row0 = b * TP + 64 * c + 16 * qt;
        I.KI = (const bf16_t*)(ws + WS_KIP) + (size_t)b * TP * 32;
        I.BM = (u64*)(ws + WS_BMP) + (size_t)I.row0 * 32; I.bmstride = 32;
    }
    return I;
}
struct IdxPre { bf16x8 aq[4][2]; bf16x8 nb0, nb1; float wv; };
DEV void idx_prefetch(const Params& p, const IdxItem& I, IdxPre& P, int tid, int lane, int wave) {
    if (I.n <= 256) return;
    unsigned char* ws = p.ws;
    const bf16_t* QI = (const bf16_t*)(ws + WS_QIB); const float* WI = (const float*)(ws + WS_WI);
    P.wv = (tid < I.nq * 8) ? WI[(size_t)I.row0 * 8 + tid] : 0.f;
    const int nqb = I.nq >> 2;
    const int i = lane & 31, a = i >> 3, gi = (i >> 2) & 1, c = i & 3, qin = 2 * gi + (a >> 1), head = 4 * (a & 1) + c;
#pragma unroll
    for (int qb = 0; qb < 4; ++qb)
#pragma unroll
        for (int ks = 0; ks < 2; ++ks) {
            if (qb < nqb) P.aq[qb][ks] = *(const bf16x8*)(QI + (size_t)(I.row0 + 4 * qb + qin) * 256 + head * 32 + 8 * (lane >> 5) + 16 * ks);
            else P.aq[qb][ks] = (bf16x8){0, 0, 0, 0, 0, 0, 0, 0};
        }
    const int g = lane >> 5, nkb = I.n >> 5;
    P.nb0 = (bf16x8){0, 0, 0, 0, 0, 0, 0, 0}; P.nb1 = P.nb0;
    if (wave < nkb) { const bf16_t* kp = I.KI + (size_t)(wave * 32 + (lane & 31)) * 32 + 8 * g; P.nb0 = *(const bf16x8*)kp; P.nb1 = *(const bf16x8*)(kp + 16); }
}
DEV int indexer_item(const Params& p, int layer, int item, unsigned char* lds, const IdxPre& P, int nxt, volatile int* slot, IdxPre& Pn) {
    const int tid = otid(), lane = tid & 63, wave = __builtin_amdgcn_readfirstlane(tid >> 6);
    const IdxItem I = idx_decode(p, layer, item);
    const int nq = I.nq, n = I.n, bmstride = I.bmstride; u64* BM = I.BM; const bf16_t* KI = I.KI;
    const int ntile = (n + 63) >> 6;
    if (n <= 256) {
        if (tid < nq * ntile) BM[(size_t)(tid / ntile) * bmstride + (tid % ntile)] = ~0ull;
        if (tid == 0) slot[1] = nxt;
        __syncthreads();
        const int nx = __builtin_amdgcn_readfirstlane(slot[1]);
        __syncthreads();
        if (nx < 1056) idx_prefetch(p, idx_decode(p, layer, nx), Pn, tid, lane, wave);
        return nx;
    }
    const int npad = ntile * 64;
    float* sc = (float*)lds;
    float* wl = (float*)(lds + 133120);
    if (tid < nq * 8) wl[tid] = P.wv;
    const int nqb = nq >> 2;
    const int g = lane >> 5;
    const int nkb = n >> 5;
    bf16x8 nb0 = P.nb0, nb1 = P.nb1;
    __syncthreads();
    for (int kb = wave; kb < nkb; kb += 8) {
        const int key = kb * 32 + (lane & 31);
        const bf16x8 b0 = nb0, b1 = nb1;
        if (kb + 8 < nkb) { const bf16_t* kp = KI + (size_t)(key + 256) * 32 + 8 * g; nb0 = *(const bf16x8*)kp; nb1 = *(const bf16x8*)(kp + 16); }
#pragma unroll
        for (int qb = 0; qb < 4; ++qb) {
            if (qb < nqb) {
                f32x16 acc;
#pragma unroll
                for (int r = 0; r < 16; ++r) acc[r] = 0.f;
                acc = __builtin_amdgcn_mfma_f32_32x32x16_bf16(P.aq[qb][0], b0, acc, 0, 0, 0);
                acc = __builtin_amdgcn_mfma_f32_32x32x16_bf16(P.aq[qb][1], b1, acc, 0, 0, 0);
#pragma unroll
                for (int qq = 0; qq < 2; ++qq) {
                    const int ql = 4 * qb + 2 * g + qq;
                    const f32x4 w0 = *(const f32x4*)(wl + ql * 8), w1 = *(const f32x4*)(wl + ql * 8 + 4);
                    float s = 0.f;
#pragma unroll
                    for (int h = 0; h < 4; ++h) s = fmaf(w0[h], __builtin_amdgcn_fmed3f(acc[8 * qq + h], 0.f, __builtin_inff()), s);
#pragma unroll
                    for (int h = 0; h < 4; ++h) s = fmaf(w1[h], __builtin_amdgcn_fmed3f(acc[8 * qq + 4 + h], 0.f, __builtin_inff()), s);
                    s = (s == 0.f) ? 0.f : s;
                    sc[(size_t)ql * npad + key] = s;
                }
            }
        }
    }
    if (npad > n && tid < nq * (npad - n)) sc[(size_t)(tid / (npad - n)) * npad + n + tid % (npad - n)] = -__builtin_inff();
    if (tid == 0) slot[1] = nxt;
    __syncthreads();
    const int nx = __builtin_amdgcn_readfirstlane(slot[1]);
    if (nx < 1056) idx_prefetch(p, idx_decode(p, layer, nx), Pn, tid, lane, wave);
    const float* scf = (const float*)lds;
    if (nq == 16) select_rows<32, 2>(scf + (size_t)(2 * wave) * npad, npad, ntile, BM + (size_t)(2 * wave) * bmstride, bmstride, lane);
    else select_rows<65, 1>(scf + (size_t)wave * npad, npad, ntile, BM + (size_t)wave * bmstride, bmstride, lane);
    __syncthreads();
    return nx;
}

DEV void sgate_item(const Params& p, int layer, int item) {
    const int tid = otid(), lane = tid & 63, wave = tid >> 6, fr = lane & 15, quad = lane >> 4;
    unsigned char* ws = p.ws;
    int row0, ni, h;
    if (item < 512) { h = item & 3; row0 = (item >> 2) * 128; ni = 128; } else { const int i2 = item - 512; h = i2 & 3; row0 = NPR + (i2 >> 2) * 32; ni = 32; }
    if (wave * 16 >= ni) return;
    const int ksmax = (ni == 32) ? 1 : (wave < 4 ? 2 : 4);
    const float* W = p.w_s + ((size_t)(layer * 4 + h) * 128 + wave * 16 + fr) * 128;
    const bf16_t* SGVT = (const bf16_t*)(ws + WS_SGVT);
    f32x4 acc[4];
#pragma unroll
    for (int nn = 0; nn < 4; ++nn) acc[nn] = (f32x4){0.f, 0.f, 0.f, 0.f};
    f32x4 a0[4], a1[4]; bf16x8 bfr[4][4];
#pragma unroll
    for (int ks = 0; ks < 4; ++ks)
        if (ks < ksmax) {
            a0[ks] = *(const f32x4*)(W + 32 * ks + 8 * quad); a1[ks] = *(const f32x4*)(W + 32 * ks + 8 * quad + 4);
#pragma unroll
            for (int nn = 0; nn < 4; ++nn) bfr[ks][nn] = *(const bf16x8*)(SGVT + (size_t)(h * 64 + 16 * nn + fr) * MT + row0 + 32 * ks + 8 * quad);
        }
    const bf16_t* ZAU = (const bf16_t*)(ws + WS_ZAU); bf16_t* YMIX = (bf16_t*)(ws + WS_YMIX);
    unsigned short uu[4][4]; float bias[4];
#pragma unroll
    for (int j = 0; j < 4; ++j) {
        const int i = wave * 16 + 4 * quad + j;
        bias[j] = p.b_s[(layer * 4 + h) * 128 + i];
#pragma unroll
        for (int nn = 0; nn < 4; ++nn) uu[j][nn] = ZAU[(size_t)(row0 + i) * 256 + h * 64 + 16 * nn + fr];
    }
#pragma unroll
    for (int ks = 0; ks < 4; ++ks)
        if (ks < ksmax) {
            const u32x4 aw = (u32x4){pk2(a0[ks][0], a0[ks][1]), pk2(a0[ks][2], a0[ks][3]), pk2(a1[ks][0], a1[ks][1]), pk2(a1[ks][2], a1[ks][3])};
            const bf16x8 af = __builtin_bit_cast(bf16x8, aw);
#pragma unroll
            for (int nn = 0; nn < 4; ++nn) acc[nn] = __builtin_amdgcn_mfma_f32_16x16x32_bf16(af, bfr[ks][nn], acc[nn], 0, 0, 0);
        }
#pragma unroll
    for (int j = 0; j < 4; ++j) {
        const int i = wave * 16 + 4 * quad + j;
#pragma unroll
        for (int nn = 0; nn < 4; ++nn) YMIX[(size_t)(row0 + i) * 1024 + h * 64 + 16 * nn + fr] = f2bf(bf2f(uu[j][nn]) * (acc[nn][j] + bias[j]));
    }
}

DEV void conv_one(const Params& p, int layer, const bf16_t* ZB, bf16_t* YMIX, int i) {
    {
        const int row = i >> 5, ch = (i & 31) * 8;
        const bool samp = row >= NPR; const int rs = row - NPR;
        const int b = samp ? (rs >> 5) : (row >> 11), t = samp ? (rs & 31) : (row & 2047), T = samp ? 32 : TP;
        float xc[3][8];
#pragma unroll
        for (int dt = 0; dt < 3; ++dt) {
            const int tt = t - 2 + dt;
            if (tt >= 0) {
                const bf16_t* zr = ZB + (size_t)(row - 2 + dt) * 768 + ch;
                const u32x4 gc = *(const u32x4*)(zr + 256), hi = *(const u32x4*)(zr + 512);
#pragma unroll
                for (int e = 0; e < 4; ++e) {
                    xc[dt][2 * e] = __uint_as_float(gc[e] << 16) * __uint_as_float(hi[e] << 16);
                    xc[dt][2 * e + 1] = __uint_as_float(gc[e] & 0xffff0000u) * __uint_as_float(hi[e] & 0xffff0000u);
                }
            } else if (samp) {
                const float* st = p.state_conv + (((size_t)layer * 8 + b) * 2 + (tt + 2)) * 256 + ch;
                const f32x4 a = *(const f32x4*)st, c = *(const f32x4*)(st + 4);
#pragma unroll
                for (int e = 0; e < 4; ++e) { xc[dt][e] = a[e]; xc[dt][4 + e] = c[e]; }
            } else {
#pragma unroll
                for (int e = 0; e < 8; ++e) xc[dt][e] = 0.f;
            }
        }
        const u32x4 gb = *(const u32x4*)(ZB + (size_t)row * 768 + ch);
        const float* cw = p.conv_w + (size_t)layer * 3 * 256 + ch;
        float y[8];
#pragma unroll
        for (int e = 0; e < 8; ++e) {
            const float gbe = (e & 1) ? __uint_as_float(gb[e >> 1] & 0xffff0000u) : __uint_as_float(gb[e >> 1] << 16);
            y[e] = gbe * (cw[e] * xc[0][e] + cw[256 + e] * xc[1][e] + cw[512 + e] * xc[2][e]);
        }
        *(u32x4*)(YMIX + (size_t)row * 1024 + 256 + ch) = pack8(y);
        if (t >= T - 2) {
            float* d = p.out + (samp ? O_CS : O_CP) + (((size_t)layer * 8 + b) * 2 + (t - (T - 2))) * 256 + ch;
            *(f32x4*)d = (f32x4){xc[2][0], xc[2][1], xc[2][2], xc[2][3]}; *(f32x4*)(d + 4) = (f32x4){xc[2][4], xc[2][5], xc[2][6], xc[2][7]};
        }
    }
}

DEV void phase_mix_a(const Params& p, int layer, unsigned char* lds) {
    {
        const int tid = otid(), lane = tid & 63, wave = __builtin_amdgcn_readfirstlane(tid >> 6);
        unsigned* ctr = (unsigned*)(p.ws + WS_BAR) + 3712 + 64 * layer;
        volatile int* slot = (volatile int*)(lds + LDS_BYTES - 32);
        if (tid == 0) slot[0] = (int)__hip_atomic_fetch_add(ctr, 1u, __ATOMIC_RELAXED, __HIP_MEMORY_SCOPE_AGENT);
        __syncthreads();
        int it = __builtin_amdgcn_readfirstlane(slot[0]);
        IdxPre P;
        if (it < 1056) idx_prefetch(p, idx_decode(p, layer, it), P, tid, lane, wave);
        while (it < 1056 + 544) {
            int nxt = 0;
            if (tid == 0) nxt = (int)__hip_atomic_fetch_add(ctr, 1u, __ATOMIC_RELAXED, __HIP_MEMORY_SCOPE_AGENT);
            if (it < 1056) {
                IdxPre Pn;
                it = indexer_item(p, layer, it, lds, P, nxt, slot, Pn);
                P = Pn;
            } else {
                sgate_item(p, layer, it - 1056);
                if (tid == 0) slot[1] = nxt;
                __syncthreads();
                it = __builtin_amdgcn_readfirstlane(slot[1]);
                __syncthreads();
            }
        }
    }
    unsigned char* ws = p.ws;
    const bf16_t* ZB = (const bf16_t*)(ws + WS_ZB); bf16_t* YMIX = (bf16_t*)(ws + WS_YMIX);
    for (int i = blockIdx.x * NTHREADS + otid(); i < MT * 32; i += gridDim.x * NTHREADS) conv_one(p, layer, ZB, YMIX, i);
}

constexpr int AT_KT = 8192, AT_VT = 9216, AT_BUF = AT_KT + AT_VT, AT_GRP = 2 * AT_BUF;
template <bool SAMPLE> struct AttnRaw { u32x4 k[2]; u32x4 v[2]; };
template <> struct AttnRaw<true> { f32x4 k[2][2]; f32x4 v[2][2]; };
struct AttnSrc { const bf16_t* kb; const bf16_t* vt; const float* ck; const float* cv; const float* nk; const float* nv; };

template <bool SAMPLE> DEV void attn_load(AttnRaw<SAMPLE>& raw, const AttnSrc& S, int kt, int tg) {
#pragma unroll
    for (int r = 0; r < 2; ++r) {
        const int q = tg + 256 * r;
        if constexpr (!SAMPLE) {
            raw.k[r] = *(const u32x4*)(S.kb + (size_t)(kt * 64 + (q >> 3)) * 64 + 8 * (q & 7));
            raw.v[r] = *(const u32x4*)(S.vt + (size_t)(q >> 3) * TPV + kt * 64 + 8 * (q & 7));
        } else {
            {
                const int key = kt * 64 + (q >> 3), g = q & 7;
                if (key < LS) { const float* s = key < PAST ? S.ck + (size_t)key * 256 + 8 * g : S.nk + (size_t)(key - PAST) * 256 + 8 * g; raw.k[r][0] = *(const f32x4*)s; raw.k[r][1] = *(const f32x4*)(s + 4); }
                else { raw.k[r][0] = (f32x4){0.f, 0.f, 0.f, 0.f}; raw.k[r][1] = raw.k[r][0]; }
            }
            {
                const int key = kt * 64 + (q & 63), g = q >> 6;
                if (key < LS) { const float* s = key < PAST ? S.cv + (size_t)key * 256 + 8 * g : S.nv + (size_t)(key - PAST) * 256 + 8 * g; raw.v[r][0] = *(const f32x4*)s; raw.v[r][1] = *(const f32x4*)(s + 4); }
                else { raw.v[r][0] = (f32x4){0.f, 0.f, 0.f, 0.f}; raw.v[r][1] = raw.v[r][0]; }
            }
        }
    }
}
template <bool SAMPLE> DEV void attn_store(const AttnRaw<SAMPLE>& raw, unsigned char* buf, int tg) {
#pragma unroll
    for (int r = 0; r < 2; ++r) {
        const int q = tg + 256 * r, row = q >> 3, g = q & 7;
        unsigned char* kd = buf + row * 128 + ((g ^ ((row >> 1) & 7)) << 4);
        if constexpr (!SAMPLE) {
            *(u32x4*)kd = raw.k[r];
            *(u32x4*)(buf + AT_KT + row * 144 + 16 * g) = raw.v[r];
        } else {
            *(u32x4*)kd = (u32x4){pk2(raw.k[r][0][0], raw.k[r][0][1]), pk2(raw.k[r][0][2], raw.k[r][0][3]), pk2(raw.k[r][1][0], raw.k[r][1][1]), pk2(raw.k[r][1][2], raw.k[r][1][3])};
            const int kl = q & 63, gv = q >> 6;
            bf16_t* vd = (bf16_t*)(buf + AT_KT + (8 * gv) * 144) + kl;
#pragma unroll
            for (int e = 0; e < 4; ++e) { vd[e * 72] = f2bf(raw.v[r][0][e]); vd[(4 + e) * 72] = f2bf(raw.v[r][1][e]); }
        }
    }
}
template <int NG> DEV void attn_tile(const unsigned char* buf, const bf16x8 (&qf)[NG][2], u64 mw, float c1, float c2, f32x4 (&o)[NG][4], float (&lsum)[NG], int fr, int quad) {
    const u64 mq = mw >> (4 * quad);
    const int mlo = (int)(unsigned)mq, mhi = (int)(unsigned)(mq >> 32);
    const unsigned nb = __float_as_uint(-c2);
    f32x4 zi[4];
#pragma unroll
    for (int t = 0; t < 4; ++t)
#pragma unroll
        for (int j = 0; j < 4; ++j) {
            const unsigned m = (unsigned)__builtin_amdgcn_sbfe(t < 2 ? mlo : mhi, 16 * (t & 1) + j, 1);
            zi[t][j] = __uint_as_float((m & nb) | (~m & 0xf149f2cau));
        }
    f32x4 st[NG][4];
#pragma unroll
    for (int t = 0; t < 4; ++t) {
        const int row = 16 * t + fr, sw = (row >> 1) & 7;
        const bf16x8 k0 = *(const bf16x8*)(buf + row * 128 + ((quad ^ sw) << 4)), k1 = *(const bf16x8*)(buf + row * 128 + (((quad + 4) ^ sw) << 4));
#pragma unroll
        for (int g = 0; g < NG; ++g) {
            const f32x4 z = __builtin_amdgcn_mfma_f32_16x16x32_bf16(k0, qf[g][0], zi[t], 0, 0, 0);
            st[g][t] = __builtin_amdgcn_mfma_f32_16x16x32_bf16(k1, qf[g][1], z, 0, 0, 0);
        }
    }
    u32x4 pw[NG][2];
#pragma unroll
    for (int g = 0; g < NG; ++g) {
#pragma unroll
        for (int t = 0; t < 4; ++t)
#pragma unroll
            for (int j = 0; j < 4; ++j) {
                const float pv = __builtin_amdgcn_exp2f(st[g][t][j]);
                st[g][t][j] = pv; lsum[g] += pv;
            }
#pragma unroll
        for (int i = 0; i < 2; ++i)
            pw[g][i] = (u32x4){pk2(st[g][2 * i][0], st[g][2 * i][1]), pk2(st[g][2 * i][2], st[g][2 * i][3]), pk2(st[g][2 * i + 1][0], st[g][2 * i + 1][1]), pk2(st[g][2 * i + 1][2], st[g][2 * i + 1][3])};
    }
#pragma unroll
    for (int i = 0; i < 2; ++i)
#pragma unroll
        for (int nn = 0; nn < 4; ++nn) {
            const unsigned char* vr = buf + AT_KT + (16 * nn + fr) * 144 + 64 * i + 8 * quad;
            const u32x2 v0 = *(const u32x2*)vr, v1 = *(const u32x2*)(vr + 32);
            const bf16x8 vb = __builtin_bit_cast(bf16x8, (u32x4){v0.x, v0.y, v1.x, v1.y});
#pragma unroll
            for (int g = 0; g < NG; ++g) o[g][nn] = __builtin_amdgcn_mfma_f32_16x16x32_bf16(__builtin_bit_cast(bf16x8, pw[g][i]), vb, o[g][nn], 0, 0, 0);
        }
}
template <bool SAMPLE, int NG> DEV void attn_stream(const AttnSrc& S, const bf16_t* Qrow, const u64* bmrow, int kt0, int kt1, int nsteps, unsigned char* glds, int tg, int lane, float c1, float c2, f32x4 (&o)[NG][4], float (&lsum)[NG]) {
    const int fr = lane & 15, quad = lane >> 4;
    bf16x8 qf[NG][2];
#pragma unroll
    for (int g = 0; g < NG; ++g) { qf[g][0] = *(const bf16x8*)(Qrow + 64 * g + 8 * quad); qf[g][1] = *(const bf16x8*)(Qrow + 64 * g + 32 + 8 * quad); }
    const int klast = kt1 - 1;
    AttnRaw<SAMPLE> rawA, rawB;
    attn_load<SAMPLE>(rawA, S, kt0, tg);
    u64 mwn = bmrow[kt0];
    attn_store<SAMPLE>(rawA, glds, tg);
    attn_load<SAMPLE>(rawA, S, min(kt0 + 1, klast), tg);
    __syncthreads();
    for (int s = 0; s < nsteps; s += 2) {
        {
            const u64 mw = mwn;
            attn_load<SAMPLE>(rawB, S, min(kt0 + s + 2, klast), tg);
            mwn = (kt0 + s + 1 < kt1) ? bmrow[kt0 + s + 1] : 0ull;
            attn_tile<NG>(glds, qf, mw, c1, c2, o, lsum, fr, quad);
            attn_store<SAMPLE>(rawA, glds + AT_BUF, tg);
            __syncthreads();
        }
        if (s + 1 < nsteps) {
            const u64 mw = mwn;
            attn_load<SAMPLE>(rawA, S, min(kt0 + s + 3, klast), tg);
            mwn = (kt0 + s + 2 < kt1) ? bmrow[kt0 + s + 2] : 0ull;
            attn_tile<NG>(glds + AT_BUF, qf, mw, c1, c2, o, lsum, fr, quad);
            attn_store<SAMPLE>(rawB, glds, tg);
            __syncthreads();
        }
    }
}
template <int NG> DEV void attn_finish(bf16_t* YMIX, int rowq, int head0, f32x4 (&o)[NG][4], float (&lsum)[NG], int lane) {
    const int fr = lane & 15, quad = lane >> 4;
#pragma unroll
    for (int g = 0; g < NG; ++g) {
        float ls = lsum[g];
        ls += __shfl_xor(ls, 16); ls += __shfl_xor(ls, 32);
#pragma unroll
        for (int j = 0; j < 4; ++j) {
            const float l = __shfl(ls, 4 * quad + j);
            const float inv = 1.0f / l;
#pragma unroll
            for (int nn = 0; nn < 4; ++nn) YMIX[(size_t)(rowq + 4 * quad + j) * 1024 + 512 + (head0 + g) * 64 + 16 * nn + fr] = f2bf(o[g][nn][j] * inv);
        }
    }
}
DEV void attn_prompt_item(const Params& p, int idx, float c1, float c2, unsigned char* lds) {
    const int tid = otid(), lane = tid & 63, wave = tid >> 6, fr = lane & 15, grp = wave >> 2, wg = wave & 3;
    unsigned char* ws = p.ws;
    const int c = 31 - (idx >> 4), r = idx & 15, b = r >> 1, hk = 2 * (r & 1) + grp;
    const int rowq = b * TP + 64 * c + 16 * wg;
    f32x4 o[2][4];
#pragma unroll
    for (int g = 0; g < 2; ++g)
#pragma unroll
        for (int nn = 0; nn < 4; ++nn) o[g][nn] = (f32x4){0.f, 0.f, 0.f, 0.f};
    float lsum[2] = {0.f, 0.f};
    AttnSrc S{};
    S.kb = (const bf16_t*)(ws + WS_KP) + (size_t)(b * 4 + hk) * TP * 64;
    S.vt = (const bf16_t*)(ws + WS_VTP) + (size_t)(b * 4 + hk) * 64 * TPV;
    const u64* bm = (const u64*)(ws + WS_BMP) + (size_t)(rowq + fr) * 32;
    attn_stream<false, 2>(S, (const bf16_t*)(ws + WS_QB) + (size_t)(rowq + fr) * 512 + 2 * hk * 64, bm, 0, c + 1, c + 1, lds + grp * AT_GRP, tid & 255, lane, c1, c2, o, lsum);
    attn_finish<2>((bf16_t*)(ws + WS_YMIX), rowq, 2 * hk, o, lsum, lane);
}
DEV void attn_sample_item(const Params& p, int layer, int item, float c1, float c2, unsigned char* lds) {
    const int tid = otid(), lane = tid & 63, wave = tid >> 6, fr = lane & 15, quad = lane >> 4, grp = wave >> 2, wg = wave & 3;
    unsigned char* ws = p.ws;
    const int qt = item & 3, bh = item >> 2, b = bh >> 2, hk = bh & 3, head = 2 * hk + (wg >> 1);
    const int rowq = NPR + b * 32 + 16 * (wg & 1);
    const int t0 = (qt == 0) ? 0 : 1 + 16 * qt, t1 = 17 + 16 * qt;
    const int tm = t0 + ((t1 - t0 + 1) >> 1), nsteps = tm - t0;
    f32x4 o[1][4];
#pragma unroll
    for (int nn = 0; nn < 4; ++nn) o[0][nn] = (f32x4){0.f, 0.f, 0.f, 0.f};
    float lsum[1] = {0.f};
    AttnSrc S{};
    S.ck = p.cache_k + (size_t)(layer * 8 + b) * PAST * 256 + hk * 64; S.cv = p.cache_v + (size_t)(layer * 8 + b) * PAST * 256 + hk * 64;
    S.nk = p.out + O_KS + (size_t)(layer * NSR + b * 32) * 256 + hk * 64; S.nv = p.out + O_VS + (size_t)(layer * NSR + b * 32) * 256 + hk * 64;
    const u64* bm = (const u64*)(ws + WS_BMS) + (size_t)(b * 32 + 16 * (wg & 1) + fr) * 72;
    attn_stream<true, 1>(S, (const bf16_t*)(ws + WS_QB) + (size_t)(rowq + fr) * 512 + head * 64, bm, grp ? tm : t0, grp ? t1 : tm, nsteps, lds + grp * AT_GRP, tid & 255, lane, c1, c2, o, lsum);
    float* xo = (float*)lds;
    if (grp) {
        float* d = xo + ((size_t)wg * 64 + lane) * 17;
#pragma unroll
        for (int nn = 0; nn < 4; ++nn)
#pragma unroll
            for (int j = 0; j < 4; ++j) d[nn * 4 + j] = o[0][nn][j];
        d[16] = lsum[0];
    }
    __syncthreads();
    if (!grp) {
        const float* d = xo + ((size_t)wg * 64 + lane) * 17;
#pragma unroll
        for (int nn = 0; nn < 4; ++nn)
#pragma unroll
            for (int j = 0; j < 4; ++j) o[0][nn][j] += d[nn * 4 + j];
        float ls = lsum[0] + d[16];
        ls += __shfl_xor(ls, 16); ls += __shfl_xor(ls, 32);
        float* PO = (float*)(ws + WS_PART) + ((size_t)(bh * 4 + qt) * 64 + wg * 16) * 64;
        float* PL = (float*)(ws + WS_PART + SZ_PARTO) + (size_t)(bh * 4 + qt) * 64 + wg * 16;
#pragma unroll
        for (int j = 0; j < 4; ++j)
#pragma unroll
            for (int nn = 0; nn < 4; ++nn) PO[(size_t)(4 * quad + j) * 64 + 16 * nn + fr] = o[0][nn][j];
        if (quad == 0) PL[fr] = ls;
    }
    __syncthreads();
}
DEV void attn_sample_combine(const Params& p) {
    unsigned char* ws = p.ws;
    const float* PO = (const float*)(ws + WS_PART); const float* PL = (const float*)(ws + WS_PART + SZ_PARTO);
    bf16_t* YMIX = (bf16_t*)(ws + WS_YMIX);
    for (int i = blockIdx.x * NTHREADS + otid(); i < 8 * 4 * 64 * 16; i += gridDim.x * NTHREADS) {
        const int d4 = i & 15, pr = (i >> 4) & 63, bh = i >> 10, b = bh >> 2, hk = bh & 3;
        f32x4 acc = (f32x4){0.f, 0.f, 0.f, 0.f}; float l = 0.f;
#pragma unroll
        for (int q = 0; q < 4; ++q) { acc += *(const f32x4*)(PO + ((size_t)(bh * 4 + q) * 64 + pr) * 64 + 4 * d4); l += PL[(size_t)(bh * 4 + q) * 64 + pr]; }
        const float inv = 1.0f / l;
        const int wg = pr >> 4, qi = 16 * (wg & 1) + (pr & 15), head = 2 * hk + (wg >> 1);
        *(u32x2*)(YMIX + (size_t)(NPR + b * 32 + qi) * 1024 + 512 + head * 64 + 4 * d4) = (u32x2){pk2(acc[0] * inv, acc[1] * inv), pk2(acc[2] * inv, acc[3] * inv)};
    }
}

DEV void phase_attn(const Params& p, int layer, unsigned char* lds) {
    const int tid = otid(), lane = tid & 63;
    const float gq = wave_max(fabsf(p.q_gain[layer * 64 + lane])), gk = wave_max(fabsf(p.k_gain[layer * 64 + lane]));
    const float bound = 8.0f * gq * gk * 1.02f;
    const float c1 = 0.125f * 1.4426950408889634f, c2 = bound * 1.4426950408889634f;
    unsigned* ctr = (unsigned*)(p.ws + WS_BAR) + 3584 + 64 * layer;
    volatile int* slot = (volatile int*)(lds + LDS_BYTES - 32);
    for (;;) {
        if (tid == 0) *slot = (int)__hip_atomic_fetch_add(ctr, 1u, __ATOMIC_RELAXED, __HIP_MEMORY_SCOPE_AGENT);
        __syncthreads();
        const int it = __builtin_amdgcn_readfirstlane(*slot);
        __syncthreads();
        if (it >= 640) break;
        if (it < 128) attn_sample_item(p, layer, it, c1, c2, lds);
        else attn_prompt_item(p, it - 128, c1, c2, lds);
    }
}

template <int NT, int CH> DEV void mini_mma(const bf16_t* A, int lda, const bf16_t* Bt, int ldb, int r0, int c0, int k0, int k1, f32x4 (&acc)[NT], int lane) {
    const int fr = lane & 15, quad = lane >> 4;
    const bf16_t* ap = A + (size_t)(r0 + fr) * lda + 8 * quad;
    const bf16_t* bp = Bt + (size_t)(c0 + fr) * ldb + 8 * quad;
    for (int k = k0; k < k1; k += 32 * CH) {
        bf16x8 a[CH], b[NT][CH];
#pragma unroll
        for (int i = 0; i < CH; ++i) {
            a[i] = *(const bf16x8*)(ap + k + 32 * i);
#pragma unroll
            for (int nt = 0; nt < NT; ++nt) b[nt][i] = *(const bf16x8*)(bp + (size_t)16 * nt * ldb + k + 32 * i);
        }
#pragma unroll
        for (int i = 0; i < CH; ++i)
#pragma unroll
            for (int nt = 0; nt < NT; ++nt) acc[nt] = __builtin_amdgcn_mfma_f32_16x16x32_bf16(a[i], b[nt][i], acc[nt], 0, 0, 0);
    }
}
DEV void mini_res(const bf16_t* A, const bf16_t* Bt, int K, float* Y, bf16_t* XB, float* SS, unsigned char* lds, int last, int live) {
    const int tid = otid(), lane = tid & 63, wave = tid >> 6, fr = lane & 15, quad = lane >> 4;
    float* part = (float*)lds;
    float* tile = (float*)(lds + 8 * 64 * 17 * 4);
    for (int t = blockIdx.x; t < 256; t += gridDim.x) {
        const int r0 = NPR + 16 * (t >> 4), ct = t & 15, c0 = 64 * ct, kw = K >> 3;
        f32x4 acc[4];
#pragma unroll
        for (int nt = 0; nt < 4; ++nt) acc[nt] = (f32x4){0.f, 0.f, 0.f, 0.f};
        if (K == DFF) mini_mma<4, 8>(A, K, Bt, K, r0, c0, wave * kw, (wave + 1) * kw, acc, lane);
        else mini_mma<4, 4>(A, K, Bt, K, r0, c0, wave * kw, (wave + 1) * kw, acc, lane);
        float* d = part + ((size_t)wave * 64 + lane) * 17;
#pragma unroll
        for (int nt = 0; nt < 4; ++nt)
#pragma unroll
            for (int j = 0; j < 4; ++j) d[nt * 4 + j] = acc[nt][j];
        __syncthreads();
#pragma unroll
        for (int vv = 0; vv < 2; ++vv) {
            const int v = 2 * wave + vv, nt = v >> 2, j = v & 3;
            float s = 0.f;
#pragma unroll
            for (int w2 = 0; w2 < 8; ++w2) s += part[((size_t)w2 * 64 + lane) * 17 + v];
            const int rl = 4 * quad + j, cl = 16 * nt + fr;
            const size_t off = (size_t)(r0 + rl) * DM + c0 + cl;
            const float xn = bf2f(XB[off]) + s;
            if (live) { if (last) Y[off] = xn; else XB[off] = f2bf(xn); } tile[rl * 65 + cl] = xn;
        }
        __syncthreads();
        if (tid < 16) {
            float sq = 0.f;
            for (int c = 0; c < 64; ++c) { const float v = tile[tid * 65 + c]; sq += v * v; }
            if (live && !last) SS[(size_t)(r0 + tid) * 16 + ct] = sq;
        }
        __syncthreads();
    }
}
DEV void mini_up(const bf16_t* XB, const bf16_t* Bt, const float* SS, bf16_t* H) {
    const int tid = otid(), lane = tid & 63, wave = tid >> 6, fr = lane & 15, quad = lane >> 4;
    for (int t = blockIdx.x; t < 256; t += gridDim.x) {
        const int r0 = NPR + 16 * (t >> 4), c0 = 256 * (t & 15) + 32 * wave;
        f32x4 acc[2];
        acc[0] = (f32x4){0.f, 0.f, 0.f, 0.f}; acc[1] = acc[0];
        mini_mma<2, 16>(XB, DM, Bt, DM, r0, c0, 0, DM, acc, lane);
#pragma unroll
        for (int j = 0; j < 4; ++j) {
            const int row = r0 + 4 * quad + j;
            const float rstd = row_rstd(SS, row);
#pragma unroll
            for (int nt = 0; nt < 2; ++nt) { const float r = fmaxf(acc[nt][j] * rstd, 0.f); H[(size_t)row * DFF + c0 + 16 * nt + fr] = f2bf(r * r); }
        }
    }
}

__global__ void __launch_bounds__(NTHREADS) hybrid_fwd(Params p) {
    extern __shared__ __attribute__((aligned(16))) unsigned char lds[];
    cg::grid_group grid = cg::this_grid();
    PG8_LAS unsigned char* l3 = (PG8_LAS unsigned char*)lds;
    unsigned char* ws = p.ws;
    bf16_t* XB = (bf16_t*)(ws + WS_XB); float* SS = (float*)(ws + WS_SS);
    if (threadIdx.x < 4) ((LAS unsigned*)(l3 + LDS_BYTES - 16))[threadIdx.x] = 0u;
    __syncthreads();
    const XcdBarrier bar = xcd_barrier_post((unsigned*)(ws + WS_BAR), (volatile LAS unsigned*)(l3 + LDS_BYTES - 16));
    for (int ph = p.ph_lo; ph < p.ph_hi; ++ph) {
        if (ph > p.ph_lo) {
            if (p.ph_hi > 64) grid.sync();
            xcd_barrier(bar);
        }
#ifdef PROBE_DUP
        const int nrep = (ph == 0) ? ((PROBE_DUP >> 0) & 1) + 1 : (((PROBE_DUP >> (1 + (ph - 1) % 6)) & 1) + 1);
        for (int rep = 0; rep < nrep; ++rep) {
        if (rep) __syncthreads();
        if (rep && ph > 0 && (ph - 1) % 6 == 2) {
            xcd_barrier(bar);
            if (blockIdx.x == 0 && threadIdx.x == 0) __hip_atomic_store((unsigned*)(ws + WS_BAR) + 3584 + 64 * ((ph - 1) / 6), 0u, __ATOMIC_RELAXED, __HIP_MEMORY_SCOPE_AGENT);
            xcd_barrier(bar);
        }
        const int live = (rep == nrep - 1);
#else
        const int live = 1;
#endif
        if (ph == 0) {
#ifndef NO_P0
            phase_prologue(p, lds);
#endif
            continue; }
        const int l = (ph - 1) / 6, s = (ph - 1) % 6;
        if (s == 0) {
#ifndef NO_S0
            pg8::Gemm g{XB, (const bf16_t*)(ws + WS_WIN + (size_t)l * SZ_WIN1), MT, INWP, DM};
            pg8::StaticOrder S; S.init(MT, INWP, (int)gridDim.x, (int)blockIdx.x);
            EpiIn E{SS, (const float*)(ws + WS_ROPE), p.q_gain, p.k_gain, p.out, ws, l};
            pg8::gemm_phase<EpiIn, pg8::StaticOrder>(l3, g, S, E, nullptr);
#endif
        } else if (s == 1) {
#ifndef NO_S1
            phase_mix_a(p, l, lds);
#endif
        } else if (s == 2) {
#ifndef NO_S2
            phase_attn(p, l, lds);
            xcd_barrier(bar);
            attn_sample_combine(p);
#endif
        } else if (s == 3) {
#ifndef NO_S3
            mini_res((const bf16_t*)(ws + WS_YMIX), (const bf16_t*)(ws + WS_WOUT + (size_t)l * SZ_WOUT1), DM, p.out, XB, SS, lds, 0, live);
            pg8::Gemm g{(const bf16_t*)(ws + WS_YMIX), (const bf16_t*)(ws + WS_WOUT + (size_t)l * SZ_WOUT1), NPR, DM, DM};
            pg8::StaticOrder S; S.init(NPR, DM, (int)gridDim.x, (int)blockIdx.x);
            EpiRes E{p.out, XB, SS, 0, live};
            pg8::gemm_phase<EpiRes, pg8::StaticOrder>(l3, g, S, E, nullptr);
#endif
        } else if (s == 4) {
#ifndef NO_S4
            mini_up(XB, (const bf16_t*)(ws + WS_WUP + (size_t)l * SZ_WUP1), SS, (bf16_t*)(ws + WS_H));
            __syncthreads();
            pg8::Gemm g{XB, (const bf16_t*)(ws + WS_WUP + (size_t)l * SZ_WUP1), NPR, DFF, DM};
            pg8::StaticOrder S; S.init(NPR, DFF, (int)gridDim.x, (int)blockIdx.x);
            EpiUp E{(bf16_t*)(ws + WS_H), SS};
            pg8::gemm_phase<EpiUp, pg8::StaticOrder>(l3, g, S, E, nullptr);
#endif
        } else {
#ifndef NO_S5
            mini_res((const bf16_t*)(ws + WS_H), (const bf16_t*)(ws + WS_WDN + (size_t)l * SZ_WUP1), DFF, p.out, XB, SS, lds, l == 1, live);
            pg8::Gemm g{(const bf16_t*)(ws + WS_H), (const bf16_t*)(ws + WS_WDN + (size_t)l * SZ_WUP1), NPR, DM, DFF};
            pg8::StaticOrder S; S.init(NPR, DM, (int)gridDim.x, (int)blockIdx.x);
            EpiRes E{p.out, XB, SS, l == 1, live};
            pg8::gemm_phase<EpiRes, pg8::StaticOrder>(l3, g, S, E, nullptr);
#endif
        }
#ifdef PROBE_DUP
        }
#endif
    }
}

extern "C" void kernel_launch(void* const* d_in, const int* in_sizes, int n_in, void* d_out, int out_size, void* d_ws, size_t ws_size, hipStream_t stream) {
    static int grid = 0;
    if (grid == 0) {
        if (n_in != 17 || out_size != 35291136 || ws_size < WS_END) { fprintf(stderr, "kernel_launch: unexpected shapes (n_in %d, out %d, ws %zu, need %zu)\n", n_in, out_size, ws_size, (size_t)WS_END); grid = -1; return; }
        int dev = 0, cus = 0, per_cu = 0;
        hipGetDevice(&dev);
        hipDeviceGetAttribute(&cus, hipDeviceAttributeMultiprocessorCount, dev);
        if (hipFuncSetAttribute((const void*)hybrid_fwd, hipFuncAttributeMaxDynamicSharedMemorySize, LDS_BYTES) != hipSuccess) { fprintf(stderr, "kernel_launch: hipFuncSetAttribute failed\n"); grid = -1; return; }
        if (hipOccupancyMaxActiveBlocksPerMultiprocessor(&per_cu, (const void*)hybrid_fwd, NTHREADS, LDS_BYTES) != hipSuccess || per_cu < 1) { fprintf(stderr, "kernel_launch: occupancy query says %d blocks per CU\n", per_cu); grid = -1; return; }
        grid = cus;
        if (per_cu * cus < grid) grid = per_cu * cus;
    }
    if (grid < 0) return;
    Params p{};
    p.x_prompt = (const float*)d_in[0]; p.x_sample = (const float*)d_in[1]; p.cache_k = (const float*)d_in[2]; p.cache_v = (const float*)d_in[3];
    p.cache_kidx = (const float*)d_in[4]; p.state_conv = (const float*)d_in[5]; p.g_mix = (const float*)d_in[6]; p.w_in = (const float*)d_in[7];
    p.q_gain = (const float*)d_in[8]; p.k_gain = (const float*)d_in[9]; p.w_s = (const float*)d_in[10]; p.b_s = (const float*)d_in[11];
    p.conv_w = (const float*)d_in[12]; p.w_out = (const float*)d_in[13]; p.g_ffn = (const float*)d_in[14]; p.w_up = (const float*)d_in[15]; p.w_down = (const float*)d_in[16];
    p.out = (float*)d_out; p.ws = (unsigned char*)d_ws;
    if (hipMemsetAsync((unsigned char*)d_ws + WS_BAR, 0, 16384, stream) != hipSuccess) { fprintf(stderr, "kernel_launch: memset of the barrier words failed\n"); return; }
#if N_LAUNCH_MODE == 1
    p.ph_lo = 0; p.ph_hi = 13;
    void* args[] = {&p};
    hipError_t e = hipLaunchCooperativeKernel((const void*)hybrid_fwd, dim3(grid), dim3(NTHREADS), args, LDS_BYTES, stream);
    if (e != hipSuccess) fprintf(stderr, "kernel_launch: cooperative launch failed: %s (grid %d)\n", hipGetErrorString(e), grid);
#else
    for (int ph = 0; ph < 13; ++ph) {
        p.ph_lo = ph; p.ph_hi = ph + 1;
        hipLaunchKernelGGL(hybrid_fwd, dim3(grid), dim3(NTHREADS), LDS_BYTES, stream, p);
    }
#endif
}
```

```cpp
#include <hip/hip_runtime.h>
#include <hip/hip_cooperative_groups.h>
#include <cstdio>
namespace cg = cooperative_groups;
#ifndef N_LAUNCH_MODE
#define N_LAUNCH_MODE 1
#endif
__device__ __forceinline__ int otid() { int t = (int)threadIdx.x; asm volatile("" : "+v"(t)); return t; }

namespace pg8 {
#define PG8_LAS __attribute__((address_space(3)))
typedef unsigned short bf16_t;
typedef short bf16x8 __attribute__((ext_vector_type(8)));
typedef float f32x4 __attribute__((ext_vector_type(4)));
typedef unsigned u32x4 __attribute__((ext_vector_type(4)));
constexpr int BM = 256, BK = 64, HALF = 128, HTB = HALF * BK * 2  , STAGE_BYTES = 8 * HTB, NXCD = 8, WGM = 8;

__host__ __device__ __forceinline__ int lds_byte(int r, int c) { const int st = (r >> 4) * 2 + (c >> 5), rr = r & 15, cc = c & 31, ob = rr * 64 + cc * 2; return st * 1024 + (ob ^ (((ob >> 9) & 1) << 5)); }
__host__ __device__ __forceinline__ void stage_rc(int b, int& R, int& C) { const int st = b / 1024, sb = b % 1024, swz = sb ^ (((sb >> 9) & 1) << 5); R = (st >> 1) * 16 + swz / 64; C = (st & 1) * 32 + (swz % 64) / 2; }
__host__ __device__ __forceinline__ int perm32(int rho) { const int n = rho >> 4, i = rho & 15; return 8 * (i >> 2) + 4 * n + (i & 3); }

struct Unit { int pm, pn; };
struct Gemm { const bf16_t* A; const bf16_t* Bt; int M, N, K; };

struct StaticOrder {
    int nM, nN, nwg, G, c;
    __host__ __device__ void init(int M, int N, int G_, int c_) { nM = M / BM; nN = N / BM; nwg = nM * nN; G = G_; c = c_; }
    __host__ __device__ bool next(int i, Unit& u) const {
        const long L = (long)i * G + c; if (L >= nwg) return false;
        int wgid = (int)L; { const int q = nwg / NXCD, r = nwg % NXCD, xcd = wgid % NXCD, off = wgid / NXCD; wgid = (xcd < r ? xcd * (q + 1) : r * (q + 1) + (xcd - r) * q) + off; }
        const int nig = WGM * nN, gid = wgid / nig, fm = gid * WGM, gsz = (nM - fm) < WGM ? (nM - fm) : WGM;
        u.pm = fm + ((wgid % nig) % gsz); u.pn = (wgid % nig) / gsz; return true;
    }
    __device__ __forceinline__ void a_ready(const Unit&) const {}
    __device__ __forceinline__ void done(const Unit&) const {}
};
template <class Epi, class Sched, bool STAMP = false>
__device__ __forceinline__ void gemm_phase(PG8_LAS unsigned char* lds, const Gemm g, const Sched& S, const Epi& E, unsigned long long* stamps) {
    const int tid = otid(), wid = __builtin_amdgcn_readfirstlane(tid >> 6), lane = tid & 63, wr = wid >> 2, wc = wid & 3, fr = lane & 15, fq = lane >> 4;
    const int K = g.K, nt = K / BK;
    int ts_lo = 0, ts_hi = 0, nts = 0; const unsigned long long rt_entry = STAMP ? (unsigned long long)wall_clock64() : 0ull;
#define PG8_STAMP() do { if (STAMP && wid == 0 && nts < 64) { const unsigned long long _c = (unsigned long long)clock64(); \
        ts_lo = (lane == nts) ? (int)(unsigned)_c : ts_lo; ts_hi = (lane == nts) ? (int)(unsigned)(_c >> 32) : ts_hi; ++nts; } } while (0)
    PG8_STAMP();
    unsigned voffA[2], voffB[2];
#pragma unroll
    for (int i = 0; i < 2; ++i) { int R, C; stage_rc(tid * 16 + i * 8192, R, C); const int Rb = Epi::PERM ? ((R & ~31) + perm32(R & 31)) : R;
        voffA[i] = (unsigned)(R * K + C) * 2u; voffB[i] = (unsigned)(Rb * K + C) * 2u; }
    const size_t kstep = (size_t)(BK * 2);
    const size_t hstep = (size_t)HALF * K * 2;
    const size_t tstep = 2 * hstep;
    const unsigned ldsw = (unsigned)wid * 1024u;
    const int aoff = lds_byte(wr * 64 + fr, fq * 8), boff = lds_byte(wc * 32 + fr, fq * 8);
#define PG8_SA(b, h) (((b) * 2 + (h)) * HTB)
#define PG8_SB(b, h) ((4 + (b) * 2 + (h)) * HTB)
#define PG8_STAGE(bufoff, gbase, voff) do { _Pragma("unroll") for (int _i = 0; _i < 2; ++_i) \
        __builtin_amdgcn_global_load_lds((const unsigned*)((const char*)(gbase) + (voff)[_i]), (PG8_LAS unsigned*)(lds + (bufoff) + ldsw + _i * 8192), 16, 0, 0); } while (0)
#define PG8_LDA(dst, b, h) do { _Pragma("unroll") for (int m = 0; m < 4; ++m) _Pragma("unroll") for (int k = 0; k < 2; ++k) dst[m][k] = *(const PG8_LAS bf16x8*)(lds + PG8_SA(b, h) + aoff + m * 2048 + k * 1024); } while (0)
#define PG8_LDB(dst, b, h) do { _Pragma("unroll") for (int n = 0; n < 2; ++n) _Pragma("unroll") for (int k = 0; k < 2; ++k) dst[n][k] = *(const PG8_LAS bf16x8*)(lds + PG8_SB(b, h) + boff + n * 2048 + k * 1024); } while (0)
#define PG8_MMA(ai, bj, At, Bt) do { __builtin_amdgcn_s_setprio(1); _Pragma("unroll") for (int m = 0; m < 4; ++m) _Pragma("unroll") for (int n = 0; n < 2; ++n) _Pragma("unroll") for (int k = 0; k < 2; ++k) \
        acc[ai][bj][m][n] = __builtin_amdgcn_mfma_f32_16x16x32_bf16(Bt[n][k], At[m][k], acc[ai][bj][m][n], 0, 0, 0); __builtin_amdgcn_s_setprio(0); } while (0)
#define PG8_WAIT_V(n) asm volatile("s_waitcnt vmcnt(" #n ")" ::: "memory")
#define PG8_WAIT_L(n) asm volatile("s_waitcnt lgkmcnt(" #n ")" ::: "memory")
#define PG8_BAR __builtin_amdgcn_s_barrier()
#define PG8_SCHED __builtin_amdgcn_sched_barrier(0)
    Unit cur, nxt; int ui = 0;
    if (!S.next(0, cur)) return;
    f32x4 acc[2][2][4][2];
#pragma unroll
    for (int a = 0; a < 2; ++a)
#pragma unroll
        for (int b = 0; b < 2; ++b)
#pragma unroll
            for (int m = 0; m < 4; ++m)
#pragma unroll
                for (int n = 0; n < 2; ++n) acc[a][b][m][n] = (f32x4){0.f, 0.f, 0.f, 0.f};
    bf16x8 At[4][2], B0[2][2], B1[2][2];
    const char* cA = (const char*)g.A + (size_t)cur.pm * tstep; const char* cB = (const char*)g.Bt + (size_t)cur.pn * tstep;
    S.a_ready(cur);
    PG8_STAGE(PG8_SB(0, 0), cB, voffB); PG8_STAGE(PG8_SA(0, 0), cA, voffA); PG8_STAGE(PG8_SB(0, 1), cB + hstep, voffB); PG8_STAGE(PG8_SA(0, 1), cA + hstep, voffA);
    if (wr == 1) PG8_BAR;
    PG8_WAIT_V(4); PG8_BAR;
    PG8_STAGE(PG8_SB(1, 0), cB + kstep, voffB); PG8_STAGE(PG8_SA(1, 0), cA + kstep, voffA); PG8_STAGE(PG8_SB(1, 1), cB + hstep + kstep, voffB);
    PG8_WAIT_V(6); PG8_BAR;
    PG8_STAMP();
    for (;;) {
        const bool has_next = S.next(ui + 1, nxt);
        const char* nA = has_next ? (const char*)g.A + (size_t)nxt.pm * tstep : cA; const char* nB = has_next ? (const char*)g.Bt + (size_t)nxt.pn * tstep : cB;
        for (int t = 0; t < nt; t += 2) {
            const bool last = (t == nt - 2);
            const char* a1 = cA + (size_t)(t + 1) * kstep;
            const char* a2 = last ? nA : cA + (size_t)(t + 2) * kstep; const char* b2 = last ? nB : cB + (size_t)(t + 2) * kstep;
            const char* a3 = a2 + kstep; const char* b3 = b2 + kstep;
            if (last && has_next) S.a_ready(nxt);
            PG8_LDB(B0, 0, 0); PG8_SCHED; PG8_LDA(At, 0, 0); PG8_STAGE(PG8_SA(1, 1), a1 + hstep, voffA);
            PG8_WAIT_L(8); PG8_BAR; PG8_WAIT_L(0); PG8_MMA(0, 0, At, B0); PG8_BAR; PG8_SCHED;
            PG8_LDB(B1, 0, 1); PG8_STAGE(PG8_SB(0, 0), b2, voffB);
            PG8_BAR; PG8_WAIT_L(0); PG8_MMA(0, 1, At, B1); PG8_BAR;
            PG8_LDA(At, 0, 1); PG8_STAGE(PG8_SA(0, 0), a2, voffA);
            PG8_BAR; PG8_WAIT_L(0); PG8_MMA(1, 0, At, B0); PG8_BAR; PG8_SCHED;
            PG8_STAGE(PG8_SB(0, 1), b2 + hstep, voffB);
            PG8_WAIT_V(6); PG8_BAR; PG8_MMA(1, 1, At, B1); PG8_BAR;
            PG8_LDB(B0, 1, 0); PG8_SCHED; PG8_LDA(At, 1, 0); PG8_STAGE(PG8_SA(0, 1), a2 + hstep, voffA);
            PG8_WAIT_L(8); PG8_BAR; PG8_WAIT_L(0); PG8_MMA(0, 0, At, B0); PG8_BAR; PG8_SCHED;
            PG8_LDB(B1, 1, 1); PG8_STAGE(PG8_SB(1, 0), b3, voffB);
            PG8_BAR; PG8_WAIT_L(0); PG8_MMA(0, 1, At, B1); PG8_BAR;
            PG8_LDA(At, 1, 1); PG8_STAGE(PG8_SA(1, 0), a3, voffA);
            PG8_BAR; PG8_WAIT_L(0); PG8_MMA(1, 0, At, B0); PG8_BAR; PG8_SCHED;
            PG8_STAGE(PG8_SB(1, 1), b3 + hstep, voffB);
            PG8_WAIT_V(6); PG8_BAR; PG8_MMA(1, 1, At, B1); PG8_BAR;
        }
        PG8_STAMP();
        if constexpr (!Epi::AFTER_DRAIN) { E(acc, cur, wr, wc, fr, fq); S.done(cur); }
        PG8_STAMP();
        if (!has_next) break;
#pragma unroll
        for (int a = 0; a < 2; ++a)
#pragma unroll
            for (int b = 0; b < 2; ++b)
#pragma unroll
                for (int m = 0; m < 4; ++m)
#pragma unroll
                    for (int n = 0; n < 2; ++n) acc[a][b][m][n] = (f32x4){0.f, 0.f, 0.f, 0.f};
        cur = nxt; cA = nA; cB = nB; ++ui;
    }
    PG8_WAIT_V(0);
    if (wr == 0) PG8_BAR;
    PG8_BAR;
    if constexpr (Epi::AFTER_DRAIN) { E.fused(acc, cur, wr, wc, fr, fq, lds, wid, lane); S.done(cur); }
    PG8_STAMP();
    if (STAMP && wid == 0) { stamps[lane] = lane < nts ? (((unsigned long long)(unsigned)ts_hi << 32) | (unsigned)ts_lo) : 0ull;
        if (lane == 62) stamps[62] = rt_entry; if (lane == 63) stamps[63] = (unsigned long long)wall_clock64(); }
#undef PG8_STAMP
#undef PG8_SA
#undef PG8_SB
#undef PG8_STAGE
#undef PG8_LDA
#undef PG8_LDB
#undef PG8_MMA
#undef PG8_WAIT_V
#undef PG8_WAIT_L
#undef PG8_BAR
#undef PG8_SCHED
}
}

using pg8::bf16_t; using pg8::bf16x8; using pg8::f32x4; using pg8::u32x4;
typedef float f32x16 __attribute__((ext_vector_type(16)));
typedef unsigned u32x2 __attribute__((ext_vector_type(2)));
typedef unsigned long long u64;
#define DEV __device__ __forceinline__

constexpr int DM = 1024, TP = 2048, NPR = 16384, NSR = 256, MT = 16640, INW = 2600, INWP = 2816, DFF = 4096, PAST = 4096, LS = 4128, LSP = 4160, TPV = 2112;
constexpr int NTHREADS = 512;
constexpr int LDS_BYTES = 139264;
constexpr size_t O_YP = 0, O_YS = 16777216, O_KP = 17039360, O_VP = 25427968, O_KIP = 33816576, O_CP = 34865152, O_KS = 34873344, O_VS = 35004416, O_KIS = 35135488, O_CS = 35151872, O_SGV = 35160064;
constexpr size_t WS_WIN = 0, SZ_WIN1 = (size_t)INWP * DM * 2;
constexpr size_t WS_WOUT = WS_WIN + 2 * SZ_WIN1, SZ_WOUT1 = (size_t)DM * DM * 2;
constexpr size_t WS_WUP = WS_WOUT + 2 * SZ_WOUT1, SZ_WUP1 = (size_t)DFF * DM * 2;
constexpr size_t WS_WDN = WS_WUP + 2 * SZ_WUP1;
constexpr size_t WS_XB = WS_WDN + 2 * SZ_WUP1;
constexpr size_t WS_SS = WS_XB + (size_t)MT * DM * 2;
constexpr size_t WS_ROPE = WS_SS + (size_t)MT * 16 * 4;
constexpr size_t WS_WI = WS_ROPE + (size_t)2080 * 64 * 4;
constexpr size_t WS_KS = WS_WI + (size_t)MT * 8 * 4, SZ_KS1 = (size_t)8 * 4 * LSP * 64 * 2;
constexpr size_t WS_VTS = WS_KS + 2 * SZ_KS1;
constexpr size_t WS_KIS = WS_VTS + 2 * SZ_KS1, SZ_KIS1 = (size_t)8 * LSP * 32 * 2;
constexpr size_t WS_BMP = WS_KIS + 2 * SZ_KIS1;
constexpr size_t WS_BMS = WS_BMP + (size_t)NPR * 32 * 8;
constexpr size_t WS_BAR = WS_BMS + (size_t)NSR * 72 * 8;
constexpr size_t WS_PART = WS_BAR + 16384;
constexpr size_t SZ_PARTO = (size_t)8 * 4 * 4 * 64 * 64 * 4;
constexpr size_t WS_MIX = WS_PART + SZ_PARTO + (size_t)8 * 4 * 4 * 64 * 4;
constexpr size_t WS_H = WS_MIX;
constexpr size_t WS_YMIX = WS_MIX;
constexpr size_t WS_ZB = WS_YMIX + (size_t)MT * 1024 * 2;
constexpr size_t WS_QB = WS_ZB + (size_t)MT * 768 * 2;
constexpr size_t WS_ZAU = WS_QB + (size_t)MT * 512 * 2;
constexpr size_t WS_SGVT = WS_ZAU + (size_t)MT * 256 * 2;
constexpr size_t WS_QIB = WS_SGVT + (size_t)MT * 256 * 2;
constexpr size_t WS_KP = WS_QIB + (size_t)MT * 256 * 2;
constexpr size_t WS_VTP = WS_KP + (size_t)8 * 4 * TP * 64 * 2;
constexpr size_t WS_KIP = WS_VTP + (size_t)8 * 4 * TPV * 64 * 2;
constexpr size_t WS_MIX_END = WS_KIP + (size_t)8 * TP * 32 * 2;
constexpr size_t WS_END = WS_H + (size_t)MT * DFF * 2;
static_assert(WS_MIX_END <= WS_END, "mixer intermediates must fit inside the H alias");
static_assert(WS_XB % 256 == 0 && WS_SS % 256 == 0 && WS_ROPE % 256 == 0 && WS_WI % 256 == 0 && WS_KS % 256 == 0 && WS_VTS % 256 == 0 && WS_KIS % 256 == 0 && WS_BMP % 256 == 0 && WS_BMS % 256 == 0 && WS_MIX % 256 == 0, "align");
static_assert(WS_ZB % 256 == 0 && WS_QB % 256 == 0 && WS_ZAU % 256 == 0 && WS_SGVT % 256 == 0 && WS_QIB % 256 == 0 && WS_KP % 256 == 0 && WS_VTP % 256 == 0 && WS_KIP % 256 == 0, "align2");

struct Params {
    const float* x_prompt; const float* x_sample; const float* cache_k; const float* cache_v; const float* cache_kidx; const float* state_conv;
    const float* g_mix; const float* w_in; const float* q_gain; const float* k_gain; const float* w_s; const float* b_s; const float* conv_w;
    const float* w_out; const float* g_ffn; const float* w_up; const float* w_down;
    float* out; unsigned char* ws;
    int ph_lo, ph_hi;
};

__constant__ float c_invf[32] = {1.000000000e+00f, 7.498942614e-01f, 5.623413324e-01f, 4.216965139e-01f, 3.162277639e-01f, 2.371373773e-01f, 1.778279394e-01f, 1.333521307e-01f, 1.000000015e-01f, 7.498941571e-02f, 5.623413250e-02f, 4.216965288e-02f, 3.162277490e-02f, 2.371373773e-02f, 1.778279431e-02f, 1.333521493e-02f, 9.999999776e-03f, 7.498941850e-03f, 5.623413250e-03f, 4.216964822e-03f, 3.162277630e-03f, 2.371373586e-03f, 1.778279431e-03f, 1.333521446e-03f, 1.000000047e-03f, 7.498942432e-04f, 5.623413017e-04f, 4.216965172e-04f, 3.162277571e-04f, 2.371373703e-04f, 1.778279402e-04f, 1.333521504e-04f};

DEV float bf2f(unsigned short h) { return __uint_as_float((unsigned)h << 16); }
typedef __bf16 bf16v2_t __attribute__((ext_vector_type(2)));
typedef float f32v2_t __attribute__((ext_vector_type(2)));
DEV unsigned pk2(float lo, float hi) { return __builtin_bit_cast(unsigned, __builtin_convertvector((f32v2_t){lo, hi}, bf16v2_t)); }
DEV unsigned short f2bf(float x) { return (unsigned short)(pk2(x, 0.f) & 0xffffu); }
DEV u32x4 pack8(const float (&v)[8]) { u32x4 w; w.x = pk2(v[0], v[1]); w.y = pk2(v[2], v[3]); w.z = pk2(v[4], v[5]); w.w = pk2(v[6], v[7]); return w; }
DEV float gelu_tanh(float x) {
    const float y = 0.7978845608028654f * (x + 0.044715f * x * x * x);
    const float e = __builtin_amdgcn_exp2f(-2.0f * 1.4426950408889634f * y);
    return x * __builtin_amdgcn_rcpf(1.0f + e);
}
DEV float wave_sum(float v) {
#pragma unroll
    for (int o = 32; o > 0; o >>= 1) v += __shfl_xor(v, o);
    return v;
}
DEV float wave_max(float v) {
#pragma unroll
    for (int o = 32; o > 0; o >>= 1) v = fmaxf(v, __shfl_xor(v, o));
    return v;
}

#define XB_TMO      128
#define XB_XCNT(j)  (256  + 64 * (j))
#define XB_XSUB(j)  (1280 + 64 * (j))
#define XB_XGEN(j)  (2304 + 64 * (j))
#define XB_TOP      3328
#define XB_TOPGEN   3392
#define XCD_BAR_WORDS 3456
#define XB_SPIN_CAP (1u << 18)
#define LAS __attribute__((address_space(3)))

__device__ __forceinline__ unsigned xb_ld(unsigned* p)              { return __hip_atomic_load(p, __ATOMIC_RELAXED, __HIP_MEMORY_SCOPE_AGENT); }
__device__ __forceinline__ unsigned xb_add(unsigned* p, unsigned v) { return __hip_atomic_fetch_add(p, v, __ATOMIC_RELAXED, __HIP_MEMORY_SCOPE_AGENT); }
__device__ __forceinline__ unsigned xb_xcc_id() { return (unsigned)__builtin_amdgcn_s_getreg((3 << 11) | 20) & 0xFu; }
#define XB_SPIN(cond, bar) do { unsigned _sp = 0; while (cond) { __builtin_amdgcn_s_sleep(1); \
    if ((++_sp & 255u) == 0u) { if (xb_ld(&(bar)[XB_TMO])) break; if (_sp > XB_SPIN_CAP) { atomicAdd(&(bar)[XB_TMO], 1u); break; } } } } while (0)

struct XcdBarrier {
    unsigned* bar; unsigned x;
    volatile LAS unsigned* st;
};

__device__ __forceinline__ XcdBarrier xcd_barrier_post(unsigned* bar, volatile LAS unsigned* st) {
    XcdBarrier b; b.bar = bar; b.x = xb_xcc_id(); b.st = st;
    if (threadIdx.x == 0) (void)xb_add(&bar[XB_XCNT(b.x)], 1u);
    return b;
}
__device__ __forceinline__ void xcd_barrier_complete(unsigned* bar, unsigned x, unsigned& nloc, unsigned& nx) {
    const unsigned G = gridDim.x * gridDim.y * gridDim.z;
    unsigned sum, cnt, mine, sp = 0u;
    for (;;) {
        sum = 0u; cnt = 0u; mine = 0u;
#pragma unroll
        for (unsigned j = 0; j < 16; ++j) { const unsigned c = xb_ld(&bar[XB_XCNT(j)]); sum += c; cnt += (c > 0u) ? 1u : 0u; mine = (j == x) ? c : mine; }
        if (sum == G) break;
        __builtin_amdgcn_s_sleep(1);
        if ((++sp & 255u) == 0u) { if (xb_ld(&bar[XB_TMO])) break; if (sp > XB_SPIN_CAP) { atomicAdd(&bar[XB_TMO], 1u); break; } }
    }
    nloc = mine > 0u ? mine : 1u; nx = cnt > 0u ? cnt : 1u;
}

__device__ __forceinline__ void xcd_barrier(const XcdBarrier& b) {
    asm volatile("s_waitcnt vmcnt(0)" ::: "memory");
    __syncthreads();
    if (threadIdx.x == 0) {
        unsigned* bar = b.bar;
        __builtin_amdgcn_s_waitcnt(0);
        unsigned nloc = b.st[0], nx = b.st[1];
        if (nloc == 0u) { xcd_barrier_complete(bar, b.x, nloc, nx); b.st[0] = nloc; b.st[1] = nx; }
        const unsigned old = xb_add(&bar[XB_XSUB(b.x)], 1u);
        const unsigned gen = old / nloc;
        if (old + 1u == (gen + 1u) * nloc) {
            __builtin_amdgcn_fence(__ATOMIC_RELEASE, "agent");
            asm volatile("s_waitcnt vmcnt(0)" ::: "memory");
            const unsigned og = xb_add(&bar[XB_TOP], 1u);
            const unsigned tg = og / nx;
            if (og + 1u == (tg + 1u) * nx) xb_add(&bar[XB_TOPGEN], 1u);
            else XB_SPIN(xb_ld(&bar[XB_TOPGEN]) == tg, bar);
            __builtin_amdgcn_fence(__ATOMIC_ACQUIRE, "agent");
            xb_add(&bar[XB_XGEN(b.x)], 1u);
            asm volatile("s_waitcnt vmcnt(0)" ::: "memory");
        } else {
            XB_SPIN(xb_ld(&bar[XB_XGEN(b.x)]) == gen, bar);
            __builtin_amdgcn_fence(__ATOMIC_ACQUIRE, "agent");
            asm volatile("s_waitcnt vmcnt(0)" ::: "memory");
        }
    }
    __syncthreads();
}


DEV float row_rstd(const float* ss, int row) {
    const f32x4* sp = (const f32x4*)(ss + (size_t)row * 16);
    const f32x4 a = sp[0], b = sp[1], c = sp[2], d = sp[3];
    const float t = ((a[0] + a[1]) + (a[2] + a[3])) + ((b[0] + b[1]) + (b[2] + b[3])) + ((c[0] + c[1]) + (c[2] + c[3])) + ((d[0] + d[1]) + (d[2] + d[3]));
    return rsqrtf(t * (1.0f / 1024.0f) + 1e-6f);
}

struct EpiIn {
    static constexpr bool PERM = false, AFTER_DRAIN = false;
    const float* ss; const float* rope; const float* qg; const float* kg; float* out; unsigned char* ws; int layer;
    __device__ __forceinline__ void operator()(const f32x4 (&acc)[2][2][4][2], const pg8::Unit& u, int wr, int wc, int fr, int fq0) const {
        const int pn = u.pn, pm = u.pm;
        const bool samp = (pm == 64);
        bf16_t* ZAU = (bf16_t*)(ws + WS_ZAU); bf16_t* SGVT = (bf16_t*)(ws + WS_SGVT); bf16_t* ZB = (bf16_t*)(ws + WS_ZB); bf16_t* QB = (bf16_t*)(ws + WS_QB);
        bf16_t* QIB = (bf16_t*)(ws + WS_QIB); float* WI = (float*)(ws + WS_WI);
#pragma unroll
        for (int ai = 0; ai < 2; ++ai)
#pragma unroll
            for (int m = 0; m < 4; ++m) {
                int row = pm * 256 + ai * 128 + wr * 64 + m * 16 + fr, fq = fq0;
                asm volatile("" : "+v"(row), "+v"(fq));
                const float rstd = row_rstd(ss, row);
                int b, t, posidx; const int rs = row - NPR;
                if (!samp) { b = row >> 11; t = row & 2047; posidx = t; } else { b = rs >> 5; t = rs & 31; posidx = 2048 + t; }
                float lo[8], hi[8];
#pragma unroll
                for (int bj = 0; bj < 2; ++bj)
#pragma unroll
                    for (int n = 0; n < 2; ++n)
#pragma unroll
                        for (int jp = 0; jp < 2; ++jp) { lo[4 * bj + 2 * n + jp] = acc[ai][bj][m][n][2 * jp] * rstd; hi[4 * bj + 2 * n + jp] = acc[ai][bj][m][n][2 * jp + 1] * rstd; }
                if (pn == 0) {
#pragma unroll
                    for (int e = 0; e < 8; ++e) { lo[e] = gelu_tanh(lo[e]); hi[e] = gelu_tanh(hi[e]); }
                    bf16_t* d = ZAU + (size_t)row * 256 + 64 * wc + 8 * fq;
                    *(u32x4*)d = pack8(lo); *(u32x4*)(d + 32) = pack8(hi);
                } else if (pn == 1) {
#pragma unroll
                    for (int e = 0; e < 8; ++e) { lo[e] = gelu_tanh(lo[e]); hi[e] = gelu_tanh(hi[e]); }
#pragma unroll
                    for (int e = 0; e < 8; ++e) {
                        SGVT[(size_t)(64 * wc + 8 * fq + e) * MT + row] = f2bf(lo[e]);
                        SGVT[(size_t)(64 * wc + 32 + 8 * fq + e) * MT + row] = f2bf(hi[e]);
                    }
                    if (samp) {
                        float* d = out + O_SGV + ((size_t)layer * NSR + rs) * 256 + 64 * wc + 8 * fq;
                        *(f32x4*)d = (f32x4){lo[0], lo[1], lo[2], lo[3]}; *(f32x4*)(d + 4) = (f32x4){lo[4], lo[5], lo[6], lo[7]};
                        *(f32x4*)(d + 32) = (f32x4){hi[0], hi[1], hi[2], hi[3]}; *(f32x4*)(d + 36) = (f32x4){hi[4], hi[5], hi[6], hi[7]};
                    }
                } else if (pn <= 4) {
                    bf16_t* d = ZB + (size_t)row * 768 + 256 * (pn - 2) + 64 * wc + 8 * fq;
                    *(u32x4*)d = pack8(lo); *(u32x4*)(d + 32) = pack8(hi);
                } else if (pn <= 7) {
                    float sq = 0.f;
#pragma unroll
                    for (int e = 0; e < 8; ++e) sq += lo[e] * lo[e] + hi[e] * hi[e];
                    sq += __shfl_xor(sq, 16); sq += __shfl_xor(sq, 32);
                    const float rh = rsqrtf(sq * (1.0f / 64.0f) + 1e-6f);
                    const float* cs = rope + (size_t)posidx * 64 + 8 * fq;
                    const f32x4 c0 = *(const f32x4*)cs, c1 = *(const f32x4*)(cs + 4), s0 = *(const f32x4*)(cs + 32), s1 = *(const f32x4*)(cs + 36);
                    const float* gp = (pn == 7 ? kg : qg) + layer * 64 + 8 * fq;
                    const f32x4 g0 = *(const f32x4*)gp, g1 = *(const f32x4*)(gp + 4), g2 = *(const f32x4*)(gp + 32), g3 = *(const f32x4*)(gp + 36);
                    float ol[8], oh[8];
#pragma unroll
                    for (int e = 0; e < 8; ++e) {
                        const float co = e < 4 ? c0[e & 3] : c1[e & 3], si = e < 4 ? s0[e & 3] : s1[e & 3];
                        const float a = lo[e] * rh * (e < 4 ? g0[e & 3] : g1[e & 3]), bb = hi[e] * rh * (e < 4 ? g2[e & 3] : g3[e & 3]);
                        ol[e] = a * co - bb * si; oh[e] = bb * co + a * si;
                    }
                    if (pn < 7) {
#pragma unroll
                        for (int e = 0; e < 8; ++e) { ol[e] *= 0.125f * 1.4426950408889634f; oh[e] *= 0.125f * 1.4426950408889634f; }
                        bf16_t* d = QB + (size_t)row * 512 + (4 * (pn - 5) + wc) * 64 + 8 * fq;
                        *(u32x4*)d = pack8(ol); *(u32x4*)(d + 32) = pack8(oh);
                    } else {
                        float* d = samp ? out + O_KS + ((size_t)layer * NSR + rs) * 256 + 64 * wc + 8 * fq : out + O_KP + ((size_t)layer * NPR + row) * 256 + 64 * wc + 8 * fq;
                        *(f32x4*)d = (f32x4){ol[0], ol[1], ol[2], ol[3]}; *(f32x4*)(d + 4) = (f32x4){ol[4], ol[5], ol[6], ol[7]};
                        *(f32x4*)(d + 32) = (f32x4){oh[0], oh[1], oh[2], oh[3]}; *(f32x4*)(d + 36) = (f32x4){oh[4], oh[5], oh[6], oh[7]};
                        if (!samp) {
                            bf16_t* kb = (bf16_t*)(ws + WS_KP) + ((size_t)(b * 4 + wc) * TP + t) * 64 + 8 * fq;
                            *(u32x4*)kb = pack8(ol); *(u32x4*)(kb + 32) = pack8(oh);
                        }
                    }
                } else if (pn == 8) {
                    float* d = samp ? out + O_VS + ((size_t)layer * NSR + rs) * 256 + 64 * wc + 8 * fq : out + O_VP + ((size_t)layer * NPR + row) * 256 + 64 * wc + 8 * fq;
                    *(f32x4*)d = (f32x4){lo[0], lo[1], lo[2], lo[3]}; *(f32x4*)(d + 4) = (f32x4){lo[4], lo[5], lo[6], lo[7]};
                    *(f32x4*)(d + 32) = (f32x4){hi[0], hi[1], hi[2], hi[3]}; *(f32x4*)(d + 36) = (f32x4){hi[4], hi[5], hi[6], hi[7]};
                    if (!samp) {
                        bf16_t* vt = (bf16_t*)(ws + WS_VTP) + (size_t)(b * 4 + wc) * 64 * TPV + t;
#pragma unroll
                        for (int e = 0; e < 8; ++e) { vt[(size_t)(8 * fq + e) * TPV] = f2bf(lo[e]); vt[(size_t)(32 + 8 * fq + e) * TPV] = f2bf(hi[e]); }
                    }
                } else {
                    const float* cs = rope + (size_t)posidx * 64 + 8 * fq;
                    const f32x4 c0 = *(const f32x4*)cs, c1 = *(const f32x4*)(cs + 4), s0 = *(const f32x4*)(cs + 32), s1 = *(const f32x4*)(cs + 36);
                    const float co[4] = {c0[0], c0[2], c1[0], c1[2]}, si[4] = {s0[0], s0[2], s1[0], s1[2]};
                    float ol[8], oh[8];
#pragma unroll
                    for (int e = 0; e < 8; ++e) { ol[e] = lo[e] * co[e & 3] - hi[e] * si[e & 3]; oh[e] = hi[e] * co[e & 3] + lo[e] * si[e & 3]; }
                    if (pn == 9) {
#pragma unroll
                        for (int bj = 0; bj < 2; ++bj) {
                            bf16_t* d = QIB + (size_t)row * 256 + 32 * (2 * wc + bj) + 4 * fq;
                            *(u32x2*)d = (u32x2){pk2(ol[4 * bj], ol[4 * bj + 1]), pk2(ol[4 * bj + 2], ol[4 * bj + 3])};
                            *(u32x2*)(d + 16) = (u32x2){pk2(oh[4 * bj], oh[4 * bj + 1]), pk2(oh[4 * bj + 2], oh[4 * bj + 3])};
                        }
                    } else if (wc == 0) {
                        float* d = samp ? out + O_KIS + ((size_t)layer * NSR + rs) * 32 + 4 * fq : out + O_KIP + ((size_t)layer * NPR + row) * 32 + 4 * fq;
                        *(f32x4*)d = (f32x4){ol[0], ol[1], ol[2], ol[3]}; *(f32x4*)(d + 16) = (f32x4){oh[0], oh[1], oh[2], oh[3]};
                        bf16_t* kb = samp ? (bf16_t*)(ws + WS_KIS + (size_t)layer * SZ_KIS1) + ((size_t)b * LSP + PAST + t) * 32 + 4 * fq
                                          : (bf16_t*)(ws + WS_KIP) + (size_t)row * 32 + 4 * fq;
                        *(u32x2*)kb = (u32x2){pk2(ol[0], ol[1]), pk2(ol[2], ol[3])};
                        *(u32x2*)(kb + 16) = (u32x2){pk2(oh[0], oh[1]), pk2(oh[2], oh[3])};
                        if (fq < 2) *(f32x4*)(WI + (size_t)row * 8 + 4 * fq) = (f32x4){lo[4] * 0.0625f, lo[5] * 0.0625f, lo[6] * 0.0625f, lo[7] * 0.0625f};
                    }
                }
                asm volatile("" ::: "memory");
            }
    }
};

struct EpiRes {
    static constexpr bool PERM = true, AFTER_DRAIN = false;
    float* Y; bf16_t* XB; float* ss; int last; int live;
    __device__ __forceinline__ void operator()(const f32x4 (&acc)[2][2][4][2], const pg8::Unit& u, int wr, int wc, int fr, int fq0) const {
        if (!live) return;
#pragma unroll
        for (int ai = 0; ai < 2; ++ai) {
            u32x4 xin[4][2];
#pragma unroll
            for (int m = 0; m < 4; ++m) {
                int row = u.pm * 256 + ai * 128 + wr * 64 + m * 16 + fr, fq = fq0;
                asm volatile("" : "+v"(row), "+v"(fq));
#pragma unroll
                for (int bj = 0; bj < 2; ++bj) xin[m][bj] = *(const u32x4*)(XB + (size_t)row * DM + u.pn * 256 + 128 * bj + 32 * wc + 8 * fq);
            }
#pragma unroll
            for (int m = 0; m < 4; ++m) {
                int row = u.pm * 256 + ai * 128 + wr * 64 + m * 16 + fr, fq = fq0;
                asm volatile("" : "+v"(row), "+v"(fq));
                float sq = 0.f;
#pragma unroll
                for (int bj = 0; bj < 2; ++bj) {
                    const size_t off = (size_t)row * DM + u.pn * 256 + 128 * bj + 32 * wc + 8 * fq;
                    const u32x4 xb = xin[m][bj];
                    f32x4 x0 = (f32x4){__uint_as_float(xb[0] << 16), __uint_as_float(xb[0] & 0xffff0000u), __uint_as_float(xb[1] << 16), __uint_as_float(xb[1] & 0xffff0000u)};
                    f32x4 x1 = (f32x4){__uint_as_float(xb[2] << 16), __uint_as_float(xb[2] & 0xffff0000u), __uint_as_float(xb[3] << 16), __uint_as_float(xb[3] & 0xffff0000u)};
                    x0 += acc[ai][bj][m][0]; x1 += acc[ai][bj][m][1];
                    if (last) { *(f32x4*)(Y + off) = x0; *(f32x4*)(Y + off + 4) = x1; }
                    else {
                        *(u32x4*)(XB + off) = (u32x4){pk2(x0[0], x0[1]), pk2(x0[2], x0[3]), pk2(x1[0], x1[1]), pk2(x1[2], x1[3])};
                        sq += ((x0[0] * x0[0] + x0[1] * x0[1]) + (x0[2] * x0[2] + x0[3] * x0[3])) + ((x1[0] * x1[0] + x1[1] * x1[1]) + (x1[2] * x1[2] + x1[3] * x1[3]));
                    }
                }
                if (!last) {
                    sq += __shfl_xor(sq, 16); sq += __shfl_xor(sq, 32);
                    if (fq0 == 0) ss[(size_t)row * 16 + u.pn * 4 + wc] = sq;
                }
            }
            asm volatile("" ::: "memory");
        }
    }
};

struct EpiUp {
    static constexpr bool PERM = true, AFTER_DRAIN = false;
    bf16_t* H; const float* ss;
    __device__ __forceinline__ void operator()(const f32x4 (&acc)[2][2][4][2], const pg8::Unit& u, int wr, int wc, int fr, int fq0) const {
#pragma unroll
        for (int ai = 0; ai < 2; ++ai) {
            float rs[4];
#pragma unroll
            for (int m = 0; m < 4; ++m) {
                int row = u.pm * 256 + ai * 128 + wr * 64 + m * 16 + fr;
                asm volatile("" : "+v"(row));
                rs[m] = row_rstd(ss, row);
            }
#pragma unroll
            for (int m = 0; m < 4; ++m) {
                int row = u.pm * 256 + ai * 128 + wr * 64 + m * 16 + fr, fq = fq0;
                asm volatile("" : "+v"(row), "+v"(fq));
                const float rstd = rs[m];
#pragma unroll
                for (int bj = 0; bj < 2; ++bj) {
                    const size_t off = (size_t)row * DFF + u.pn * 256 + 128 * bj + 32 * wc + 8 * fq;
                    float v[8];
#pragma unroll
                    for (int j = 0; j < 4; ++j) { const float r0 = fmaxf(acc[ai][bj][m][0][j] * rstd, 0.f), r1 = fmaxf(acc[ai][bj][m][1][j] * rstd, 0.f); v[j] = r0 * r0; v[4 + j] = r1 * r1; }
                    *(u32x4*)(H + off) = pack8(v);
                }
            }
            asm volatile("" ::: "memory");
        }
    }
};

DEV int win_colmap(int cg) {
    const int pn = cg >> 8, r = cg & 255, bj = r >> 7, wc = (r >> 5) & 3, n = (r >> 4) & 1, fq = (r >> 2) & 3, jp = (r >> 1) & 1, s = r & 1;
    int o;
    if (pn < 9) o = 256 * pn + 64 * wc + 32 * s + 8 * fq + 4 * bj + 2 * n + jp;
    else o = 256 * pn + 32 * (2 * wc + bj) + 16 * s + 4 * fq + 2 * n + jp;
    return o < INW ? o : -1;
}
DEV void sincos_acc(float ang, float& c, float& s) {
    const double x = (double)ang, twopi = 6.283185307179586476925287;
    const double k = __builtin_rint(x * (1.0 / twopi));
    const double r = x - k * twopi, r2 = r * r;
    double sp = 1.0, cp = 1.0;
#pragma unroll
    for (int i = 14; i >= 1; --i) { sp = 1.0 - sp * r2 / (double)((2 * i) * (2 * i + 1)); cp = 1.0 - cp * r2 / (double)((2 * i - 1) * (2 * i)); }
    s = (float)(r * sp); c = (float)cp;
}

struct TJob { const float* W; const float* gain; bf16_t* Bt; int N, K, c0, k0, perm; };
DEV TJob tjob_decode(const Params& p, int job) {
    unsigned char* ws = p.ws;
    const int l = job / 3008; int r = job % 3008; TJob j;
    if (r < 704) { j.W = p.w_in + (size_t)l * DM * INW; j.gain = p.g_mix + l * DM; j.Bt = (bf16_t*)(ws + WS_WIN + (size_t)l * SZ_WIN1); j.N = INW; j.K = DM; j.c0 = (r >> 4) * 64; j.k0 = (r & 15) * 64; j.perm = 1; }
    else if (r < 960) { r -= 704; j.W = p.w_out + (size_t)l * DM * DM; j.gain = nullptr; j.Bt = (bf16_t*)(ws + WS_WOUT + (size_t)l * SZ_WOUT1); j.N = DM; j.K = DM; j.c0 = (r >> 4) * 64; j.k0 = (r & 15) * 64; j.perm = 0; }
    else if (r < 1984) { r -= 960; j.W = p.w_up + (size_t)l * DM * DFF; j.gain = p.g_ffn + l * DM; j.Bt = (bf16_t*)(ws + WS_WUP + (size_t)l * SZ_WUP1); j.N = DFF; j.K = DM; j.c0 = (r >> 4) * 64; j.k0 = (r & 15) * 64; j.perm = 0; }
    else { r -= 1984; j.W = p.w_down + (size_t)l * DFF * DM; j.gain = nullptr; j.Bt = (bf16_t*)(ws + WS_WDN + (size_t)l * SZ_WUP1); j.N = DM; j.K = DFF; j.c0 = (r >> 6) * 64; j.k0 = (r & 63) * 64; j.perm = 0; }
    return j;
}
DEV void tjob_load(const TJob& j, float (&v)[8], int tid) {
    if (j.perm) {
#pragma unroll
        for (int it = 0; it < 8; ++it) {
            const int idx = tid + 512 * it, kk = idx >> 6, cc = idx & 63, o = win_colmap(j.c0 + cc);
            v[it] = (o >= 0) ? j.W[(size_t)(j.k0 + kk) * j.N + o] * j.gain[j.k0 + kk] : 0.f;
        }
    } else {
#pragma unroll
        for (int it = 0; it < 2; ++it) {
            const int idx = tid + 512 * it, kk = idx >> 4, c4 = idx & 15;
            const f32x4 x = *(const f32x4*)(j.W + (size_t)(j.k0 + kk) * j.N + j.c0 + 4 * c4);
            const float g = j.gain ? j.gain[j.k0 + kk] : 1.f;
#pragma unroll
            for (int e = 0; e < 4; ++e) v[4 * it + e] = x[e] * g;
        }
    }
}
DEV void tjob_lds(const TJob& j, const float (&v)[8], float* tile, int tid) {
    if (j.perm) {
#pragma unroll
        for (int it = 0; it < 8; ++it) { const int idx = tid + 512 * it; tile[(idx & 63) * 65 + (idx >> 6)] = v[it]; }
    } else {
#pragma unroll
        for (int it = 0; it < 2; ++it) {
            const int idx = tid + 512 * it, kk = idx >> 4, c4 = idx & 15;
#pragma unroll
            for (int e = 0; e < 4; ++e) tile[(4 * c4 + e) * 65 + kk] = v[4 * it + e];
        }
    }
}
DEV void tjob_flush(const TJob& j, const float* tile, int tid) {
    const int cc = tid >> 3, kg = tid & 7;
    float v[8];
#pragma unroll
    for (int i = 0; i < 8; ++i) v[i] = tile[cc * 65 + 8 * kg + i];
    *(u32x4*)(j.Bt + (size_t)(j.c0 + cc) * j.K + j.k0 + 8 * kg) = pack8(v);
}

DEV void transpose_jobs(const Params& p, unsigned char* lds, int j0, int j1, int me, int nblk);
DEV void phase_prologue(const Params& p, unsigned char* lds) {
    const int tid = otid(), lane = tid & 63, G = gridDim.x;
    unsigned char* ws = p.ws;
    {
        bf16_t* XB = (bf16_t*)(ws + WS_XB); float* SS = (float*)(ws + WS_SS);
        for (int row0 = blockIdx.x * 8 + (tid >> 6); row0 < MT; row0 += G * 16) {
            f32x4 v[2][4]; int rows[2];
#pragma unroll
            for (int h = 0; h < 2; ++h) {
                const int row = row0 + h * G * 8; rows[h] = row;
                if (row < MT) {
                    const float* src = row < NPR ? p.x_prompt + (size_t)row * DM : p.x_sample + (size_t)(row - NPR) * DM;
#pragma unroll
                    for (int i = 0; i < 4; ++i) v[h][i] = *(const f32x4*)(src + i * 256 + lane * 4);
                }
            }
#pragma unroll
            for (int h = 0; h < 2; ++h) {
                const int row = rows[h];
                if (row < MT) {
                    bf16_t* xb = XB + (size_t)row * DM;
                    float sq = 0.f;
#pragma unroll
                    for (int i = 0; i < 4; ++i) {
                        const f32x4 x = v[h][i];
                        *(u32x2*)(xb + i * 256 + lane * 4) = (u32x2){pk2(x[0], x[1]), pk2(x[2], x[3])};
                        sq += (x[0] * x[0] + x[1] * x[1]) + (x[2] * x[2] + x[3] * x[3]);
                    }
                    sq = wave_sum(sq);
                    if (lane < 16) SS[(size_t)row * 16 + lane] = lane == 0 ? sq : 0.f;
                }
            }
        }
    }
    const int gtid = blockIdx.x * NTHREADS + tid, gsz = G * NTHREADS;
    {
        float* RT = (float*)(ws + WS_ROPE);
        for (int i = gtid; i < 2080 * 32; i += gsz) {
            const int pi = i >> 5, k = i & 31, pos = pi < 2048 ? pi : PAST + (pi - 2048);
            float c, s; sincos_acc((float)pos * c_invf[k], c, s);
            RT[pi * 64 + k] = c; RT[pi * 64 + 32 + k] = s;
        }
    }
    {
        bf16_t* KIS = (bf16_t*)(ws + WS_KIS);
        for (int i = gtid; i < 2 * 8 * PAST * 4; i += gsz) {
            const int dg = i & 3, key = (i >> 2) & 4095, lb = i >> 14;
            const float* src = p.cache_kidx + ((size_t)lb * PAST + key) * 32 + dg * 8;
            const f32x4 a = *(const f32x4*)src, b = *(const f32x4*)(src + 4);
            *(u32x4*)(KIS + ((size_t)lb * LSP + key) * 32 + dg * 8) = (u32x4){pk2(a[0], a[1]), pk2(a[2], a[3]), pk2(b[0], b[1]), pk2(b[2], b[3])};
        }
    }
    transpose_jobs(p, lds, 0, 6016, blockIdx.x, G);
}
DEV void transpose_jobs(const Params& p, unsigned char* lds, int j0, int j1, int me, int nblk) {
    const int tid = otid();
    {
        float* tile = (float*)lds;
        for (int jb = j0 + me * 4; jb < j1; jb += nblk * 4) {
            float v[4][8];
#pragma unroll
            for (int u = 0; u < 4; ++u) { const TJob j = tjob_decode(p, jb + u); tjob_load(j, v[u], tid); }
#pragma unroll
            for (int u = 0; u < 4; ++u) { const TJob j = tjob_decode(p, jb + u); tjob_lds(j, v[u], tile + u * 4160, tid); }
            __syncthreads();
#pragma unroll
            for (int u = 0; u < 4; ++u) { const TJob j = tjob_decode(p, jb + u); tjob_flush(j, tile + u * 4160, tid); }
            __syncthreads();
        }
    }
}

DEV unsigned sort_key(float f) { const unsigned u = __float_as_uint(f); return (u & 0x80000000u) ? ~u : (u | 0x80000000u); }

DEV int wave_isum(int v) {
    v += __builtin_amdgcn_update_dpp(0, v, 0x111, 0xf, 0xf, true);
    v += __builtin_amdgcn_update_dpp(0, v, 0x112, 0xf, 0xf, true);
    v += __builtin_amdgcn_update_dpp(0, v, 0x114, 0xf, 0xf, true);
    v += __builtin_amdgcn_update_dpp(0, v, 0x118, 0xf, 0xf, true);
    v += __builtin_amdgcn_update_dpp(0, v, 0x142, 0xa, 0xf, false);
    v += __builtin_amdgcn_update_dpp(0, v, 0x143, 0xc, 0xf, false);
    return __builtin_amdgcn_readlane(v, 63);
}
template <int NCH, int NR> DEV void select_rows(const float* rowf, int npad, int nch, u64* bmr, int bmstride, int lane) {
    asm volatile("" : "+s"(nch));
    unsigned kreg[NR][NCH];
#pragma unroll
    for (int r = 0; r < NR; ++r)
#pragma unroll
        for (int c = 0; c < NCH; ++c) {
            const unsigned k = sort_key(rowf[(size_t)r * npad + c * 64 + lane]);
            kreg[r][c] = (c < nch) ? k : 0u;
        }
    unsigned T[NR]; bool done[NR];
#pragma unroll
    for (int r = 0; r < NR; ++r) { T[r] = 0u; done[r] = false; }
    for (int bit = 31; bit >= 0; --bit) {
        unsigned cand[NR]; int cnt[NR];
#pragma unroll
        for (int r = 0; r < NR; ++r) { cand[r] = T[r] | (1u << bit); cnt[r] = 0; }
#pragma unroll
        for (int c = 0; c < NCH; ++c) {
            if ((c & 7) == 0 && c >= nch) break;
#pragma unroll
            for (int r = 0; r < NR; ++r) cnt[r] += (kreg[r][c] >= cand[r]) ? 1 : 0;
        }
        bool alldone = true;
#pragma unroll
        for (int r = 0; r < NR; ++r) {
            const int tot = wave_isum(cnt[r]);
            if (tot >= 256) T[r] = cand[r];
            if (tot == 256) done[r] = true;
            alldone = alldone && done[r];
        }
        if (alldone) break;
    }
#pragma unroll
    for (int r = 0; r < NR; ++r) {
        int cg = 0;
#pragma unroll
        for (int c = 0; c < NCH; ++c) { if ((c & 7) == 0 && c >= nch) break; cg += (kreg[r][c] > T[r]) ? 1 : 0; }
        const int need = 256 - wave_isum(cg);
        int eqbase = 0;
#pragma unroll
        for (int c = 0; c < NCH; ++c) {
            if (c < nch) {
                const unsigned kv = kreg[r][c];
                const bool eq = (kv == T[r]);
                const u64 be = __ballot(eq);
                const int rank = eqbase + __popcll(be & ((1ull << lane) - 1ull));
                const bool sel = (kv > T[r]) || (eq && rank < need);
                const u64 bs = __ballot(sel);
                eqbase += __popcll(be);
                if (lane == 0) bmr[(size_t)r * bmstride + c] = bs;
            }
        }
    }
}

struct IdxItem { int nq, n, row0, bmstride; const bf16_t* KI; u64* BM; };
DEV IdxItem idx_decode(const Params& p, int layer, int item) {
    unsigned char* ws = p.ws; IdxItem I;
    if (item < 32) {
        const int b = item >> 2, qt = item & 3;
        I.nq = 8; I.n = LS; I.row0 = NPR + b * 32 + qt * 8;
        I.KI = (const bf16_t*)(ws + WS_KIS + (size_t)layer * SZ_KIS1) + (size_t)b * LSP * 32;
        I.BM = (u64*)(ws + WS_BMS) + (size_t)(b * 32 + qt * 8) * 72; I.bmstride = 72;
    } else {
        const int i2 = item - 32, c = 31 - (i2 >> 5), w = i2 & 31, b = w >> 2, qt = w & 3;
        I.nq = 16; I.n = 64 * (c + 1); I.row0 = b * TP + 64 * c + 16 * qt;
        I.KI = (const bf16_t*)(ws + WS_KIP) + (size_t)b * TP * 32;
        I.BM = (u64*)(ws + WS_BMP) + (size_t)I.row0 * 32; I.bmstride = 32;
    }
    return I;
}
struct IdxPre { bf16x8 aq[4][2]; bf16x8 nb0, nb1; float wv; };
DEV void idx_prefetch(const Params& p, const IdxItem& I, IdxPre& P, int tid, int lane, int wave) {
    if (I.n <= 256) return;
    unsigned char* ws = p.ws;
    const bf16_t* QI = (const bf16_t*)(ws + WS_QIB); const float* WI = (const float*)(ws + WS_WI);
    P.wv = (tid < I.nq * 8) ? WI[(size_t)I.row0 * 8 + tid] : 0.f;
    const int nqb = I.nq >> 2;
    const int i = lane & 31, a = i >> 3, gi = (i >> 2) & 1, c = i & 3, qin = 2 * gi + (a >> 1), head = 4 * (a & 1) + c;
#pragma unroll
    for (int qb = 0; qb < 4; ++qb)
#pragma unroll
        for (int ks = 0; ks < 2; ++ks) {
            if (qb < nqb) P.aq[qb][ks] = *(const bf16x8*)(QI + (size_t)(I.row0 + 4 * qb + qin) * 256 + head * 32 + 8 * (lane >> 5) + 16 * ks);
            else P.aq[qb][ks] = (bf16x8){0, 0, 0, 0, 0, 0, 0, 0};
        }
    const int g = lane >> 5, nkb = I.n >> 5;
    P.nb0 = (bf16x8){0, 0, 0, 0, 0, 0, 0, 0}; P.nb1 = P.nb0;
    if (wave < nkb) { const bf16_t* kp = I.KI + (size_t)(wave * 32 + (lane & 31)) * 32 + 8 * g; P.nb0 = *(const bf16x8*)kp; P.nb1 = *(const bf16x8*)(kp + 16); }
}
DEV int indexer_item(const Params& p, int layer, int item, unsigned char* lds, const IdxPre& P, int nxt, volatile int* slot, IdxPre& Pn) {
    const int tid = otid(), lane = tid & 63, wave = __builtin_amdgcn_readfirstlane(tid >> 6);
    const IdxItem I = idx_decode(p, layer, item);
    const int nq = I.nq, n = I.n, bmstride = I.bmstride; u64* BM = I.BM; const bf16_t* KI = I.KI;
    const int ntile = (n + 63) >> 6;
    if (n <= 256) {
        if (tid < nq * ntile) BM[(size_t)(tid / ntile) * bmstride + (tid % ntile)] = ~0ull;
        if (tid == 0) slot[1] = nxt;
        __syncthreads();
        const int nx = __builtin_amdgcn_readfirstlane(slot[1]);
        __syncthreads();
        if (nx < 1056) idx_prefetch(p, idx_decode(p, layer, nx), Pn, tid, lane, wave);
        return nx;
    }
    const int npad = ntile * 64;
    float* sc = (float*)lds;
    float* wl = (float*)(lds + 133120);
    if (tid < nq * 8) wl[tid] = P.wv;
    const int nqb = nq >> 2;
    const int g = lane >> 5;
    const int nkb = n >> 5;
    bf16x8 nb0 = P.nb0, nb1 = P.nb1;
    __syncthreads();
    for (int kb = wave; kb < nkb; kb += 8) {
        const int key = kb * 32 + (lane & 31);
        const bf16x8 b0 = nb0, b1 = nb1;
        if (kb + 8 < nkb) { const bf16_t* kp = KI + (size_t)(key + 256) * 32 + 8 * g; nb0 = *(const bf16x8*)kp; nb1 = *(const bf16x8*)(kp + 16); }
#pragma unroll
        for (int qb = 0; qb < 4; ++qb) {
            if (qb < nqb) {
                f32x16 acc;
#pragma unroll
                for (int r = 0; r < 16; ++r) acc[r] = 0.f;
                acc = __builtin_amdgcn_mfma_f32_32x32x16_bf16(P.aq[qb][0], b0, acc, 0, 0, 0);
                acc = __builtin_amdgcn_mfma_f32_32x32x16_bf16(P.aq[qb][1], b1, acc, 0, 0, 0);
#pragma unroll
                for (int qq = 0; qq < 2; ++qq) {
                    const int ql = 4 * qb + 2 * g + qq;
                    const f32x4 w0 = *(const f32x4*)(wl + ql * 8), w1 = *(const f32x4*)(wl + ql * 8 + 4);
                    float s = 0.f;
#pragma unroll
                    for (int h = 0; h < 4; ++h) s = fmaf(w0[h], __builtin_amdgcn_fmed3f(acc[8 * qq + h], 0.f, __builtin_inff()), s);
#pragma unroll
                    for (int h = 0; h < 4; ++h) s = fmaf(w1[h], __builtin_amdgcn_fmed3f(acc[8 * qq + 4 + h], 0.f, __builtin_inff()), s);
                    s = (s == 0.f) ? 0.f : s;
                    sc[(size_t)ql * npad + key] = s;
                }
            }
        }
    }
    if (npad > n && tid < nq * (npad - n)) sc[(size_t)(tid / (npad - n)) * npad + n + tid % (npad - n)] = -__builtin_inff();
    if (tid == 0) slot[1] = nxt;
    __syncthreads();
    const int nx = __builtin_amdgcn_readfirstlane(slot[1]);
    if (nx < 1056) idx_prefetch(p, idx_decode(p, layer, nx), Pn, tid, lane, wave);
    const float* scf = (const float*)lds;
    if (nq == 16) select_rows<32, 2>(scf + (size_t)(2 * wave) * npad, npad, ntile, BM + (size_t)(2 * wave) * bmstride, bmstride, lane);
    else select_rows<65, 1>(scf + (size_t)wave * npad, npad, ntile, BM + (size_t)wave * bmstride, bmstride, lane);
    __syncthreads();
    return nx;
}

DEV void sgate_item(const Params& p, int layer, int item) {
    const int tid = otid(), lane = tid & 63, wave = tid >> 6, fr = lane & 15, quad = lane >> 4;
    unsigned char* ws = p.ws;
    int row0, ni, h;
    if (item < 512) { h = item & 3; row0 = (item >> 2) * 128; ni = 128; } else { const int i2 = item - 512; h = i2 & 3; row0 = NPR + (i2 >> 2) * 32; ni = 32; }
    if (wave * 16 >= ni) return;
    const int ksmax = (ni == 32) ? 1 : (wave < 4 ? 2 : 4);
    const float* W = p.w_s + ((size_t)(layer * 4 + h) * 128 + wave * 16 + fr) * 128;
    const bf16_t* SGVT = (const bf16_t*)(ws + WS_SGVT);
    f32x4 acc[4];
#pragma unroll
    for (int nn = 0; nn < 4; ++nn) acc[nn] = (f32x4){0.f, 0.f, 0.f, 0.f};
    f32x4 a0[4], a1[4]; bf16x8 bfr[4][4];
#pragma unroll
    for (int ks = 0; ks < 4; ++ks)
        if (ks < ksmax) {
            a0[ks] = *(const f32x4*)(W + 32 * ks + 8 * quad); a1[ks] = *(const f32x4*)(W + 32 * ks + 8 * quad + 4);
#pragma unroll
            for (int nn = 0; nn < 4; ++nn) bfr[ks][nn] = *(const bf16x8*)(SGVT + (size_t)(h * 64 + 16 * nn + fr) * MT + row0 + 32 * ks + 8 * quad);
        }
    const bf16_t* ZAU = (const bf16_t*)(ws + WS_ZAU); bf16_t* YMIX = (bf16_t*)(ws + WS_YMIX);
    unsigned short uu[4][4]; float bias[4];
#pragma unroll
    for (int j = 0; j < 4; ++j) {
        const int i = wave * 16 + 4 * quad + j;
        bias[j] = p.b_s[(layer * 4 + h) * 128 + i];
#pragma unroll
        for (int nn = 0; nn < 4; ++nn) uu[j][nn] = ZAU[(size_t)(row0 + i) * 256 + h * 64 + 16 * nn + fr];
    }
#pragma unroll
    for (int ks = 0; ks < 4; ++ks)
        if (ks < ksmax) {
            const u32x4 aw = (u32x4){pk2(a0[ks][0], a0[ks][1]), pk2(a0[ks][2], a0[ks][3]), pk2(a1[ks][0], a1[ks][1]), pk2(a1[ks][2], a1[ks][3])};
            const bf16x8 af = __builtin_bit_cast(bf16x8, aw);
#pragma unroll
            for (int nn = 0; nn < 4; ++nn) acc[nn] = __builtin_amdgcn_mfma_f32_16x16x32_bf16(af, bfr[ks][nn], acc[nn], 0, 0, 0);
        }
#pragma unroll
    for (int j = 0; j < 4; ++j) {
        const int i = wave * 16 + 4 * quad + j;
#pragma unroll
        for (int nn = 0; nn < 4; ++nn) YMIX[(size_t)(row0 + i) * 1024 + h * 64 + 16 * nn + fr] = f2bf(bf2f(uu[j][nn]) * (acc[nn][j] + bias[j]));
    }
}

DEV void conv_one(const Params& p, int layer, const bf16_t* ZB, bf16_t* YMIX, int i) {
    {
        const int row = i >> 5, ch = (i & 31) * 8;
        const bool samp = row >= NPR; const int rs = row - NPR;
        const int b = samp ? (rs >> 5) : (row >> 11), t = samp ? (rs & 31) : (row & 2047), T = samp ? 32 : TP;
        float xc[3][8];
#pragma unroll
        for (int dt = 0; dt < 3; ++dt) {
            const int tt = t - 2 + dt;
            if (tt >= 0) {
                const bf16_t* zr = ZB + (size_t)(row - 2 + dt) * 768 + ch;
                const u32x4 gc = *(const u32x4*)(zr + 256), hi = *(const u32x4*)(zr + 512);
#pragma unroll
                for (int e = 0; e < 4; ++e) {
                    xc[dt][2 * e] = __uint_as_float(gc[e] << 16) * __uint_as_float(hi[e] << 16);
                    xc[dt][2 * e + 1] = __uint_as_float(gc[e] & 0xffff0000u) * __uint_as_float(hi[e] & 0xffff0000u);
                }
            } else if (samp) {
                const float* st = p.state_conv + (((size_t)layer * 8 + b) * 2 + (tt + 2)) * 256 + ch;
                const f32x4 a = *(const f32x4*)st, c = *(const f32x4*)(st + 4);
#pragma unroll
                for (int e = 0; e < 4; ++e) { xc[dt][e] = a[e]; xc[dt][4 + e] = c[e]; }
            } else {
#pragma unroll
                for (int e = 0; e < 8; ++e) xc[dt][e] = 0.f;
            }
        }
        const u32x4 gb = *(const u32x4*)(ZB + (size_t)row * 768 + ch);
        const float* cw = p.conv_w + (size_t)layer * 3 * 256 + ch;
        float y[8];
#pragma unroll
        for (int e = 0; e < 8; ++e) {
            const float gbe = (e & 1) ? __uint_as_float(gb[e >> 1] & 0xffff0000u) : __uint_as_float(gb[e >> 1] << 16);
            y[e] = gbe * (cw[e] * xc[0][e] + cw[256 + e] * xc[1][e] + cw[512 + e] * xc[2][e]);
        }
        *(u32x4*)(YMIX + (size_t)row * 1024 + 256 + ch) = pack8(y);
        if (t >= T - 2) {
            float* d = p.out + (samp ? O_CS : O_CP) + (((size_t)layer * 8 + b) * 2 + (t - (T - 2))) * 256 + ch;
            *(f32x4*)d = (f32x4){xc[2][0], xc[2][1], xc[2][2], xc[2][3]}; *(f32x4*)(d + 4) = (f32x4){xc[2][4], xc[2][5], xc[2][6], xc[2][7]};
        }
    }
}

DEV void phase_mix_a(const Params& p, int layer, unsigned char* lds) {
    {
        unsigned char* ws = p.ws;
        const bf16_t* ZB = (const bf16_t*)(ws + WS_ZB); bf16_t* YMIX = (bf16_t*)(ws + WS_YMIX);
        for (int i = blockIdx.x * NTHREADS + otid(); i < MT * 32; i += gridDim.x * NTHREADS) conv_one(p, layer, ZB, YMIX, i);
    }
    {
        const int tid = otid(), lane = tid & 63, wave = __builtin_amdgcn_readfirstlane(tid >> 6);
        unsigned* ctr = (unsigned*)(p.ws + WS_BAR) + 3712 + 64 * layer;
        volatile int* slot = (volatile int*)(lds + LDS_BYTES - 32);
        if (tid == 0) slot[0] = (int)__hip_atomic_fetch_add(ctr, 1u, __ATOMIC_RELAXED, __HIP_MEMORY_SCOPE_AGENT);
        __syncthreads();
        int it = __builtin_amdgcn_readfirstlane(slot[0]);
        IdxPre P;
        if (it < 1056) idx_prefetch(p, idx_decode(p, layer, it), P, tid, lane, wave);
        while (it < 1056 + 544) {
            int nxt = 0;
            if (tid == 0) nxt = (int)__hip_atomic_fetch_add(ctr, 1u, __ATOMIC_RELAXED, __HIP_MEMORY_SCOPE_AGENT);
            if (it < 1056) {
                IdxPre Pn;
                it = indexer_item(p, layer, it, lds, P, nxt, slot, Pn);
                P = Pn;
            } else {
                sgate_item(p, layer, it - 1056);
                if (tid == 0) slot[1] = nxt;
                __syncthreads();
                it = __builtin_amdgcn_readfirstlane(slot[1]);
                __syncthreads();
            }
        }
    }
}

constexpr int AT_KT = 8192, AT_VT = 9216, AT_BUF = AT_KT + AT_VT, AT_GRP = 2 * AT_BUF;
template <bool SAMPLE> struct AttnRaw { u32x4 k[2]; u32x4 v[2]; };
template <> struct AttnRaw<true> { f32x4 k[2][2]; f32x4 v[2][2]; };
struct AttnSrc { const bf16_t* kb; const bf16_t* vt; const float* ck; const float* cv; const float* nk; const float* nv; };

template <bool SAMPLE> DEV void attn_load(AttnRaw<SAMPLE>& raw, const AttnSrc& S, int kt, int tg) {
#pragma unroll
    for (int r = 0; r < 2; ++r) {
        const int q = tg + 256 * r;
        if constexpr (!SAMPLE) {
            raw.k[r] = *(const u32x4*)(S.kb + (size_t)(kt * 64 + (q >> 3)) * 64 + 8 * (q & 7));
            raw.v[r] = *(const u32x4*)(S.vt + (size_t)(q >> 3) * TPV + kt * 64 + 8 * (q & 7));
        } else {
            {
                const int key = kt * 64 + (q >> 3), g = q & 7;
                if (key < LS) { const float* s = key < PAST ? S.ck + (size_t)key * 256 + 8 * g : S.nk + (size_t)(key - PAST) * 256 + 8 * g; raw.k[r][0] = *(const f32x4*)s; raw.k[r][1] = *(const f32x4*)(s + 4); }
                else { raw.k[r][0] = (f32x4){0.f, 0.f, 0.f, 0.f}; raw.k[r][1] = raw.k[r][0]; }
            }
            {
                const int key = kt * 64 + (q & 63), g = q >> 6;
                if (key < LS) { const float* s = key < PAST ? S.cv + (size_t)key * 256 + 8 * g : S.nv + (size_t)(key - PAST) * 256 + 8 * g; raw.v[r][0] = *(const f32x4*)s; raw.v[r][1] = *(const f32x4*)(s + 4); }
                else { raw.v[r][0] = (f32x4){0.f, 0.f, 0.f, 0.f}; raw.v[r][1] = raw.v[r][0]; }
            }
        }
    }
}
template <bool SAMPLE> DEV void attn_store(const AttnRaw<SAMPLE>& raw, unsigned char* buf, int tg) {
#pragma unroll
    for (int r = 0; r < 2; ++r) {
        const int q = tg + 256 * r, row = q >> 3, g = q & 7;
        unsigned char* kd = buf + row * 128 + ((g ^ ((row >> 1) & 7)) << 4);
        if constexpr (!SAMPLE) {
            *(u32x4*)kd = raw.k[r];
            *(u32x4*)(buf + AT_KT + row * 144 + 16 * g) = raw.v[r];
        } else {
            *(u32x4*)kd = (u32x4){pk2(raw.k[r][0][0], raw.k[r][0][1]), pk2(raw.k[r][0][2], raw.k[r][0][3]), pk2(raw.k[r][1][0], raw.k[r][1][1]), pk2(raw.k[r][1][2], raw.k[r][1][3])};
            const int kl = q & 63, gv = q >> 6;
            bf16_t* vd = (bf16_t*)(buf + AT_KT + (8 * gv) * 144) + kl;
#pragma unroll
            for (int e = 0; e < 4; ++e) { vd[e * 72] = f2bf(raw.v[r][0][e]); vd[(4 + e) * 72] = f2bf(raw.v[r][1][e]); }
        }
    }
}
template <int NG> DEV void attn_tile(const unsigned char* buf, const bf16x8 (&qf)[NG][2], u64 mw, float c1, float c2, f32x4 (&o)[NG][4], float (&lsum)[NG], int fr, int quad) {
    const u64 mq = mw >> (4 * quad);
    const int mlo = (int)(unsigned)mq, mhi = (int)(unsigned)(mq >> 32);
    const unsigned nb = __float_as_uint(-c2);
    f32x4 zi[4];
#pragma unroll
    for (int t = 0; t < 4; ++t)
#pragma unroll
        for (int j = 0; j < 4; ++j) {
            const unsigned m = (unsigned)__builtin_amdgcn_sbfe(t < 2 ? mlo : mhi, 16 * (t & 1) + j, 1);
            zi[t][j] = __uint_as_float((m & nb) | (~m & 0xf149f2cau));
        }
    f32x4 st[NG][4];
#pragma unroll
    for (int t = 0; t < 4; ++t) {
        const int row = 16 * t + fr, sw = (row >> 1) & 7;
        const bf16x8 k0 = *(const bf16x8*)(buf + row * 128 + ((quad ^ sw) << 4)), k1 = *(const bf16x8*)(buf + row * 128 + (((quad + 4) ^ sw) << 4));
#pragma unroll
        for (int g = 0; g < NG; ++g) {
            const f32x4 z = __builtin_amdgcn_mfma_f32_16x16x32_bf16(k0, qf[g][0], zi[t], 0, 0, 0);
            st[g][t] = __builtin_amdgcn_mfma_f32_16x16x32_bf16(k1, qf[g][1], z, 0, 0, 0);
        }
    }
    u32x4 pw[NG][2];
#pragma unroll
    for (int g = 0; g < NG; ++g) {
#pragma unroll
        for (int t = 0; t < 4; ++t)
#pragma unroll
            for (int j = 0; j < 4; ++j) {
                const float pv = __builtin_amdgcn_exp2f(st[g][t][j]);
                st[g][t][j] = pv; lsum[g] += pv;
            }
#pragma unroll
        for (int i = 0; i < 2; ++i)
            pw[g][i] = (u32x4){pk2(st[g][2 * i][0], st[g][2 * i][1]), pk2(st[g][2 * i][2], st[g][2 * i][3]), pk2(st[g][2 * i + 1][0], st[g][2 * i + 1][1]), pk2(st[g][2 * i + 1][2], st[g][2 * i + 1][3])};
    }
#pragma unroll
    for (int i = 0; i < 2; ++i)
#pragma unroll
        for (int nn = 0; nn < 4; ++nn) {
            const unsigned char* vr = buf + AT_KT + (16 * nn + fr) * 144 + 64 * i + 8 * quad;
            const u32x2 v0 = *(const u32x2*)vr, v1 = *(const u32x2*)(vr + 32);
            const bf16x8 vb = __builtin_bit_cast(bf16x8, (u32x4){v0.x, v0.y, v1.x, v1.y});
#pragma unroll
            for (int g = 0; g < NG; ++g) o[g][nn] = __builtin_amdgcn_mfma_f32_16x16x32_bf16(__builtin_bit_cast(bf16x8, pw[g][i]), vb, o[g][nn], 0, 0, 0);
        }
}
template <bool SAMPLE, int NG> DEV void attn_stream(const AttnSrc& S, const bf16_t* Qrow, const u64* bmrow, int kt0, int kt1, int nsteps, unsigned char* glds, int tg, int lane, float c1, float c2, f32x4 (&o)[NG][4], float (&lsum)[NG]) {
    const int fr = lane & 15, quad = lane >> 4;
    bf16x8 qf[NG][2];
#pragma unroll
    for (int g = 0; g < NG; ++g) { qf[g][0] = *(const bf16x8*)(Qrow + 64 * g + 8 * quad); qf[g][1] = *(const bf16x8*)(Qrow + 64 * g + 32 + 8 * quad); }
    const int klast = kt1 - 1;
    AttnRaw<SAMPLE> rawA, rawB;
    attn_load<SAMPLE>(rawA, S, kt0, tg);
    u64 mwn = bmrow[kt0];
    attn_store<SAMPLE>(rawA, glds, tg);
    attn_load<SAMPLE>(rawA, S, min(kt0 + 1, klast), tg);
    __syncthreads();
    for (int s = 0; s < nsteps; s += 2) {
        {
            const u64 mw = mwn;
            attn_load<SAMPLE>(rawB, S, min(kt0 + s + 2, klast), tg);
            mwn = (kt0 + s + 1 < kt1) ? bmrow[kt0 + s + 1] : 0ull;
            attn_tile<NG>(glds, qf, mw, c1, c2, o, lsum, fr, quad);
            attn_store<SAMPLE>(rawA, glds + AT_BUF, tg);
            __syncthreads();
        }
        if (s + 1 < nsteps) {
            const u64 mw = mwn;
            attn_load<SAMPLE>(rawA, S, min(kt0 + s + 3, klast), tg);
            mwn = (kt0 + s + 2 < kt1) ? bmrow[kt0 + s + 2] : 0ull;
            attn_tile<NG>(glds + AT_BUF, qf, mw, c1, c2, o, lsum, fr, quad);
            attn_store<SAMPLE>(rawB, glds, tg);
            __syncthreads();
        }
    }
}
template <int NG> DEV void attn_finish(bf16_t* YMIX, int rowq, int head0, f32x4 (&o)[NG][4], float (&lsum)[NG], int lane) {
    const int fr = lane & 15, quad = lane >> 4;
#pragma unroll
    for (int g = 0; g < NG; ++g) {
        float ls = lsum[g];
        ls += __shfl_xor(ls, 16); ls += __shfl_xor(ls, 32);
#pragma unroll
        for (int j = 0; j < 4; ++j) {
            const float l = __shfl(ls, 4 * quad + j);
            const float inv = 1.0f / l;
#pragma unroll
            for (int nn = 0; nn < 4; ++nn) YMIX[(size_t)(rowq + 4 * quad + j) * 1024 + 512 + (head0 + g) * 64 + 16 * nn + fr] = f2bf(o[g][nn][j] * inv);
        }
    }
}
DEV void attn_prompt_item(const Params& p, int idx, float c1, float c2, unsigned char* lds) {
    const int tid = otid(), lane = tid & 63, wave = tid >> 6, fr = lane & 15, grp = wave >> 2, wg = wave & 3;
    unsigned char* ws = p.ws;
    const int c = 31 - (idx >> 4), r = idx & 15, b = r >> 1, hk = 2 * (r & 1) + grp;
    const int rowq = b * TP + 64 * c + 16 * wg;
    f32x4 o[2][4];
#pragma unroll
    for (int g = 0; g < 2; ++g)
#pragma unroll
        for (int nn = 0; nn < 4; ++nn) o[g][nn] = (f32x4){0.f, 0.f, 0.f, 0.f};
    float lsum[2] = {0.f, 0.f};
    AttnSrc S{};
    S.kb = (const bf16_t*)(ws + WS_KP) + (size_t)(b * 4 + hk) * TP * 64;
    S.vt = (const bf16_t*)(ws + WS_VTP) + (size_t)(b * 4 + hk) * 64 * TPV;
    const u64* bm = (const u64*)(ws + WS_BMP) + (size_t)(rowq + fr) * 32;
    attn_stream<false, 2>(S, (const bf16_t*)(ws + WS_QB) + (size_t)(rowq + fr) * 512 + 2 * hk * 64, bm, 0, c + 1, c + 1, lds + grp * AT_GRP, tid & 255, lane, c1, c2, o, lsum);
    attn_finish<2>((bf16_t*)(ws + WS_YMIX), rowq, 2 * hk, o, lsum, lane);
}
DEV void attn_sample_item(const Params& p, int layer, int item, float c1, float c2, unsigned char* lds) {
    const int tid = otid(), lane = tid & 63, wave = tid >> 6, fr = lane & 15, quad = lane >> 4, grp = wave >> 2, wg = wave & 3;
    unsigned char* ws = p.ws;
    const int qt = item & 3, bh = item >> 2, b = bh >> 2, hk = bh & 3, head = 2 * hk + (wg >> 1);
    const int rowq = NPR + b * 32 + 16 * (wg & 1);
    const int t0 = (qt == 0) ? 0 : 1 + 16 * qt, t1 = 17 + 16 * qt;
    const int tm = t0 + ((t1 - t0 + 1) >> 1), nsteps = tm - t0;
    f32x4 o[1][4];
#pragma unroll
    for (int nn = 0; nn < 4; ++nn) o[0][nn] = (f32x4){0.f, 0.f, 0.f, 0.f};
    float lsum[1] = {0.f};
    AttnSrc S{};
    S.ck = p.cache_k + (size_t)(layer * 8 + b) * PAST * 256 + hk * 64; S.cv = p.cache_v + (size_t)(layer * 8 + b) * PAST * 256 + hk * 64;
    S.nk = p.out + O_KS + (size_t)(layer * NSR + b * 32) * 256 + hk * 64; S.nv = p.out + O_VS + (size_t)(layer * NSR + b * 32) * 256 + hk * 64;
    const u64* bm = (const u64*)(ws + WS_BMS) + (size_t)(b * 32 + 16 * (wg & 1) + fr) * 72;
    attn_stream<true, 1>(S, (const bf16_t*)(ws + WS_QB) + (size_t)(rowq + fr) * 512 + head * 64, bm, grp ? tm : t0, grp ? t1 : tm, nsteps, lds + grp * AT_GRP, tid & 255, lane, c1, c2, o, lsum);
    float* xo = (float*)lds;
    if (grp) {
        float* d = xo + ((size_t)wg * 64 + lane) * 17;
#pragma unroll
        for (int nn = 0; nn < 4; ++nn)
#pragma unroll
            for (int j = 0; j < 4; ++j) d[nn * 4 + j] = o[0][nn][j];
        d[16] = lsum[0];
    }
    __syncthreads();
    if (!grp) {
        const float* d = xo + ((size_t)wg * 64 + lane) * 17;
#pragma unroll
        for (int nn = 0; nn < 4; ++nn)
#pragma unroll
            for (int j = 0; j < 4; ++j) o[0][nn][j] += d[nn * 4 + j];
        float ls = lsum[0] + d[16];
        ls += __shfl_xor(ls, 16); ls += __shfl_xor(ls, 32);
        float* PO = (float*)(ws + WS_PART) + ((size_t)(bh * 4 + qt) * 64 + wg * 16) * 64;
        float* PL = (float*)(ws + WS_PART + SZ_PARTO) + (size_t)(bh * 4 + qt) * 64 + wg * 16;
#pragma unroll
        for (int j = 0; j < 4; ++j)
#pragma unroll
            for (int nn = 0; nn < 4; ++nn) PO[(size_t)(4 * quad + j) * 64 + 16 * nn + fr] = o[0][nn][j];
        if (quad == 0) PL[fr] = ls;
    }
    __syncthreads();
}
DEV void attn_sample_combine(const Params& p) {
    unsigned char* ws = p.ws;
    const float* PO = (const float*)(ws + WS_PART); const float* PL = (const float*)(ws + WS_PART + SZ_PARTO);
    bf16_t* YMIX = (bf16_t*)(ws + WS_YMIX);
    for (int i = blockIdx.x * NTHREADS + otid(); i < 8 * 4 * 64 * 16; i += gridDim.x * NTHREADS) {
        const int d4 = i & 15, pr = (i >> 4) & 63, bh = i >> 10, b = bh >> 2, hk = bh & 3;
        f32x4 acc = (f32x4){0.f, 0.f, 0.f, 0.f}; float l = 0.f;
#pragma unroll
        for (int q = 0; q < 4; ++q) { acc += *(const f32x4*)(PO + ((size_t)(bh * 4 + q) * 64 + pr) * 64 + 4 * d4); l += PL[(size_t)(bh * 4 + q) * 64 + pr]; }
        const float inv = 1.0f / l;
        const int wg = pr >> 4, qi = 16 * (wg & 1) + (pr & 15), head = 2 * hk + (wg >> 1);
        *(u32x2*)(YMIX + (size_t)(NPR + b * 32 + qi) * 1024 + 512 + head * 64 + 4 * d4) = (u32x2){pk2(acc[0] * inv, acc[1] * inv), pk2(acc[2] * inv, acc[3] * inv)};
    }
}

DEV void phase_attn(const Params& p, int layer, unsigned char* lds) {
    const int tid = otid(), lane = tid & 63;
    const float gq = wave_max(fabsf(p.q_gain[layer * 64 + lane])), gk = wave_max(fabsf(p.k_gain[layer * 64 + lane]));
    const float bound = 8.0f * gq * gk * 1.02f;
    const float c1 = 0.125f * 1.4426950408889634f, c2 = bound * 1.4426950408889634f;
    unsigned* ctr = (unsigned*)(p.ws + WS_BAR) + 3584 + 64 * layer;
    volatile int* slot = (volatile int*)(lds + LDS_BYTES - 32);
    for (;;) {
        if (tid == 0) *slot = (int)__hip_atomic_fetch_add(ctr, 1u, __ATOMIC_RELAXED, __HIP_MEMORY_SCOPE_AGENT);
        __syncthreads();
        const int it = __builtin_amdgcn_readfirstlane(*slot);
        __syncthreads();
        if (it >= 640) break;
        if (it < 128) attn_sample_item(p, layer, it, c1, c2, lds);
        else attn_prompt_item(p, it - 128, c1, c2, lds);
    }
}

template <int NT, int CH> DEV void mini_mma(const bf16_t* A, int lda, const bf16_t* Bt, int ldb, int r0, int c0, int k0, int k1, f32x4 (&acc)[NT], int lane) {
    const int fr = lane & 15, quad = lane >> 4;
    const bf16_t* ap = A + (size_t)(r0 + fr) * lda + 8 * quad;
    const bf16_t* bp = Bt + (size_t)(c0 + fr) * ldb + 8 * quad;
    for (int k = k0; k < k1; k += 32 * CH) {
        bf16x8 a[CH], b[NT][CH];
#pragma unroll
        for (int i = 0; i < CH; ++i) {
            a[i] = *(const bf16x8*)(ap + k + 32 * i);
#pragma unroll
            for (int nt = 0; nt < NT; ++nt) b[nt][i] = *(const bf16x8*)(bp + (size_t)16 * nt * ldb + k + 32 * i);
        }
#pragma unroll
        for (int i = 0; i < CH; ++i)
#pragma unroll
            for (int nt = 0; nt < NT; ++nt) acc[nt] = __builtin_amdgcn_mfma_f32_16x16x32_bf16(a[i], b[nt][i], acc[nt], 0, 0, 0);
    }
}
DEV void mini_res(const bf16_t* A, const bf16_t* Bt, int K, float* Y, bf16_t* XB, float* SS, unsigned char* lds, int last, int live) {
    const int tid = otid(), lane = tid & 63, wave = tid >> 6, fr = lane & 15, quad = lane >> 4;
    float* part = (float*)lds;
    float* tile = (float*)(lds + 8 * 64 * 17 * 4);
    for (int t = blockIdx.x; t < 256; t += gridDim.x) {
        const int r0 = NPR + 16 * (t >> 4), ct = t & 15, c0 = 64 * ct, kw = K >> 3;
        f32x4 acc[4];
#pragma unroll
        for (int nt = 0; nt < 4; ++nt) acc[nt] = (f32x4){0.f, 0.f, 0.f, 0.f};
        if (K == DFF) mini_mma<4, 8>(A, K, Bt, K, r0, c0, wave * kw, (wave + 1) * kw, acc, lane);
        else mini_mma<4, 4>(A, K, Bt, K, r0, c0, wave * kw, (wave + 1) * kw, acc, lane);
        float* d = part + ((size_t)wave * 64 + lane) * 17;
#pragma unroll
        for (int nt = 0; nt < 4; ++nt)
#pragma unroll
            for (int j = 0; j < 4; ++j) d[nt * 4 + j] = acc[nt][j];
        __syncthreads();
#pragma unroll
        for (int vv = 0; vv < 2; ++vv) {
            const int v = 2 * wave + vv, nt = v >> 2, j = v & 3;
            float s = 0.f;
#pragma unroll
            for (int w2 = 0; w2 < 8; ++w2) s += part[((size_t)w2 * 64 + lane) * 17 + v];
            const int rl = 4 * quad + j, cl = 16 * nt + fr;
            const size_t off = (size_t)(r0 + rl) * DM + c0 + cl;
            const float xn = bf2f(XB[off]) + s;
            if (live) { if (last) Y[off] = xn; else XB[off] = f2bf(xn); } tile[rl * 65 + cl] = xn;
        }
        __syncthreads();
        if (tid < 16) {
            float sq = 0.f;
            for (int c = 0; c < 64; ++c) { const float v = tile[tid * 65 + c]; sq += v * v; }
            if (live && !last) SS[(size_t)(r0 + tid) * 16 + ct] = sq;
        }
        __syncthreads();
    }
}
DEV void mini_up(const bf16_t* XB, const bf16_t* Bt, const float* SS, bf16_t* H) {
    const int tid = otid(), lane = tid & 63, wave = tid >> 6, fr = lane & 15, quad = lane >> 4;
    for (int t = blockIdx.x; t < 256; t += gridDim.x) {
        const int r0 = NPR + 16 * (t >> 4), c0 = 256 * (t & 15) + 32 * wave;
        f32x4 acc[2];
        acc[0] = (f32x4){0.f, 0.f, 0.f, 0.f}; acc[1] = acc[0];
        mini_mma<2, 16>(XB, DM, Bt, DM, r0, c0, 0, DM, acc, lane);
#pragma unroll
        for (int j = 0; j < 4; ++j) {
            const int row = r0 + 4 * quad + j;
            const float rstd = row_rstd(SS, row);
#pragma unroll
            for (int nt = 0; nt < 2; ++nt) { const float r = fmaxf(acc[nt][j] * rstd, 0.f); H[(size_t)row * DFF + c0 + 16 * nt + fr] = f2bf(r * r); }
        }
    }
}

__global__ void __launch_bounds__(NTHREADS) hybrid_fwd(Params p) {
    extern __shared__ __attribute__((aligned(16))) unsigned char lds[];
    cg::grid_group grid = cg::this_grid();
    PG8_LAS unsigned char* l3 = (PG8_LAS unsigned char*)lds;
    unsigned char* ws = p.ws;
    bf16_t* XB = (bf16_t*)(ws + WS_XB); float* SS = (float*)(ws + WS_SS);
    if (threadIdx.x < 4) ((LAS unsigned*)(l3 + LDS_BYTES - 16))[threadIdx.x] = 0u;
    __syncthreads();
    const XcdBarrier bar = xcd_barrier_post((unsigned*)(ws + WS_BAR), (volatile LAS unsigned*)(l3 + LDS_BYTES - 16));
    for (int ph = p.ph_lo; ph < p.ph_hi; ++ph) {
        if (ph > p.ph_lo) {
            if (p.ph_hi > 64) grid.sync();
            xcd_barrier(bar);
        }
#ifdef PROBE_DUP
        const int nrep = (ph == 0) ? ((PROBE_DUP >> 0) & 1) + 1 : (((PROBE_DUP >> (1 + (ph - 1) % 6)) & 1) + 1);
        for (int rep = 0; rep < nrep; ++rep) {
        if (rep) __syncthreads();
        if (rep && ph > 0 && (ph - 1) % 6 == 2) {
            xcd_barrier(bar);
            if (blockIdx.x == 0 && threadIdx.x == 0) __hip_atomic_store((unsigned*)(ws + WS_BAR) + 3584 + 64 * ((ph - 1) / 6), 0u, __ATOMIC_RELAXED, __HIP_MEMORY_SCOPE_AGENT);
            xcd_barrier(bar);
        }
        const int live = (rep == nrep - 1);
#else
        const int live = 1;
#endif
        if (ph == 0) {
#ifndef NO_P0
            phase_prologue(p, lds);
#endif
            continue; }
        const int l = (ph - 1) / 6, s = (ph - 1) % 6;
        if (s == 0) {
#ifndef NO_S0
            pg8::Gemm g{XB, (const bf16_t*)(ws + WS_WIN + (size_t)l * SZ_WIN1), MT, INWP, DM};
            pg8::StaticOrder S; S.init(MT, INWP, (int)gridDim.x, (int)blockIdx.x);
            EpiIn E{SS, (const float*)(ws + WS_ROPE), p.q_gain, p.k_gain, p.out, ws, l};
            pg8::gemm_phase<EpiIn, pg8::StaticOrder>(l3, g, S, E, nullptr);
#endif
        } else if (s == 1) {
#ifndef NO_S1
            phase_mix_a(p, l, lds);
#endif
        } else if (s == 2) {
#ifndef NO_S2
            phase_attn(p, l, lds);
            xcd_barrier(bar);
            attn_sample_combine(p);
#endif
        } else if (s == 3) {
#ifndef NO_S3
            mini_res((const bf16_t*)(ws + WS_YMIX), (const bf16_t*)(ws + WS_WOUT + (size_t)l * SZ_WOUT1), DM, p.out, XB, SS, lds, 0, live);
            pg8::Gemm g{(const bf16_t*)(ws + WS_YMIX), (const bf16_t*)(ws + WS_WOUT + (size_t)l * SZ_WOUT1), NPR, DM, DM};
            pg8::StaticOrder S; S.init(NPR, DM, (int)gridDim.x, (int)blockIdx.x);
            EpiRes E{p.out, XB, SS, 0, live};
            pg8::gemm_phase<EpiRes, pg8::StaticOrder>(l3, g, S, E, nullptr);
#endif
        } else if (s == 4) {
#ifndef NO_S4
            mini_up(XB, (const bf16_t*)(ws + WS_WUP + (size_t)l * SZ_WUP1), SS, (bf16_t*)(ws + WS_H));
            __syncthreads();
            pg8::Gemm g{XB, (const bf16_t*)(ws + WS_WUP + (size_t)l * SZ_WUP1), NPR, DFF, DM};
            pg8::StaticOrder S; S.init(NPR, DFF, (int)gridDim.x, (int)blockIdx.x);
            EpiUp E{(bf16_t*)(ws + WS_H), SS};
            pg8::gemm_phase<EpiUp, pg8::StaticOrder>(l3, g, S, E, nullptr);
#endif
        } else {
#ifndef NO_S5
            mini_res((const bf16_t*)(ws + WS_H), (const bf16_t*)(ws + WS_WDN + (size_t)l * SZ_WUP1), DFF, p.out, XB, SS, lds, l == 1, live);
            pg8::Gemm g{(const bf16_t*)(ws + WS_H), (const bf16_t*)(ws + WS_WDN + (size_t)l * SZ_WUP1), NPR, DM, DFF};
            pg8::StaticOrder S; S.init(NPR, DM, (int)gridDim.x, (int)blockIdx.x);
            EpiRes E{p.out, XB, SS, l == 1, live};
            pg8::gemm_phase<EpiRes, pg8::StaticOrder>(l3, g, S, E, nullptr);
#endif
        }
#ifdef PROBE_DUP
        }
#endif
    }
}

extern "C" void kernel_launch(void* const* d_in, const int* in_sizes, int n_in, void* d_out, int out_size, void* d_ws, size_t ws_size, hipStream_t stream) {
    static int grid = 0;
    if (grid == 0) {
        if (n_in != 17 || out_size != 35291136 || ws_size < WS_END) { fprintf(stderr, "kernel_launch: unexpected shapes (n_in %d, out %d, ws %zu, need %zu)\n", n_in, out_size, ws_size, (size_t)WS_END); grid = -1; return; }
        int dev = 0, cus = 0, per_cu = 0;
        hipGetDevice(&dev);
        hipDeviceGetAttribute(&cus, hipDeviceAttributeMultiprocessorCount, dev);
        if (hipFuncSetAttribute((const void*)hybrid_fwd, hipFuncAttributeMaxDynamicSharedMemorySize, LDS_BYTES) != hipSuccess) { fprintf(stderr, "kernel_launch: hipFuncSetAttribute failed\n"); grid = -1; return; }
        if (hipOccupancyMaxActiveBlocksPerMultiprocessor(&per_cu, (const void*)hybrid_fwd, NTHREADS, LDS_BYTES) != hipSuccess || per_cu < 1) { fprintf(stderr, "kernel_launch: occupancy query says %d blocks per CU\n", per_cu); grid = -1; return; }
        grid = cus;
        if (per_cu * cus < grid) grid = per_cu * cus;
    }
    if (grid < 0) return;
    Params p{};
    p.x_prompt = (const float*)d_in[0]; p.x_sample = (const float*)d_in[1]; p.cache_k = (const float*)d_in[2]; p.cache_v = (const float*)d_in[3];
    p.cache_kidx = (const float*)d_in[4]; p.state_conv = (const float*)d_in[5]; p.g_mix = (const float*)d_in[6]; p.w_in = (const float*)d_in[7];
    p.q_gain = (const float*)d_in[8]; p.k_gain = (const float*)d_in[9]; p.w_s = (const float*)d_in[10]; p.b_s = (const float*)d_in[11];
    p.conv_w = (const float*)d_in[12]; p.w_out = (const float*)d_in[13]; p.g_ffn = (const float*)d_in[14]; p.w_up = (const float*)d_in[15]; p.w_down = (const float*)d_in[16];
    p.out = (float*)d_out; p.ws = (unsigned char*)d_ws;
    if (hipMemsetAsync((unsigned char*)d_ws + WS_BAR, 0, 16384, stream) != hipSuccess) { fprintf(stderr, "kernel_launch: memset of the barrier words failed\n"); return; }
#if N_LAUNCH_MODE == 1
    p.ph_lo = 0; p.ph_hi = 13;
    void* args[] = {&p};
    hipError_t e = hipLaunchCooperativeKernel((const void*)hybrid_fwd, dim3(grid), dim3(NTHREADS), args, LDS_BYTES, stream);
    if (e != hipSuccess) fprintf(stderr, "kernel_launch: cooperative launch failed: %s (grid %d)\n", hipGetErrorString(e), grid);
#else
    for (int ph = 0; ph < 13; ++ph) {
        p.ph_lo = ph; p.ph_hi = ph + 1;
        hipLaunchKernelGGL(hybrid_fwd, dim3(grid), dim3(NTHREADS), LDS_BYTES, stream, p);
    }
#endif
}
```

```cpp
#include <hip/hip_runtime.h>
#include <hip/hip_cooperative_groups.h>
#include <cstdio>
namespace cg = cooperative_groups;
#ifndef N_LAUNCH_MODE
#define N_LAUNCH_MODE 1
#endif
__device__ __forceinline__ int otid() { int t = (int)threadIdx.x; asm volatile("" : "+v"(t)); return t; }

namespace pg8 {
#define PG8_LAS __attribute__((address_space(3)))
typedef unsigned short bf16_t;
typedef short bf16x8 __attribute__((ext_vector_type(8)));
typedef float f32x4 __attribute__((ext_vector_type(4)));
typedef unsigned u32x4 __attribute__((ext_vector_type(4)));
constexpr int BM = 256, BK = 64, HALF = 128, HTB = HALF * BK * 2  , STAGE_BYTES = 8 * HTB, NXCD = 8, WGM = 8;

__host__ __device__ __forceinline__ int lds_byte(int r, int c) { const int st = (r >> 4) * 2 + (c >> 5), rr = r & 15, cc = c & 31, ob = rr * 64 + cc * 2; return st * 1024 + (ob ^ (((ob >> 9) & 1) << 5)); }
__host__ __device__ __forceinline__ void stage_rc(int b, int& R, int& C) { const int st = b / 1024, sb = b % 1024, swz = sb ^ (((sb >> 9) & 1) << 5); R = (st >> 1) * 16 + swz / 64; C = (st & 1) * 32 + (swz % 64) / 2; }
__host__ __device__ __forceinline__ int perm32(int rho) { const int n = rho >> 4, i = rho & 15; return 8 * (i >> 2) + 4 * n + (i & 3); }

struct Unit { int pm, pn; };
struct Gemm { const bf16_t* A; const bf16_t* Bt; int M, N, K; };

struct StaticOrder {
    int nM, nN, nwg, G, c;
    __host__ __device__ void init(int M, int N, int G_, int c_) { nM = M / BM; nN = N / BM; nwg = nM * nN; G = G_; c = c_; }
    __host__ __device__ bool next(int i, Unit& u) const {
        const long L = (long)i * G + c; if (L >= nwg) return false;
        int wgid = (int)L; { const int q = nwg / NXCD, r = nwg % NXCD, xcd = wgid % NXCD, off = wgid / NXCD; wgid = (xcd < r ? xcd * (q + 1) : r * (q + 1) + (xcd - r) * q) + off; }
        const int nig = WGM * nN, gid = wgid / nig, fm = gid * WGM, gsz = (nM - fm) < WGM ? (nM - fm) : WGM;
        u.pm = fm + ((wgid % nig) % gsz); u.pn = (wgid % nig) / gsz; return true;
    }
    __device__ __forceinline__ void a_ready(const Unit&) const {}
    __device__ __forceinline__ void done(const Unit&) const {}
};
template <class Epi, class Sched, bool STAMP = false>
__device__ __forceinline__ void gemm_phase(PG8_LAS unsigned char* lds, const Gemm g, const Sched& S, const Epi& E, unsigned long long* stamps) {
    const int tid = otid(), wid = __builtin_amdgcn_readfirstlane(tid >> 6), lane = tid & 63, wr = wid >> 2, wc = wid & 3, fr = lane & 15, fq = lane >> 4;
    const int K = g.K, nt = K / BK;
    int ts_lo = 0, ts_hi = 0, nts = 0; const unsigned long long rt_entry = STAMP ? (unsigned long long)wall_clock64() : 0ull;
#define PG8_STAMP() do { if (STAMP && wid == 0 && nts < 64) { const unsigned long long _c = (unsigned long long)clock64(); \
        ts_lo = (lane == nts) ? (int)(unsigned)_c : ts_lo; ts_hi = (lane == nts) ? (int)(unsigned)(_c >> 32) : ts_hi; ++nts; } } while (0)
    PG8_STAMP();
    unsigned voffA[2], voffB[2];
#pragma unroll
    for (int i = 0; i < 2; ++i) { int R, C; stage_rc(tid * 16 + i * 8192, R, C); const int Rb = Epi::PERM ? ((R & ~31) + perm32(R & 31)) : R;
        voffA[i] = (unsigned)(R * K + C) * 2u; voffB[i] = (unsigned)(Rb * K + C) * 2u; }
    const size_t kstep = (size_t)(BK * 2);
    const size_t hstep = (size_t)HALF * K * 2;
    const size_t tstep = 2 * hstep;
    const unsigned ldsw = (unsigned)wid * 1024u;
    const int aoff = lds_byte(wr * 64 + fr, fq * 8), boff = lds_byte(wc * 32 + fr, fq * 8);
#define PG8_SA(b, h) (((b) * 2 + (h)) * HTB)
#define PG8_SB(b, h) ((4 + (b) * 2 + (h)) * HTB)
#define PG8_STAGE(bufoff, gbase, voff) do { _Pragma("unroll") for (int _i = 0; _i < 2; ++_i) \
        __builtin_amdgcn_global_load_lds((const unsigned*)((const char*)(gbase) + (voff)[_i]), (PG8_LAS unsigned*)(lds + (bufoff) + ldsw + _i * 8192), 16, 0, 0); } while (0)
#define PG8_LDA(dst, b, h) do { _Pragma("unroll") for (int m = 0; m < 4; ++m) _Pragma("unroll") for (int k = 0; k < 2; ++k) dst[m][k] = *(const PG8_LAS bf16x8*)(lds + PG8_SA(b, h) + aoff + m * 2048 + k * 1024); } while (0)
#define PG8_LDB(dst, b, h) do { _Pragma("unroll") for (int n = 0; n < 2; ++n) _Pragma("unroll") for (int k = 0; k < 2; ++k) dst[n][k] = *(const PG8_LAS bf16x8*)(lds + PG8_SB(b, h) + boff + n * 2048 + k * 1024); } while (0)
#define PG8_MMA(ai, bj, At, Bt) do { __builtin_amdgcn_s_setprio(1); _Pragma("unroll") for (int m = 0; m < 4; ++m) _Pragma("unroll") for (int n = 0; n < 2; ++n) _Pragma("unroll") for (int k = 0; k < 2; ++k) \
        acc[ai][bj][m][n] = __builtin_amdgcn_mfma_f32_16x16x32_bf16(Bt[n][k], At[m][k], acc[ai][bj][m][n], 0, 0, 0); __builtin_amdgcn_s_setprio(0); } while (0)
#define PG8_WAIT_V(n) asm volatile("s_waitcnt vmcnt(" #n ")" ::: "memory")
#define PG8_WAIT_L(n) asm volatile("s_waitcnt lgkmcnt(" #n ")" ::: "memory")
#define PG8_BAR __builtin_amdgcn_s_barrier()
#define PG8_SCHED __builtin_amdgcn_sched_barrier(0)
    Unit cur, nxt; int ui = 0;
    if (!S.next(0, cur)) return;
    f32x4 acc[2][2][4][2];
#pragma unroll
    for (int a = 0; a < 2; ++a)
#pragma unroll
        for (int b = 0; b < 2; ++b)
#pragma unroll
            for (int m = 0; m < 4; ++m)
#pragma unroll
                for (int n = 0; n < 2; ++n) acc[a][b][m][n] = (f32x4){0.f, 0.f, 0.f, 0.f};
    bf16x8 At[4][2], B0[2][2], B1[2][2];
    const char* cA = (const char*)g.A + (size_t)cur.pm * tstep; const char* cB = (const char*)g.Bt + (size_t)cur.pn * tstep;
    S.a_ready(cur);
    PG8_STAGE(PG8_SB(0, 0), cB, voffB); PG8_STAGE(PG8_SA(0, 0), cA, voffA); PG8_STAGE(PG8_SB(0, 1), cB + hstep, voffB); PG8_STAGE(PG8_SA(0, 1), cA + hstep, voffA);
    if (wr == 1) PG8_BAR;
    PG8_WAIT_V(4); PG8_BAR;
    PG8_STAGE(PG8_SB(1, 0), cB + kstep, voffB); PG8_STAGE(PG8_SA(1, 0), cA + kstep, voffA); PG8_STAGE(PG8_SB(1, 1), cB + hstep + kstep, voffB);
    PG8_WAIT_V(6); PG8_BAR;
    PG8_STAMP();
    for (;;) {
        const bool has_next = S.next(ui + 1, nxt);
        const char* nA = has_next ? (const char*)g.A + (size_t)nxt.pm * tstep : cA; const char* nB = has_next ? (const char*)g.Bt + (size_t)nxt.pn * tstep : cB;
        for (int t = 0; t < nt; t += 2) {
            const bool last = (t == nt - 2);
            const char* a1 = cA + (size_t)(t + 1) * kstep;
            const char* a2 = last ? nA : cA + (size_t)(t + 2) * kstep; const char* b2 = last ? nB : cB + (size_t)(t + 2) * kstep;
            const char* a3 = a2 + kstep; const char* b3 = b2 + kstep;
            if (last && has_next) S.a_ready(nxt);
            PG8_LDB(B0, 0, 0); PG8_SCHED; PG8_LDA(At, 0, 0); PG8_STAGE(PG8_SA(1, 1), a1 + hstep, voffA);
            PG8_WAIT_L(8); PG8_BAR; PG8_WAIT_L(0); PG8_MMA(0, 0, At, B0); PG8_BAR; PG8_SCHED;
            PG8_LDB(B1, 0, 1); PG8_STAGE(PG8_SB(0, 0), b2, voffB);
            PG8_BAR; PG8_WAIT_L(0); PG8_MMA(0, 1, At, B1); PG8_BAR;
            PG8_LDA(At, 0, 1); PG8_STAGE(PG8_SA(0, 0), a2, voffA);
            PG8_BAR; PG8_WAIT_L(0); PG8_MMA(1, 0, At, B0); PG8_BAR; PG8_SCHED;
            PG8_STAGE(PG8_SB(0, 1), b2 + hstep, voffB);
            PG8_WAIT_V(6); PG8_BAR; PG8_MMA(1, 1, At, B1); PG8_BAR;
            PG8_LDB(B0, 1, 0); PG8_SCHED; PG8_LDA(At, 1, 0); PG8_STAGE(PG8_SA(0, 1), a2 + hstep, voffA);
            PG8_WAIT_L(8); PG8_BAR; PG8_WAIT_L(0); PG8_MMA(0, 0, At, B0); PG8_BAR; PG8_SCHED;
            PG8_LDB(B1, 1, 1); PG8_STAGE(PG8_SB(1, 0), b3, voffB);
            PG8_BAR; PG8_WAIT_L(0); PG8_MMA(0, 1, At, B1); PG8_BAR;
            PG8_LDA(At, 1, 1); PG8_STAGE(PG8_SA(1, 0), a3, voffA);
            PG8_BAR; PG8_WAIT_L(0); PG8_MMA(1, 0, At, B0); PG8_BAR; PG8_SCHED;
            PG8_STAGE(PG8_SB(1, 1), b3 + hstep, voffB);
            PG8_WAIT_V(6); PG8_BAR; PG8_MMA(1, 1, At, B1); PG8_BAR;
        }
        PG8_STAMP();
        if constexpr (!Epi::AFTER_DRAIN) { E(acc, cur, wr, wc, fr, fq); S.done(cur); }
        PG8_STAMP();
        if (!has_next) break;
#pragma unroll
        for (int a = 0; a < 2; ++a)
#pragma unroll
            for (int b = 0; b < 2; ++b)
#pragma unroll
                for (int m = 0; m < 4; ++m)
#pragma unroll
                    for (int n = 0; n < 2; ++n) acc[a][b][m][n] = (f32x4){0.f, 0.f, 0.f, 0.f};
        cur = nxt; cA = nA; cB = nB; ++ui;
    }
    PG8_WAIT_V(0);
    if (wr == 0) PG8_BAR;
    PG8_BAR;
    if constexpr (Epi::AFTER_DRAIN) { E.fused(acc, cur, wr, wc, fr, fq, lds, wid, lane); S.done(cur); }
    PG8_STAMP();
    if (STAMP && wid == 0) { stamps[lane] = lane < nts ? (((unsigned long long)(unsigned)ts_hi << 32) | (unsigned)ts_lo) : 0ull;
        if (lane == 62) stamps[62] = rt_entry; if (lane == 63) stamps[63] = (unsigned long long)wall_clock64(); }
#undef PG8_STAMP
#undef PG8_SA
#undef PG8_SB
#undef PG8_STAGE
#undef PG8_LDA
#undef PG8_LDB
#undef PG8_MMA
#undef PG8_WAIT_V
#undef PG8_WAIT_L
#undef PG8_BAR
#undef PG8_SCHED
}
}

using pg8::bf16_t; using pg8::bf16x8; using pg8::f32x4; using pg8::u32x4;
typedef float f32x16 __attribute__((ext_vector_type(16)));
typedef unsigned u32x2 __attribute__((ext_vector_type(2)));
typedef unsigned long long u64;
#define DEV __device__ __forceinline__

constexpr int DM = 1024, TP = 2048, NPR = 16384, NSR = 256, MT = 16640, INW = 2600, INWP = 2816, DFF = 4096, PAST = 4096, LS = 4128, LSP = 4160, TPV = 2112;
constexpr int NTHREADS = 512;
constexpr int LDS_BYTES = 139264;
constexpr size_t O_YP = 0, O_YS = 16777216, O_KP = 17039360, O_VP = 25427968, O_KIP = 33816576, O_CP = 34865152, O_KS = 34873344, O_VS = 35004416, O_KIS = 35135488, O_CS = 35151872, O_SGV = 35160064;
constexpr size_t WS_WIN = 0, SZ_WIN1 = (size_t)INWP * DM * 2;
constexpr size_t WS_WOUT = WS_WIN + 2 * SZ_WIN1, SZ_WOUT1 = (size_t)DM * DM * 2;
constexpr size_t WS_WUP = WS_WOUT + 2 * SZ_WOUT1, SZ_WUP1 = (size_t)DFF * DM * 2;
constexpr size_t WS_WDN = WS_WUP + 2 * SZ_WUP1;
constexpr size_t WS_XB = WS_WDN + 2 * SZ_WUP1;
constexpr size_t WS_SS = WS_XB + (size_t)MT * DM * 2;
constexpr size_t WS_ROPE = WS_SS + (size_t)MT * 16 * 4;
constexpr size_t WS_WI = WS_ROPE + (size_t)2080 * 64 * 4;
constexpr size_t WS_KS = WS_WI + (size_t)MT * 8 * 4, SZ_KS1 = (size_t)8 * 4 * LSP * 64 * 2;
constexpr size_t WS_VTS = WS_KS + 2 * SZ_KS1;
constexpr size_t WS_KIS = WS_VTS + 2 * SZ_KS1, SZ_KIS1 = (size_t)8 * LSP * 32 * 2;
constexpr size_t WS_BMP = WS_KIS + 2 * SZ_KIS1;
constexpr size_t WS_BMS = WS_BMP + (size_t)NPR * 32 * 8;
constexpr size_t WS_BAR = WS_BMS + (size_t)NSR * 72 * 8;
constexpr size_t WS_PART = WS_BAR + 16384;
constexpr size_t SZ_PARTO = (size_t)8 * 4 * 4 * 64 * 64 * 4;
constexpr size_t WS_MIX = WS_PART + SZ_PARTO + (size_t)8 * 4 * 4 * 64 * 4;
constexpr size_t WS_H = WS_MIX;
constexpr size_t WS_YMIX = WS_MIX;
constexpr size_t WS_ZB = WS_YMIX + (size_t)MT * 1024 * 2;
constexpr size_t WS_QB = WS_ZB + (size_t)MT * 768 * 2;
constexpr size_t WS_ZAU = WS_QB + (size_t)MT * 512 * 2;
constexpr size_t WS_SGVT = WS_ZAU + (size_t)MT * 256 * 2;
constexpr size_t WS_QIB = WS_SGVT + (size_t)MT * 256 * 2;
constexpr size_t WS_KP = WS_QIB + (size_t)MT * 256 * 2;
constexpr size_t WS_VTP = WS_KP + (size_t)8 * 4 * TP * 64 * 2;
constexpr size_t WS_KIP = WS_VTP + (size_t)8 * 4 * TPV * 64 * 2;
constexpr size_t WS_MIX_END = WS_KIP + (size_t)8 * TP * 32 * 2;
constexpr size_t WS_END = WS_H + (size_t)MT * DFF * 2;
static_assert(WS_MIX_END <= WS_END, "mixer intermediates must fit inside the H alias");
static_assert(WS_XB % 256 == 0 && WS_SS % 256 == 0 && WS_ROPE % 256 == 0 && WS_WI % 256 == 0 && WS_KS % 256 == 0 && WS_VTS % 256 == 0 && WS_KIS % 256 == 0 && WS_BMP % 256 == 0 && WS_BMS % 256 == 0 && WS_MIX % 256 == 0, "align");
static_assert(WS_ZB % 256 == 0 && WS_QB % 256 == 0 && WS_ZAU % 256 == 0 && WS_SGVT % 256 == 0 && WS_QIB % 256 == 0 && WS_KP % 256 == 0 && WS_VTP % 256 == 0 && WS_KIP % 256 == 0, "align2");

struct Params {
    const float* x_prompt; const float* x_sample; const float* cache_k; const float* cache_v; const float* cache_kidx; const float* state_conv;
    const float* g_mix; const float* w_in; const float* q_gain; const float* k_gain; const float* w_s; const float* b_s; const float* conv_w;
    const float* w_out; const float* g_ffn; const float* w_up; const float* w_down;
    float* out; unsigned char* ws;
    int ph_lo, ph_hi;
};

__constant__ float c_invf[32] = {1.000000000e+00f, 7.498942614e-01f, 5.623413324e-01f, 4.216965139e-01f, 3.162277639e-01f, 2.371373773e-01f, 1.778279394e-01f, 1.333521307e-01f, 1.000000015e-01f, 7.498941571e-02f, 5.623413250e-02f, 4.216965288e-02f, 3.162277490e-02f, 2.371373773e-02f, 1.778279431e-02f, 1.333521493e-02f, 9.999999776e-03f, 7.498941850e-03f, 5.623413250e-03f, 4.216964822e-03f, 3.162277630e-03f, 2.371373586e-03f, 1.778279431e-03f, 1.333521446e-03f, 1.000000047e-03f, 7.498942432e-04f, 5.623413017e-04f, 4.216965172e-04f, 3.162277571e-04f, 2.371373703e-04f, 1.778279402e-04f, 1.333521504e-04f};

DEV float bf2f(unsigned short h) { return __uint_as_float((unsigned)h << 16); }
typedef __bf16 bf16v2_t __attribute__((ext_vector_type(2)));
typedef float f32v2_t __attribute__((ext_vector_type(2)));
DEV unsigned pk2(float lo, float hi) { return __builtin_bit_cast(unsigned, __builtin_convertvector((f32v2_t){lo, hi}, bf16v2_t)); }
DEV unsigned short f2bf(float x) { return (unsigned short)(pk2(x, 0.f) & 0xffffu); }
DEV u32x4 pack8(const float (&v)[8]) { u32x4 w; w.x = pk2(v[0], v[1]); w.y = pk2(v[2], v[3]); w.z = pk2(v[4], v[5]); w.w = pk2(v[6], v[7]); return w; }
DEV float gelu_tanh(float x) {
    const float y = 0.7978845608028654f * (x + 0.044715f * x * x * x);
    const float e = __builtin_amdgcn_exp2f(-2.0f * 1.4426950408889634f * y);
    return x * __builtin_amdgcn_rcpf(1.0f + e);
}
DEV float wave_sum(float v) {
#pragma unroll
    for (int o = 32; o > 0; o >>= 1) v += __shfl_xor(v, o);
    return v;
}
DEV float wave_max(float v) {
#pragma unroll
    for (int o = 32; o > 0; o >>= 1) v = fmaxf(v, __shfl_xor(v, o));
    return v;
}

#define XB_TMO      128
#define XB_XCNT(j)  (256  + 64 * (j))
#define XB_XSUB(j)  (1280 + 64 * (j))
#define XB_XGEN(j)  (2304 + 64 * (j))
#define XB_TOP      3328
#define XB_TOPGEN   3392
#define XCD_BAR_WORDS 3456
#define XB_SPIN_CAP (1u << 18)
#define LAS __attribute__((address_space(3)))

__device__ __forceinline__ unsigned xb_ld(unsigned* p)              { return __hip_atomic_load(p, __ATOMIC_RELAXED, __HIP_MEMORY_SCOPE_AGENT); }
__device__ __forceinline__ unsigned xb_add(unsigned* p, unsigned v) { return __hip_atomic_fetch_add(p, v, __ATOMIC_RELAXED, __HIP_MEMORY_SCOPE_AGENT); }
__device__ __forceinline__ unsigned xb_xcc_id() { return (unsigned)__builtin_amdgcn_s_getreg((3 << 11) | 20) & 0xFu; }
#define XB_SPIN(cond, bar) do { unsigned _sp = 0; while (cond) { __builtin_amdgcn_s_sleep(1); \
    if ((++_sp & 255u) == 0u) { if (xb_ld(&(bar)[XB_TMO])) break; if (_sp > XB_SPIN_CAP) { atomicAdd(&(bar)[XB_TMO], 1u); break; } } } } while (0)

struct XcdBarrier {
    unsigned* bar; unsigned x;
    volatile LAS unsigned* st;
};

__device__ __forceinline__ XcdBarrier xcd_barrier_post(unsigned* bar, volatile LAS unsigned* st) {
    XcdBarrier b; b.bar = bar; b.x = xb_xcc_id(); b.st = st;
    if (threadIdx.x == 0) (void)xb_add(&bar[XB_XCNT(b.x)], 1u);
    return b;
}
__device__ __forceinline__ void xcd_barrier_complete(unsigned* bar, unsigned x, unsigned& nloc, unsigned& nx) {
    const unsigned G = gridDim.x * gridDim.y * gridDim.z;
    unsigned sum, cnt, mine, sp = 0u;
    for (;;) {
        sum = 0u; cnt = 0u; mine = 0u;
#pragma unroll
        for (unsigned j = 0; j < 16; ++j) { const unsigned c = xb_ld(&bar[XB_XCNT(j)]); sum += c; cnt += (c > 0u) ? 1u : 0u; mine = (j == x) ? c : mine; }
        if (sum == G) break;
        __builtin_amdgcn_s_sleep(1);
        if ((++sp & 255u) == 0u) { if (xb_ld(&bar[XB_TMO])) break; if (sp > XB_SPIN_CAP) { atomicAdd(&bar[XB_TMO], 1u); break; } }
    }
    nloc = mine > 0u ? mine : 1u; nx = cnt > 0u ? cnt : 1u;
}

__device__ __forceinline__ void xcd_barrier(const XcdBarrier& b) {
    asm volatile("s_waitcnt vmcnt(0)" ::: "memory");
    __syncthreads();
    if (threadIdx.x == 0) {
        unsigned* bar = b.bar;
        __builtin_amdgcn_s_waitcnt(0);
        unsigned nloc = b.st[0], nx = b.st[1];
        if (nloc == 0u) { xcd_barrier_complete(bar, b.x, nloc, nx); b.st[0] = nloc; b.st[1] = nx; }
        const unsigned old = xb_add(&bar[XB_XSUB(b.x)], 1u);
        const unsigned gen = old / nloc;
        if (old + 1u == (gen + 1u) * nloc) {
            __builtin_amdgcn_fence(__ATOMIC_RELEASE, "agent");
            asm volatile("s_waitcnt vmcnt(0)" ::: "memory");
            const unsigned og = xb_add(&bar[XB_TOP], 1u);
            const unsigned tg = og / nx;
            if (og + 1u == (tg + 1u) * nx) xb_add(&bar[XB_TOPGEN], 1u);
            else XB_SPIN(xb_ld(&bar[XB_TOPGEN]) == tg, bar);
            __builtin_amdgcn_fence(__ATOMIC_ACQUIRE, "agent");
            xb_add(&bar[XB_XGEN(b.x)], 1u);
            asm volatile("s_waitcnt vmcnt(0)" ::: "memory");
        } else {
            XB_SPIN(xb_ld(&bar[XB_XGEN(b.x)]) == gen, bar);
            __builtin_amdgcn_fence(__ATOMIC_ACQUIRE, "agent");
            asm volatile("s_waitcnt vmcnt(0)" ::: "memory");
        }
    }
    __syncthreads();
}


DEV float row_rstd(const float* ss, int row) {
    const f32x4* sp = (const f32x4*)(ss + (size_t)row * 16);
    const f32x4 a = sp[0], b = sp[1], c = sp[2], d = sp[3];
    const float t = ((a[0] + a[1]) + (a[2] + a[3])) + ((b[0] + b[1]) + (b[2] + b[3])) + ((c[0] + c[1]) + (c[2] + c[3])) + ((d[0] + d[1]) + (d[2] + d[3]));
    return rsqrtf(t * (1.0f / 1024.0f) + 1e-6f);
}

struct EpiIn {
    static constexpr bool PERM = false, AFTER_DRAIN = false;
    const float* ss; const float* rope; const float* qg; const float* kg; float* out; unsigned char* ws; int layer;
    __device__ __forceinline__ void operator()(const f32x4 (&acc)[2][2][4][2], const pg8::Unit& u, int wr, int wc, int fr, int fq0) const {
        const int pn = u.pn, pm = u.pm;
        const bool samp = (pm == 64);
        bf16_t* ZAU = (bf16_t*)(ws + WS_ZAU); bf16_t* SGVT = (bf16_t*)(ws + WS_SGVT); bf16_t* ZB = (bf16_t*)(ws + WS_ZB); bf16_t* QB = (bf16_t*)(ws + WS_QB);
        bf16_t* QIB = (bf16_t*)(ws + WS_QIB); float* WI = (float*)(ws + WS_WI);
#pragma unroll
        for (int ai = 0; ai < 2; ++ai)
#pragma unroll
            for (int m = 0; m < 4; ++m) {
                int row = pm * 256 + ai * 128 + wr * 64 + m * 16 + fr, fq = fq0;
                asm volatile("" : "+v"(row), "+v"(fq));
                const float rstd = row_rstd(ss, row);
                int b, t, posidx; const int rs = row - NPR;
                if (!samp) { b = row >> 11; t = row & 2047; posidx = t; } else { b = rs >> 5; t = rs & 31; posidx = 2048 + t; }
                float lo[8], hi[8];
#pragma unroll
                for (int bj = 0; bj < 2; ++bj)
#pragma unroll
                    for (int n = 0; n < 2; ++n)
#pragma unroll
                        for (int jp = 0; jp < 2; ++jp) { lo[4 * bj + 2 * n + jp] = acc[ai][bj][m][n][2 * jp] * rstd; hi[4 * bj + 2 * n + jp] = acc[ai][bj][m][n][2 * jp + 1] * rstd; }
                if (pn == 0) {
#pragma unroll
                    for (int e = 0; e < 8; ++e) { lo[e] = gelu_tanh(lo[e]); hi[e] = gelu_tanh(hi[e]); }
                    bf16_t* d = ZAU + (size_t)row * 256 + 64 * wc + 8 * fq;
                    *(u32x4*)d = pack8(lo); *(u32x4*)(d + 32) = pack8(hi);
                } else if (pn == 1) {
#pragma unroll
                    for (int e = 0; e < 8; ++e) { lo[e] = gelu_tanh(lo[e]); hi[e] = gelu_tanh(hi[e]); }
#pragma unroll
                    for (int e = 0; e < 8; ++e) {
                        SGVT[(size_t)(64 * wc + 8 * fq + e) * MT + row] = f2bf(lo[e]);
                        SGVT[(size_t)(64 * wc + 32 + 8 * fq + e) * MT + row] = f2bf(hi[e]);
                    }
                    if (samp) {
                        float* d = out + O_SGV + ((size_t)layer * NSR + rs) * 256 + 64 * wc + 8 * fq;
                        *(f32x4*)d = (f32x4){lo[0], lo[1], lo[2], lo[3]}; *(f32x4*)(d + 4) = (f32x4){lo[4], lo[5], lo[6], lo[7]};
                        *(f32x4*)(d + 32) = (f32x4){hi[0], hi[1], hi[2], hi[3]}; *(f32x4*)(d + 36) = (f32x4){hi[4], hi[5], hi[6], hi[7]};
                    }
                } else if (pn <= 4) {
                    bf16_t* d = ZB + (size_t)row * 768 + 256 * (pn - 2) + 64 * wc + 8 * fq;
                    *(u32x4*)d = pack8(lo); *(u32x4*)(d + 32) = pack8(hi);
                } else if (pn <= 7) {
                    float sq = 0.f;
#pragma unroll
                    for (int e = 0; e < 8; ++e) sq += lo[e] * lo[e] + hi[e] * hi[e];
                    sq += __shfl_xor(sq, 16); sq += __shfl_xor(sq, 32);
                    const float rh = rsqrtf(sq * (1.0f / 64.0f) + 1e-6f);
                    const float* cs = rope + (size_t)posidx * 64 + 8 * fq;
                    const f32x4 c0 = *(const f32x4*)cs, c1 = *(const f32x4*)(cs + 4), s0 = *(const f32x4*)(cs + 32), s1 = *(const f32x4*)(cs + 36);
                    const float* gp = (pn == 7 ? kg : qg) + layer * 64 + 8 * fq;
                    const f32x4 g0 = *(const f32x4*)gp, g1 = *(const f32x4*)(gp + 4), g2 = *(const f32x4*)(gp + 32), g3 = *(const f32x4*)(gp + 36);
                    float ol[8], oh[8];
#pragma unroll
                    for (int e = 0; e < 8; ++e) {
                        const float co = e < 4 ? c0[e & 3] : c1[e & 3], si = e < 4 ? s0[e & 3] : s1[e & 3];
                        const float a = lo[e] * rh * (e < 4 ? g0[e & 3] : g1[e & 3]), bb = hi[e] * rh * (e < 4 ? g2[e & 3] : g3[e & 3]);
                        ol[e] = a * co - bb * si; oh[e] = bb * co + a * si;
                    }
                    if (pn < 7) {
#pragma unroll
                        for (int e = 0; e < 8; ++e) { ol[e] *= 0.125f * 1.4426950408889634f; oh[e] *= 0.125f * 1.4426950408889634f; }
                        bf16_t* d = QB + (size_t)row * 512 + (4 * (pn - 5) + wc) * 64 + 8 * fq;
                        *(u32x4*)d = pack8(ol); *(u32x4*)(d + 32) = pack8(oh);
                    } else {
                        float* d = samp ? out + O_KS + ((size_t)layer * NSR + rs) * 256 + 64 * wc + 8 * fq : out + O_KP + ((size_t)layer * NPR + row) * 256 + 64 * wc + 8 * fq;
                        *(f32x4*)d = (f32x4){ol[0], ol[1], ol[2], ol[3]}; *(f32x4*)(d + 4) = (f32x4){ol[4], ol[5], ol[6], ol[7]};
                        *(f32x4*)(d + 32) = (f32x4){oh[0], oh[1], oh[2], oh[3]}; *(f32x4*)(d + 36) = (f32x4){oh[4], oh[5], oh[6], oh[7]};
                        if (!samp) {
                            bf16_t* kb = (bf16_t*)(ws + WS_KP) + ((size_t)(b * 4 + wc) * TP + t) * 64 + 8 * fq;
                            *(u32x4*)kb = pack8(ol); *(u32x4*)(kb + 32) = pack8(oh);
                        }
                    }
                } else if (pn == 8) {
                    float* d = samp ? out + O_VS + ((size_t)layer * NSR + rs) * 256 + 64 * wc + 8 * fq : out + O_VP + ((size_t)layer * NPR + row) * 256 + 64 * wc + 8 * fq;
                    *(f32x4*)d = (f32x4){lo[0], lo[1], lo[2], lo[3]}; *(f32x4*)(d + 4) = (f32x4){lo[4], lo[5], lo[6], lo[7]};
                    *(f32x4*)(d + 32) = (f32x4){hi[0], hi[1], hi[2], hi[3]}; *(f32x4*)(d + 36) = (f32x4){hi[4], hi[5], hi[6], hi[7]};
                    if (!samp) {
                        bf16_t* vt = (bf16_t*)(ws + WS_VTP) + (size_t)(b * 4 + wc) * 64 * TPV + t;
#pragma unroll
                        for (int e = 0; e < 8; ++e) { vt[(size_t)(8 * fq + e) * TPV] = f2bf(lo[e]); vt[(size_t)(32 + 8 * fq + e) * TPV] = f2bf(hi[e]); }
                    }
                } else {
                    const float* cs = rope + (size_t)posidx * 64 + 8 * fq;
                    const f32x4 c0 = *(const f32x4*)cs, c1 = *(const f32x4*)(cs + 4), s0 = *(const f32x4*)(cs + 32), s1 = *(const f32x4*)(cs + 36);
                    const float co[4] = {c0[0], c0[2], c1[0], c1[2]}, si[4] = {s0[0], s0[2], s1[0], s1[2]};
                    float ol[8], oh[8];
#pragma unroll
                    for (int e = 0; e < 8; ++e) { ol[e] = lo[e] * co[e & 3] - hi[e] * si[e & 3]; oh[e] = hi[e] * co[e & 3] + lo[e] * si[e & 3]; }
                    if (pn == 9) {
#pragma unroll
                        for (int bj = 0; bj < 2; ++bj) {
                            bf16_t* d = QIB + (size_t)row * 256 + 32 * (2 * wc + bj) + 4 * fq;
                            *(u32x2*)d = (u32x2){pk2(ol[4 * bj], ol[4 * bj + 1]), pk2(ol[4 * bj + 2], ol[4 * bj + 3])};
                            *(u32x2*)(d + 16) = (u32x2){pk2(oh[4 * bj], oh[4 * bj + 1]), pk2(oh[4 * bj + 2], oh[4 * bj + 3])};
                        }
                    } else if (wc == 0) {
                        float* d = samp ? out + O_KIS + ((size_t)layer * NSR + rs) * 32 + 4 * fq : out + O_KIP + ((size_t)layer * NPR + row) * 32 + 4 * fq;
                        *(f32x4*)d = (f32x4){ol[0], ol[1], ol[2], ol[3]}; *(f32x4*)(d + 16) = (f32x4){oh[0], oh[1], oh[2], oh[3]};
                        bf16_t* kb = samp ? (bf16_t*)(ws + WS_KIS + (size_t)layer * SZ_KIS1) + ((size_t)b * LSP + PAST + t) * 32 + 4 * fq
                                          : (bf16_t*)(ws + WS_KIP) + (size_t)row * 32 + 4 * fq;
                        *(u32x2*)kb = (u32x2){pk2(ol[0], ol[1]), pk2(ol[2], ol[3])};
                        *(u32x2*)(kb + 16) = (u32x2){pk2(oh[0], oh[1]), pk2(oh[2], oh[3])};
                        if (fq < 2) *(f32x4*)(WI + (size_t)row * 8 + 4 * fq) = (f32x4){lo[4] * 0.0625f, lo[5] * 0.0625f, lo[6] * 0.0625f, lo[7] * 0.0625f};
                    }
                }
                asm volatile("" ::: "memory");
            }
    }
};

struct EpiRes {
    static constexpr bool PERM = true, AFTER_DRAIN = false;
    float* Y; bf16_t* XB; float* ss; int last; int live;
    __device__ __forceinline__ void operator()(const f32x4 (&acc)[2][2][4][2], const pg8::Unit& u, int wr, int wc, int fr, int fq0) const {
        if (!live) return;
#pragma unroll
        for (int ai = 0; ai < 2; ++ai) {
            u32x4 xin[4][2];
#pragma unroll
            for (int m = 0; m < 4; ++m) {
                int row = u.pm * 256 + ai * 128 + wr * 64 + m * 16 + fr, fq = fq0;
                asm volatile("" : "+v"(row), "+v"(fq));
#pragma unroll
                for (int bj = 0; bj < 2; ++bj) xin[m][bj] = *(const u32x4*)(XB + (size_t)row * DM + u.pn * 256 + 128 * bj + 32 * wc + 8 * fq);
            }
#pragma unroll
            for (int m = 0; m < 4; ++m) {
                int row = u.pm * 256 + ai * 128 + wr * 64 + m * 16 + fr, fq = fq0;
                asm volatile("" : "+v"(row), "+v"(fq));
                float sq = 0.f;
#pragma unroll
                for (int bj = 0; bj < 2; ++bj) {
                    const size_t off = (size_t)row * DM + u.pn * 256 + 128 * bj + 32 * wc + 8 * fq;
                    const u32x4 xb = xin[m][bj];
                    f32x4 x0 = (f32x4){__uint_as_float(xb[0] << 16), __uint_as_float(xb[0] & 0xffff0000u), __uint_as_float(xb[1] << 16), __uint_as_float(xb[1] & 0xffff0000u)};
                    f32x4 x1 = (f32x4){__uint_as_float(xb[2] << 16), __uint_as_float(xb[2] & 0xffff0000u), __uint_as_float(xb[3] << 16), __uint_as_float(xb[3] & 0xffff0000u)};
                    x0 += acc[ai][bj][m][0]; x1 += acc[ai][bj][m][1];
                    if (last) { *(f32x4*)(Y + off) = x0; *(f32x4*)(Y + off + 4) = x1; }
                    else {
                        *(u32x4*)(XB + off) = (u32x4){pk2(x0[0], x0[1]), pk2(x0[2], x0[3]), pk2(x1[0], x1[1]), pk2(x1[2], x1[3])};
                        sq += ((x0[0] * x0[0] + x0[1] * x0[1]) + (x0[2] * x0[2] + x0[3] * x0[3])) + ((x1[0] * x1[0] + x1[1] * x1[1]) + (x1[2] * x1[2] + x1[3] * x1[3]));
                    }
                }
                if (!last) {
                    sq += __shfl_xor(sq, 16); sq += __shfl_xor(sq, 32);
                    if (fq0 == 0) ss[(size_t)row * 16 + u.pn * 4 + wc] = sq;
                }
            }
            asm volatile("" ::: "memory");
        }
    }
};

struct EpiUp {
    static constexpr bool PERM = true, AFTER_DRAIN = false;
    bf16_t* H; const float* ss;
    __device__ __forceinline__ void operator()(const f32x4 (&acc)[2][2][4][2], const pg8::Unit& u, int wr, int wc, int fr, int fq0) const {
#pragma unroll
        for (int ai = 0; ai < 2; ++ai) {
            float rs[4];
#pragma unroll
            for (int m = 0; m < 4; ++m) {
                int row = u.pm * 256 + ai * 128 + wr * 64 + m * 16 + fr;
                asm volatile("" : "+v"(row));
                rs[m] = row_rstd(ss, row);
            }
#pragma unroll
            for (int m = 0; m < 4; ++m) {
                int row = u.pm * 256 + ai * 128 + wr * 64 + m * 16 + fr, fq = fq0;
                asm volatile("" : "+v"(row), "+v"(fq));
                const float rstd = rs[m];
#pragma unroll
                for (int bj = 0; bj < 2; ++bj) {
                    const size_t off = (size_t)row * DFF + u.pn * 256 + 128 * bj + 32 * wc + 8 * fq;
                    float v[8];
#pragma unroll
                    for (int j = 0; j < 4; ++j) { const float r0 = fmaxf(acc[ai][bj][m][0][j] * rstd, 0.f), r1 = fmaxf(acc[ai][bj][m][1][j] * rstd, 0.f); v[j] = r0 * r0; v[4 + j] = r1 * r1; }
                    *(u32x4*)(H + off) = pack8(v);
                }
            }
            asm volatile("" ::: "memory");
        }
    }
};

DEV int win_colmap(int cg) {
    const int pn = cg >> 8, r = cg & 255, bj = r >> 7, wc = (r >> 5) & 3, n = (r >> 4) & 1, fq = (r >> 2) & 3, jp = (r >> 1) & 1, s = r & 1;
    int o;
    if (pn < 9) o = 256 * pn + 64 * wc + 32 * s + 8 * fq + 4 * bj + 2 * n + jp;
    else o = 256 * pn + 32 * (2 * wc + bj) + 16 * s + 4 * fq + 2 * n + jp;
    return o < INW ? o : -1;
}
DEV void sincos_acc(float ang, float& c, float& s) {
    const double x = (double)ang, twopi = 6.283185307179586476925287;
    const double k = __builtin_rint(x * (1.0 / twopi));
    const double r = x - k * twopi, r2 = r * r;
    double sp = 1.0, cp = 1.0;
#pragma unroll
    for (int i = 14; i >= 1; --i) { sp = 1.0 - sp * r2 / (double)((2 * i) * (2 * i + 1)); cp = 1.0 - cp * r2 / (double)((2 * i - 1) * (2 * i)); }
    s = (float)(r * sp); c = (float)cp;
}

struct TJob { const float* W; const float* gain; bf16_t* Bt; int N, K, c0, k0, perm; };
DEV TJob tjob_decode(const Params& p, int job) {
    unsigned char* ws = p.ws;
    const int l = job / 3008; int r = job % 3008; TJob j;
    if (r < 704) { j.W = p.w_in + (size_t)l * DM * INW; j.gain = p.g_mix + l * DM; j.Bt = (bf16_t*)(ws + WS_WIN + (size_t)l * SZ_WIN1); j.N = INW; j.K = DM; j.c0 = (r >> 4) * 64; j.k0 = (r & 15) * 64; j.perm = 1; }
    else if (r < 960) { r -= 704; j.W = p.w_out + (size_t)l * DM * DM; j.gain = nullptr; j.Bt = (bf16_t*)(ws + WS_WOUT + (size_t)l * SZ_WOUT1); j.N = DM; j.K = DM; j.c0 = (r >> 4) * 64; j.k0 = (r & 15) * 64; j.perm = 0; }
    else if (r < 1984) { r -= 960; j.W = p.w_up + (size_t)l * DM * DFF; j.gain = p.g_ffn + l * DM; j.Bt = (bf16_t*)(ws + WS_WUP + (size_t)l * SZ_WUP1); j.N = DFF; j.K = DM; j.c0 = (r >> 4) * 64; j.k0 = (r & 15) * 64; j.perm = 0; }
    else { r -= 1984; j.W = p.w_down + (size_t)l * DFF * DM; j.gain = nullptr; j.Bt = (bf16_t*)(ws + WS_WDN + (size_t)l * SZ_WUP1); j.N = DM; j.K = DFF; j.c0 = (r >> 6) * 64; j.k0 = (r & 63) * 64; j.perm = 0; }
    return j;
}
DEV void tjob_load(const TJob& j, float (&v)[8], int tid) {
    if (j.perm) {
#pragma unroll
        for (int it = 0; it < 8; ++it) {
            const int idx = tid + 512 * it, kk = idx >> 6, cc = idx & 63, o = win_colmap(j.c0 + cc);
            v[it] = (o >= 0) ? j.W[(size_t)(j.k0 + kk) * j.N + o] * j.gain[j.k0 + kk] : 0.f;
        }
    } else {
#pragma unroll
        for (int it = 0; it < 2; ++it) {
            const int idx = tid + 512 * it, kk = idx >> 4, c4 = idx & 15;
            const f32x4 x = *(const f32x4*)(j.W + (size_t)(j.k0 + kk) * j.N + j.c0 + 4 * c4);
            const float g = j.gain ? j.gain[j.k0 + kk] : 1.f;
#pragma unroll
            for (int e = 0; e < 4; ++e) v[4 * it + e] = x[e] * g;
        }
    }
}
DEV void tjob_lds(const TJob& j, const float (&v)[8], float* tile, int tid) {
    if (j.perm) {
#pragma unroll
        for (int it = 0; it < 8; ++it) { const int idx = tid + 512 * it; tile[(idx & 63) * 65 + (idx >> 6)] = v[it]; }
    } else {
#pragma unroll
        for (int it = 0; it < 2; ++it) {
            const int idx = tid + 512 * it, kk = idx >> 4, c4 = idx & 15;
#pragma unroll
            for (int e = 0; e < 4; ++e) tile[(4 * c4 + e) * 65 + kk] = v[4 * it + e];
        }
    }
}
DEV void tjob_flush(const TJob& j, const float* tile, int tid) {
    const int cc = tid >> 3, kg = tid & 7;
    float v[8];
#pragma unroll
    for (int i = 0; i < 8; ++i) v[i] = tile[cc * 65 + 8 * kg + i];
    *(u32x4*)(j.Bt + (size_t)(j.c0 + cc) * j.K + j.k0 + 8 * kg) = pack8(v);
}

DEV void transpose_jobs(const Params& p, unsigned char* lds, int j0, int j1, int me, int nblk);
DEV void phase_prologue(const Params& p, unsigned char* lds) {
    const int tid = otid(), lane = tid & 63, G = gridDim.x;
    unsigned char* ws = p.ws;
    {
        bf16_t* XB = (bf16_t*)(ws + WS_XB); float* SS = (float*)(ws + WS_SS);
        for (int row0 = blockIdx.x * 8 + (tid >> 6); row0 < MT; row0 += G * 16) {
            f32x4 v[2][4]; int rows[2];
#pragma unroll
            for (int h = 0; h < 2; ++h) {
                const int row = row0 + h * G * 8; rows[h] = row;
                if (row < MT) {
                    const float* src = row < NPR ? p.x_prompt + (size_t)row * DM : p.x_sample + (size_t)(row - NPR) * DM;
#pragma unroll
                    for (int i = 0; i < 4; ++i) v[h][i] = *(const f32x4*)(src + i * 256 + lane * 4);
                }
            }
#pragma unroll
            for (int h = 0; h < 2; ++h) {
                const int row = rows[h];
                if (row < MT) {
                    bf16_t* xb = XB + (size_t)row * DM;
                    float sq = 0.f;
#pragma unroll
                    for (int i = 0; i < 4; ++i) {
                        const f32x4 x = v[h][i];
                        *(u32x2*)(xb + i * 256 + lane * 4) = (u32x2){pk2(x[0], x[1]), pk2(x[2], x[3])};
                        sq += (x[0] * x[0] + x[1] * x[1]) + (x[2] * x[2] + x[3] * x[3]);
                    }
                    sq = wave_sum(sq);
                    if (lane < 16) SS[(size_t)row * 16 + lane] = lane == 0 ? sq : 0.f;
                }
            }
        }
    }
    const int gtid = blockIdx.x * NTHREADS + tid, gsz = G * NTHREADS;
    {
        float* RT = (float*)(ws + WS_ROPE);
        for (int i = gtid; i < 2080 * 32; i += gsz) {
            const int pi = i >> 5, k = i & 31, pos = pi < 2048 ? pi : PAST + (pi - 2048);
            float c, s; sincos_acc((float)pos * c_invf[k], c, s);
            RT[pi * 64 + k] = c; RT[pi * 64 + 32 + k] = s;
        }
    }
    {
        bf16_t* KIS = (bf16_t*)(ws + WS_KIS);
        for (int i = gtid; i < 2 * 8 * PAST * 4; i += gsz) {
            const int dg = i & 3, key = (i >> 2) & 4095, lb = i >> 14;
            const float* src = p.cache_kidx + ((size_t)lb * PAST + key) * 32 + dg * 8;
            const f32x4 a = *(const f32x4*)src, b = *(const f32x4*)(src + 4);
            *(u32x4*)(KIS + ((size_t)lb * LSP + key) * 32 + dg * 8) = (u32x4){pk2(a[0], a[1]), pk2(a[2], a[3]), pk2(b[0], b[1]), pk2(b[2], b[3])};
        }
    }
    transpose_jobs(p, lds, 0, 6016, blockIdx.x, G);
}
DEV void transpose_jobs(const Params& p, unsigned char* lds, int j0, int j1, int me, int nblk) {
    const int tid = otid();
    {
        float* tile = (float*)lds;
        for (int jb = j0 + me * 4; jb < j1; jb += nblk * 4) {
            float v[4][8];
#pragma unroll
            for (int u = 0; u < 4; ++u) { const TJob j = tjob_decode(p, jb + u); tjob_load(j, v[u], tid); }
#pragma unroll
            for (int u = 0; u < 4; ++u) { const TJob j = tjob_decode(p, jb + u); tjob_lds(j, v[u], tile + u * 4160, tid); }
            __syncthreads();
#pragma unroll
            for (int u = 0; u < 4; ++u) { const TJob j = tjob_decode(p, jb + u); tjob_flush(j, tile + u * 4160, tid); }
            __syncthreads();
        }
    }
}

DEV unsigned sort_key(float f) { const unsigned u = __float_as_uint(f); return (u & 0x80000000u) ? ~u : (u | 0x80000000u); }

DEV int wave_isum(int v) {
    v += __builtin_amdgcn_update_dpp(0, v, 0x111, 0xf, 0xf, true);
    v += __builtin_amdgcn_update_dpp(0, v, 0x112, 0xf, 0xf, true);
    v += __builtin_amdgcn_update_dpp(0, v, 0x114, 0xf, 0xf, true);
    v += __builtin_amdgcn_update_dpp(0, v, 0x118, 0xf, 0xf, true);
    v += __builtin_amdgcn_update_dpp(0, v, 0x142, 0xa, 0xf, false);
    v += __builtin_amdgcn_update_dpp(0, v, 0x143, 0xc, 0xf, false);
    return __builtin_amdgcn_readlane(v, 63);
}
template <int NCH, int NR> DEV void select_rows(const float* rowf, int npad, int nch, u64* bmr, int bmstride, int lane) {
    asm volatile("" : "+s"(nch));
    unsigned kreg[NR][NCH];
#pragma unroll
    for (int r = 0; r < NR; ++r)
#pragma unroll
        for (int c = 0; c < NCH; ++c) {
            const unsigned k = sort_key(rowf[(size_t)r * npad + c * 64 + lane]);
            kreg[r][c] = (c < nch) ? k : 0u;
        }
    unsigned T[NR]; bool done[NR];
#pragma unroll
    for (int r = 0; r < NR; ++r) { T[r] = 0u; done[r] = false; }
    for (int bit = 31; bit >= 0; --bit) {
        unsigned cand[NR]; int cnt[NR];
#pragma unroll
        for (int r = 0; r < NR; ++r) { cand[r] = T[r] | (1u << bit); cnt[r] = 0; }
#pragma unroll
        for (int c = 0; c < NCH; ++c) {
            if ((c & 7) == 0 && c >= nch) break;
#pragma unroll
            for (int r = 0; r < NR; ++r) cnt[r] += (kreg[r][c] >= cand[r]) ? 1 : 0;
        }
        bool alldone = true;
#pragma unroll
        for (int r = 0; r < NR; ++r) {
            const int tot = wave_isum(cnt[r]);
            if (tot >= 256) T[r] = cand[r];
            if (tot == 256) done[r] = true;
            alldone = alldone && done[r];
        }
        if (alldone) break;
    }
#pragma unroll
    for (int r = 0; r < NR; ++r) {
        int cg = 0;
#pragma unroll
        for (int c = 0; c < NCH; ++c) { if ((c & 7) == 0 && c >= nch) break; cg += (kreg[r][c] > T[r]) ? 1 : 0; }
        const int need = 256 - wave_isum(cg);
        int eqbase = 0;
#pragma unroll
        for (int c = 0; c < NCH; ++c) {
            if (c < nch) {
                const unsigned kv = kreg[r][c];
                const bool eq = (kv == T[r]);
                const u64 be = __ballot(eq);
                const int rank = eqbase + __popcll(be & ((1ull << lane) - 1ull));
                const bool sel = (kv > T[r]) || (eq && rank < need);
                const u64 bs = __ballot(sel);
                eqbase += __popcll(be);
                if (lane == 0) bmr[(size_t)r * bmstride + c] = bs;
            }
        }
    }
}

struct IdxItem { int nq, n, row0, bmstride; const bf16_t* KI; u64* BM; };
DEV IdxItem idx_decode(const Params& p, int layer, int item) {
    unsigned char* ws = p.ws; IdxItem I;
    if (item < 32) {
        const int b = item >> 2, qt = item & 3;
        I.nq = 8; I.n = LS; I.row0 = NPR + b * 32 + qt * 8;
        I.KI = (const bf16_t*)(ws + WS_KIS + (size_t)layer * SZ_KIS1) + (size_t)b * LSP * 32;
        I.BM = (u64*)(ws + WS_BMS) + (size_t)(b * 32 + qt * 8) * 72; I.bmstride = 72;
    } else {
        const int i2 = item - 32, c = 31 - (i2 >> 5), w = i2 & 31, b = w >> 2, qt = w & 3;
        I.nq = 16; I.n = 64 * (c + 1); I.row0 = b * TP + 64 * c + 16 * qt;
        I.KI = (const bf16_t*)(ws + WS_KIP) + (size_t)b * TP * 32;
        I.BM = (u64*)(ws + WS_BMP) + (size_t)I.row0 * 32; I.bmstride = 32;
    }
    return I;
}
struct IdxPre { bf16x8 aq[4][2]; bf16x8 nb0, nb1; float wv; };
DEV void idx_prefetch(const Params& p, const IdxItem& I, IdxPre& P, int tid, int lane, int wave) {
    if (I.n <= 256) return;
    unsigned char* ws = p.ws;
    const bf16_t* QI = (const bf16_t*)(ws + WS_QIB); const float* WI = (const float*)(ws + WS_WI);
    P.wv = (tid < I.nq * 8) ? WI[(size_t)I.row0 * 8 + tid] : 0.f;
    const int nqb = I.nq >> 2;
    const int i = lane & 31, a = i >> 3, gi = (i >> 2) & 1, c = i & 3, qin = 2 * gi + (a >> 1), head = 4 * (a & 1) + c;
#pragma unroll
    for (int qb = 0; qb < 4; ++qb)
#pragma unroll
        for (int ks = 0; ks < 2; ++ks) {
            if (qb < nqb) P.aq[qb][ks] = *(const bf16x8*)(QI + (size_t)(I.row0 + 4 * qb + qin) * 256 + head * 32 + 8 * (lane >> 5) + 16 * ks);
            else P.aq[qb][ks] = (bf16x8){0, 0, 0, 0, 0, 0, 0, 0};
        }
    const int g = lane >> 5, nkb = I.n >> 5;
    P.nb0 = (bf16x8){0, 0, 0, 0, 0, 0, 0, 0}; P.nb1 = P.nb0;
    if (wave < nkb) { const bf16_t* kp = I.KI + (size_t)(wave * 32 + (lane & 31)) * 32 + 8 * g; P.nb0 = *(const bf16x8*)kp; P.nb1 = *(const bf16x8*)(kp + 16); }
}
DEV int indexer_item(const Params& p, int layer, int item, unsigned char* lds, const IdxPre& P, int nxt, volatile int* slot, IdxPre& Pn) {
    const int tid = otid(), lane = tid & 63, wave = __builtin_amdgcn_readfirstlane(tid >> 6);
    const IdxItem I = idx_decode(p, layer, item);
    const int nq = I.nq, n = I.n, bmstride = I.bmstride; u64* BM = I.BM; const bf16_t* KI = I.KI;
    const int ntile = (n + 63) >> 6;
    if (n <= 256) {
        if (tid < nq * ntile) BM[(size_t)(tid / ntile) * bmstride + (tid % ntile)] = ~0ull;
        if (tid == 0) slot[1] = nxt;
        __syncthreads();
        const int nx = __builtin_amdgcn_readfirstlane(slot[1]);
        __syncthreads();
        if (nx < 1056) idx_prefetch(p, idx_decode(p, layer, nx), Pn, tid, lane, wave);
        return nx;
    }
    const int npad = ntile * 64;
    float* sc = (float*)lds;
    float* wl = (float*)(lds + 133120);
    if (tid < nq * 8) wl[tid] = P.wv;
    const int nqb = nq >> 2;
    const int g = lane >> 5;
    const int nkb = n >> 5;
    bf16x8 nb0 = P.nb0, nb1 = P.nb1;
    __syncthreads();
    for (int kb = wave; kb < nkb; kb += 8) {
        const int key = kb * 32 + (lane & 31);
        const bf16x8 b0 = nb0, b1 = nb1;
        if (kb + 8 < nkb) { const bf16_t* kp = KI + (size_t)(key + 256) * 32 + 8 * g; nb0 = *(const bf16x8*)kp; nb1 = *(const bf16x8*)(kp + 16); }
#pragma unroll
        for (int qb = 0; qb < 4; ++qb) {
            if (qb < nqb) {
                f32x16 acc;
#pragma unroll
                for (int r = 0; r < 16; ++r) acc[r] = 0.f;
                acc = __builtin_amdgcn_mfma_f32_32x32x16_bf16(P.aq[qb][0], b0, acc, 0, 0, 0);
                acc = __builtin_amdgcn_mfma_f32_32x32x16_bf16(P.aq[qb][1], b1, acc, 0, 0, 0);
#pragma unroll
                for (int qq = 0; qq < 2; ++qq) {
                    const int ql = 4 * qb + 2 * g + qq;
                    const f32x4 w0 = *(const f32x4*)(wl + ql * 8), w1 = *(const f32x4*)(wl + ql * 8 + 4);
                    float s = 0.f;
#pragma unroll
                    for (int h = 0; h < 4; ++h) s = fmaf(w0[h], __builtin_amdgcn_fmed3f(acc[8 * qq + h], 0.f, __builtin_inff()), s);
#pragma unroll
                    for (int h = 0; h < 4; ++h) s = fmaf(w1[h], __builtin_amdgcn_fmed3f(acc[8 * qq + 4 + h], 0.f, __builtin_inff()), s);
                    s = (s == 0.f) ? 0.f : s;
                    sc[(size_t)ql * npad + key] = s;
                }
            }
        }
    }
    if (npad > n && tid < nq * (npad - n)) sc[(size_t)(tid / (npad - n)) * npad + n + tid % (npad - n)] = -__builtin_inff();
    if (tid == 0) slot[1] = nxt;
    __syncthreads();
    const int nx = __builtin_amdgcn_readfirstlane(slot[1]);
    if (nx < 1056) idx_prefetch(p, idx_decode(p, layer, nx), Pn, tid, lane, wave);
    const float* scf = (const float*)lds;
    if (nq == 16) select_rows<32, 2>(scf + (size_t)(2 * wave) * npad, npad, ntile, BM + (size_t)(2 * wave) * bmstride, bmstride, lane);
    else select_rows<65, 1>(scf + (size_t)wave * npad, npad, ntile, BM + (size_t)wave * bmstride, bmstride, lane);
    __syncthreads();
    return nx;
}

DEV void sgate_item(const Params& p, int layer, int item) {
    const int tid = otid(), lane = tid & 63, wave = tid >> 6, fr = lane & 15, quad = lane >> 4;
    unsigned char* ws = p.ws;
    int row0, ni, h;
    if (item < 512) { h = item & 3; row0 = (item >> 2) * 128; ni = 128; } else { const int i2 = item - 512; h = i2 & 3; row0 = NPR + (i2 >> 2) * 32; ni = 32; }
    if (wave * 16 >= ni) return;
    const int ksmax = (ni == 32) ? 1 : (wave < 4 ? 2 : 4);
    const float* W = p.w_s + ((size_t)(layer * 4 + h) * 128 + wave * 16 + fr) * 128;
    const bf16_t* SGVT = (const bf16_t*)(ws + WS_SGVT);
    f32x4 acc[4];
#pragma unroll
    for (int nn = 0; nn < 4; ++nn) acc[nn] = (f32x4){0.f, 0.f, 0.f, 0.f};
    f32x4 a0[4], a1[4]; bf16x8 bfr[4][4];
#pragma unroll
    for (int ks = 0; ks < 4; ++ks)
        if (ks < ksmax) {
            a0[ks] = *(const f32x4*)(W + 32 * ks + 8 * quad); a1[ks] = *(const f32x4*)(W + 32 * ks + 8 * quad + 4);
#pragma unroll
            for (int nn = 0; nn < 4; ++nn) bfr[ks][nn] = *(const bf16x8*)(SGVT + (size_t)(h * 64 + 16 * nn + fr) * MT + row0 + 32 * ks + 8 * quad);
        }
    const bf16_t* ZAU = (const bf16_t*)(ws + WS_ZAU); bf16_t* YMIX = (bf16_t*)(ws + WS_YMIX);
    unsigned short uu[4][4]; float bias[4];
#pragma unroll
    for (int j = 0; j < 4; ++j) {
        const int i = wave * 16 + 4 * quad + j;
        bias[j] = p.b_s[(layer * 4 + h) * 128 + i];
#pragma unroll
        for (int nn = 0; nn < 4; ++nn) uu[j][nn] = ZAU[(size_t)(row0 + i) * 256 + h * 64 + 16 * nn + fr];
    }
#pragma unroll
    for (int ks = 0; ks < 4; ++ks)
        if (ks < ksmax) {
            const u32x4 aw = (u32x4){pk2(a0[ks][0], a0[ks][1]), pk2(a0[ks][2], a0[ks][3]), pk2(a1[ks][0], a1[ks][1]), pk2(a1[ks][2], a1[ks][3])};
            const bf16x8 af = __builtin_bit_cast(bf16x8, aw);
#pragma unroll
            for (int nn = 0; nn < 4; ++nn) acc[nn] = __builtin_amdgcn_mfma_f32_16x16x32_bf16(af, bfr[ks][nn], acc[nn], 0, 0, 0);
        }
#pragma unroll
    for (int j = 0; j < 4; ++j) {
        const int i = wave * 16 + 4 * quad + j;
#pragma unroll
        for (int nn = 0; nn < 4; ++nn) YMIX[(size_t)(row0 + i) * 1024 + h * 64 + 16 * nn + fr] = f2bf(bf2f(uu[j][nn]) * (acc[nn][j] + bias[j]));
    }
}

DEV void conv_one(const Params& p, int layer, const bf16_t* ZB, bf16_t* YMIX, int i) {
    {
        const int row = i >> 5, ch = (i & 31) * 8;
        const bool samp = row >= NPR; const int rs = row - NPR;
        const int b = samp ? (rs >> 5) : (row >> 11), t = samp ? (rs & 31) : (row & 2047), T = samp ? 32 : TP;
        float xc[3][8];
#pragma unroll
        for (int dt = 0; dt < 3; ++dt) {
            const int tt = t - 2 + dt;
            if (tt >= 0) {
                const bf16_t* zr = ZB + (size_t)(row - 2 + dt) * 768 + ch;
                const u32x4 gc = *(const u32x4*)(zr + 256), hi = *(const u32x4*)(zr + 512);
#pragma unroll
                for (int e = 0; e < 4; ++e) {
                    xc[dt][2 * e] = __uint_as_float(gc[e] << 16) * __uint_as_float(hi[e] << 16);
                    xc[dt][2 * e + 1] = __uint_as_float(gc[e] & 0xffff0000u) * __uint_as_float(hi[e] & 0xffff0000u);
                }
            } else if (samp) {
                const float* st = p.state_conv + (((size_t)layer * 8 + b) * 2 + (tt + 2)) * 256 + ch;
                const f32x4 a = *(const f32x4*)st, c = *(const f32x4*)(st + 4);
#pragma unroll
                for (int e = 0; e < 4; ++e) { xc[dt][e] = a[e]; xc[dt][4 + e] = c[e]; }
            } else {
#pragma unroll
                for (int e = 0; e < 8; ++e) xc[dt][e] = 0.f;
            }
        }
        const u32x4 gb = *(const u32x4*)(ZB + (size_t)row * 768 + ch);
        const float* cw = p.conv_w + (size_t)layer * 3 * 256 + ch;
        float y[8];
#pragma unroll
        for (int e = 0; e < 8; ++e) {
            const float gbe = (e & 1) ? __uint_as_float(gb[e >> 1] & 0xffff0000u) : __uint_as_float(gb[e >> 1] << 16);
            y[e] = gbe * (cw[e] * xc[0][e] + cw[256 + e] * xc[1][e] + cw[512 + e] * xc[2][e]);
        }
        *(u32x4*)(YMIX + (size_t)row * 1024 + 256 + ch) = pack8(y);
        if (t >= T - 2) {
            float* d = p.out + (samp ? O_CS : O_CP) + (((size_t)layer * 8 + b) * 2 + (t - (T - 2))) * 256 + ch;
            *(f32x4*)d = (f32x4){xc[2][0], xc[2][1], xc[2][2], xc[2][3]}; *(f32x4*)(d + 4) = (f32x4){xc[2][4], xc[2][5], xc[2][6], xc[2][7]};
        }
    }
}

DEV void phase_mix_a(const Params& p, int layer, unsigned char* lds) {
    {
        unsigned char* ws = p.ws;
        const bf16_t* ZB = (const bf16_t*)(ws + WS_ZB); bf16_t* YMIX = (bf16_t*)(ws + WS_YMIX);
        for (int i = blockIdx.x * NTHREADS + otid(); i < MT * 32; i += gridDim.x * NTHREADS) conv_one(p, layer, ZB, YMIX, i);
    }
    {
        const int tid = otid(), lane = tid & 63, wave = __builtin_amdgcn_readfirstlane(tid >> 6);
        unsigned* ctr = (unsigned*)(p.ws + WS_BAR) + 3712 + 64 * layer;
        volatile int* slot = (volatile int*)(lds + LDS_BYTES - 32);
        if (tid == 0) slot[0] = (int)__hip_atomic_fetch_add(ctr, 1u, __ATOMIC_RELAXED, __HIP_MEMORY_SCOPE_AGENT);
        __syncthreads();
        int it = __builtin_amdgcn_readfirstlane(slot[0]);
        IdxPre P;
        if (it < 1056) idx_prefetch(p, idx_decode(p, layer, it), P, tid, lane, wave);
        while (it < 1056 + 544) {
            int nxt = 0;
            if (tid == 0) nxt = (int)__hip_atomic_fetch_add(ctr, 1u, __ATOMIC_RELAXED, __HIP_MEMORY_SCOPE_AGENT);
            if (it < 1056) {
                IdxPre Pn;
                it = indexer_item(p, layer, it, lds, P, nxt, slot, Pn);
                P = Pn;
            } else {
                sgate_item(p, layer, it - 1056);
                if (tid == 0) slot[1] = nxt;
                __syncthreads();
                it = __builtin_amdgcn_readfirstlane(slot[1]);
                __syncthreads();
            }
        }
    }
}

constexpr int AT_VP = 136;
constexpr int AT_KT = 8192, AT_VT = 64 * AT_VP, AT_BUF = AT_KT + AT_VT, AT_GRP = 2 * AT_BUF;
template <bool SAMPLE> struct AttnRaw { u32x4 k[2]; u32x4 v[2]; };
template <> struct AttnRaw<true> { f32x4 k[2][2]; f32x4 v[2][2]; };
struct AttnSrc { const bf16_t* kb; const bf16_t* vt; const float* ck; const float* cv; const float* nk; const float* nv; };

template <bool SAMPLE> DEV void attn_load(AttnRaw<SAMPLE>& raw, const AttnSrc& S, int kt, int tg) {
#pragma unroll
    for (int r = 0; r < 2; ++r) {
        const int q = tg + 256 * r;
        if constexpr (!SAMPLE) {
            raw.k[r] = *(const u32x4*)(S.kb + (size_t)(kt * 64 + (q >> 3)) * 64 + 8 * (q & 7));
            raw.v[r] = *(const u32x4*)(S.vt + (size_t)(q >> 3) * TPV + kt * 64 + 8 * (q & 7));
        } else {
            {
                const int key = kt * 64 + (q >> 3), g = q & 7;
                if (key < LS) { const float* s = key < PAST ? S.ck + (size_t)key * 256 + 8 * g : S.nk + (size_t)(key - PAST) * 256 + 8 * g; raw.k[r][0] = *(const f32x4*)s; raw.k[r][1] = *(const f32x4*)(s + 4); }
                else { raw.k[r][0] = (f32x4){0.f, 0.f, 0.f, 0.f}; raw.k[r][1] = raw.k[r][0]; }
            }
            {
                const int key = kt * 64 + (q >> 3), g = q & 7;
                if (key < LS) { const float* s = key < PAST ? S.cv + (size_t)key * 256 + 8 * g : S.nv + (size_t)(key - PAST) * 256 + 8 * g; raw.v[r][0] = *(const f32x4*)s; raw.v[r][1] = *(const f32x4*)(s + 4); }
                else { raw.v[r][0] = (f32x4){0.f, 0.f, 0.f, 0.f}; raw.v[r][1] = raw.v[r][0]; }
            }
        }
    }
}
template <bool SAMPLE> DEV void attn_store(const AttnRaw<SAMPLE>& raw, unsigned char* buf, int tg) {
#pragma unroll
    for (int r = 0; r < 2; ++r) {
        const int q = tg + 256 * r, row = q >> 3, g = q & 7;
        unsigned char* kd = buf + row * 128 + ((g ^ ((row >> 1) & 7)) << 4);
        if constexpr (!SAMPLE) {
            *(u32x4*)kd = raw.k[r];
            *(u32x2*)(buf + AT_KT + row * AT_VP + 16 * g) = (u32x2){raw.v[r].x, raw.v[r].y}; *(u32x2*)(buf + AT_KT + row * AT_VP + 16 * g + 8) = (u32x2){raw.v[r].z, raw.v[r].w};
        } else {
            *(u32x4*)kd = (u32x4){pk2(raw.k[r][0][0], raw.k[r][0][1]), pk2(raw.k[r][0][2], raw.k[r][0][3]), pk2(raw.k[r][1][0], raw.k[r][1][1]), pk2(raw.k[r][1][2], raw.k[r][1][3])};
            const int kl = q >> 3, gv = q & 7;
            bf16_t* vd = (bf16_t*)(buf + AT_KT + (8 * gv) * AT_VP) + kl;
#pragma unroll
            for (int e = 0; e < 4; ++e) { vd[e * (AT_VP / 2)] = f2bf(raw.v[r][0][e]); vd[(4 + e) * (AT_VP / 2)] = f2bf(raw.v[r][1][e]); }
        }
    }
}
template <int NG> DEV void attn_tile(const unsigned char* buf, const bf16x8 (&qf)[NG][2], u64 mw, float c1, float c2, f32x4 (&o)[NG][4], float (&lsum)[NG], int fr, int quad) {
    const u64 mq = mw >> (4 * quad);
    const int mlo = (int)(unsigned)mq, mhi = (int)(unsigned)(mq >> 32);
    const unsigned nb = __float_as_uint(-c2);
    f32x4 zi[4];
#pragma unroll
    for (int t = 0; t < 4; ++t)
#pragma unroll
        for (int j = 0; j < 4; ++j) {
            const unsigned m = (unsigned)__builtin_amdgcn_sbfe(t < 2 ? mlo : mhi, 16 * (t & 1) + j, 1);
            zi[t][j] = __uint_as_float((m & nb) | (~m & 0xf149f2cau));
        }
    f32x4 st[NG][4];
#pragma unroll
    for (int t = 0; t < 4; ++t) {
        const int row = 16 * t + fr, sw = (row >> 1) & 7;
        const bf16x8 k0 = *(const bf16x8*)(buf + row * 128 + ((quad ^ sw) << 4)), k1 = *(const bf16x8*)(buf + row * 128 + (((quad + 4) ^ sw) << 4));
#pragma unroll
        for (int g = 0; g < NG; ++g) {
            const f32x4 z = __builtin_amdgcn_mfma_f32_16x16x32_bf16(k0, qf[g][0], zi[t], 0, 0, 0);
            st[g][t] = __builtin_amdgcn_mfma_f32_16x16x32_bf16(k1, qf[g][1], z, 0, 0, 0);
        }
    }
    u32x4 pw[NG][2];
#pragma unroll
    for (int g = 0; g < NG; ++g) {
#pragma unroll
        for (int t = 0; t < 4; ++t)
#pragma unroll
            for (int j = 0; j < 4; ++j) {
                const float pv = __builtin_amdgcn_exp2f(st[g][t][j]);
                st[g][t][j] = pv; lsum[g] += pv;
            }
#pragma unroll
        for (int i = 0; i < 2; ++i)
            pw[g][i] = (u32x4){pk2(st[g][2 * i][0], st[g][2 * i][1]), pk2(st[g][2 * i][2], st[g][2 * i][3]), pk2(st[g][2 * i + 1][0], st[g][2 * i + 1][1]), pk2(st[g][2 * i + 1][2], st[g][2 * i + 1][3])};
    }
#pragma unroll
    for (int i = 0; i < 2; ++i)
#pragma unroll
        for (int nn = 0; nn < 4; ++nn) {
            const unsigned char* vr = buf + AT_KT + (16 * nn + fr) * AT_VP + 64 * i + 8 * quad;
            const u32x2 v0 = *(const u32x2*)vr, v1 = *(const u32x2*)(vr + 32);
            const bf16x8 vb = __builtin_bit_cast(bf16x8, (u32x4){v0.x, v0.y, v1.x, v1.y});
#pragma unroll
            for (int g = 0; g < NG; ++g) o[g][nn] = __builtin_amdgcn_mfma_f32_16x16x32_bf16(__builtin_bit_cast(bf16x8, pw[g][i]), vb, o[g][nn], 0, 0, 0);
        }
}
template <bool SAMPLE, int NG> DEV void attn_stream(const AttnSrc& S, const bf16_t* Qrow, const u64* bmrow, int kt0, int kt1, int nsteps, unsigned char* glds, int tg, int lane, float c1, float c2, f32x4 (&o)[NG][4], float (&lsum)[NG]) {
    const int fr = lane & 15, quad = lane >> 4;
    bf16x8 qf[NG][2];
#pragma unroll
    for (int g = 0; g < NG; ++g) { qf[g][0] = *(const bf16x8*)(Qrow + 64 * g + 8 * quad); qf[g][1] = *(const bf16x8*)(Qrow + 64 * g + 32 + 8 * quad); }
    const int klast = kt1 - 1;
    AttnRaw<SAMPLE> R0, R1, R2;
    u64 mwn = bmrow[kt0];
    attn_load<SAMPLE>(R0, S, kt0, tg);
    attn_load<SAMPLE>(R1, S, min(kt0 + 1, klast), tg);
    attn_load<SAMPLE>(R2, S, min(kt0 + 2, klast), tg);
    attn_store<SAMPLE>(R0, glds, tg);
    __syncthreads();
#define ATTN_STEP(CUR, RSTORE, RLOAD, SIDX) do { \
        const u64 mw = mwn; \
        mwn = (kt0 + (SIDX) + 1 < kt1) ? bmrow[kt0 + (SIDX) + 1] : 0ull; \
        attn_load<SAMPLE>(RLOAD, S, min(kt0 + (SIDX) + 3, klast), tg); \
        attn_tile<NG>(glds + (CUR) * AT_BUF, qf, mw, c1, c2, o, lsum, fr, quad); \
        attn_store<SAMPLE>(RSTORE, glds + ((CUR) ^ 1) * AT_BUF, tg); \
        __syncthreads(); } while (0)
    for (int s = 0; s < nsteps; s += 6) {
        ATTN_STEP(0, R1, R0, s);
        if (s + 1 < nsteps) ATTN_STEP(1, R2, R1, s + 1);
        if (s + 2 < nsteps) ATTN_STEP(0, R0, R2, s + 2);
        if (s + 3 < nsteps) ATTN_STEP(1, R1, R0, s + 3);
        if (s + 4 < nsteps) ATTN_STEP(0, R2, R1, s + 4);
        if (s + 5 < nsteps) ATTN_STEP(1, R0, R2, s + 5);
    }
#undef ATTN_STEP
}
template <int NG> DEV void attn_finish(bf16_t* YMIX, int rowq, int head0, f32x4 (&o)[NG][4], float (&lsum)[NG], int lane) {
    const int fr = lane & 15, quad = lane >> 4;
#pragma unroll
    for (int g = 0; g < NG; ++g) {
        float ls = lsum[g];
        ls += __shfl_xor(ls, 16); ls += __shfl_xor(ls, 32);
#pragma unroll
        for (int j = 0; j < 4; ++j) {
            const float l = __shfl(ls, 4 * quad + j);
            const float inv = 1.0f / l;
#pragma unroll
            for (int nn = 0; nn < 4; ++nn) YMIX[(size_t)(rowq + 4 * quad + j) * 1024 + 512 + (head0 + g) * 64 + 16 * nn + fr] = f2bf(o[g][nn][j] * inv);
        }
    }
}
DEV void attn_prompt_item(const Params& p, int idx, float c1, float c2, unsigned char* lds) {
    const int tid = otid(), lane = tid & 63, wave = tid >> 6, fr = lane & 15, grp = wave >> 2, wg = wave & 3;
    unsigned char* ws = p.ws;
    const int c = 31 - (idx >> 4), r = idx & 15, b = r >> 1, hk = 2 * (r & 1) + grp;
    const int rowq = b * TP + 64 * c + 16 * wg;
    f32x4 o[2][4];
#pragma unroll
    for (int g = 0; g < 2; ++g)
#pragma unroll
        for (int nn = 0; nn < 4; ++nn) o[g][nn] = (f32x4){0.f, 0.f, 0.f, 0.f};
    float lsum[2] = {0.f, 0.f};
    AttnSrc S{};
    S.kb = (const bf16_t*)(ws + WS_KP) + (size_t)(b * 4 + hk) * TP * 64;
    S.vt = (const bf16_t*)(ws + WS_VTP) + (size_t)(b * 4 + hk) * 64 * TPV;
    const u64* bm = (const u64*)(ws + WS_BMP) + (size_t)(rowq + fr) * 32;
    attn_stream<false, 2>(S, (const bf16_t*)(ws + WS_QB) + (size_t)(rowq + fr) * 512 + 2 * hk * 64, bm, 0, c + 1, c + 1, lds + grp * AT_GRP, tid & 255, lane, c1, c2, o, lsum);
    attn_finish<2>((bf16_t*)(ws + WS_YMIX), rowq, 2 * hk, o, lsum, lane);
}
DEV void attn_sample_item(const Params& p, int layer, int item, float c1, float c2, unsigned char* lds) {
    const int tid = otid(), lane = tid & 63, wave = tid >> 6, fr = lane & 15, quad = lane >> 4, grp = wave >> 2, wg = wave & 3;
    unsigned char* ws = p.ws;
    const int qt = item & 3, bh = item >> 2, b = bh >> 2, hk = bh & 3, head = 2 * hk + (wg >> 1);
    const int rowq = NPR + b * 32 + 16 * (wg & 1);
    const int t0 = (qt == 0) ? 0 : 1 + 16 * qt, t1 = 17 + 16 * qt;
    const int tm = t0 + ((t1 - t0 + 1) >> 1), nsteps = tm - t0;
    f32x4 o[1][4];
#pragma unroll
    for (int nn = 0; nn < 4; ++nn) o[0][nn] = (f32x4){0.f, 0.f, 0.f, 0.f};
    float lsum[1] = {0.f};
    AttnSrc S{};
    S.ck = p.cache_k + (size_t)(layer * 8 + b) * PAST * 256 + hk * 64; S.cv = p.cache_v + (size_t)(layer * 8 + b) * PAST * 256 + hk * 64;
    S.nk = p.out + O_KS + (size_t)(layer * NSR + b * 32) * 256 + hk * 64; S.nv = p.out + O_VS + (size_t)(layer * NSR + b * 32) * 256 + hk * 64;
    const u64* bm = (const u64*)(ws + WS_BMS) + (size_t)(b * 32 + 16 * (wg & 1) + fr) * 72;
    attn_stream<true, 1>(S, (const bf16_t*)(ws + WS_QB) + (size_t)(rowq + fr) * 512 + head * 64, bm, grp ? tm : t0, grp ? t1 : tm, nsteps, lds + grp * AT_GRP, tid & 255, lane, c1, c2, o, lsum);
    float* xo = (float*)lds;
    if (grp) {
        float* d = xo + ((size_t)wg * 64 + lane) * 17;
#pragma unroll
        for (int nn = 0; nn < 4; ++nn)
#pragma unroll
            for (int j = 0; j < 4; ++j) d[nn * 4 + j] = o[0][nn][j];
        d[16] = lsum[0];
    }
    __syncthreads();
    if (!grp) {
        const float* d = xo + ((size_t)wg * 64 + lane) * 17;
#pragma unroll
        for (int nn = 0; nn < 4; ++nn)
#pragma unroll
            for (int j = 0; j < 4; ++j) o[0][nn][j] += d[nn * 4 + j];
        float ls = lsum[0] + d[16];
        ls += __shfl_xor(ls, 16); ls += __shfl_xor(ls, 32);
        float* PO = (float*)(ws + WS_PART) + ((size_t)(bh * 4 + qt) * 64 + wg * 16) * 64;
        float* PL = (float*)(ws + WS_PART + SZ_PARTO) + (size_t)(bh * 4 + qt) * 64 + wg * 16;
#pragma unroll
        for (int j = 0; j < 4; ++j)
#pragma unroll
            for (int nn = 0; nn < 4; ++nn) PO[(size_t)(4 * quad + j) * 64 + 16 * nn + fr] = o[0][nn][j];
        if (quad == 0) PL[fr] = ls;
    }
    __syncthreads();
}
DEV void attn_sample_combine(const Params& p) {
    unsigned char* ws = p.ws;
    const float* PO = (const float*)(ws + WS_PART); const float* PL = (const float*)(ws + WS_PART + SZ_PARTO);
    bf16_t* YMIX = (bf16_t*)(ws + WS_YMIX);
    for (int i = blockIdx.x * NTHREADS + otid(); i < 8 * 4 * 64 * 16; i += gridDim.x * NTHREADS) {
        const int d4 = i & 15, pr = (i >> 4) & 63, bh = i >> 10, b = bh >> 2, hk = bh & 3;
        f32x4 acc = (f32x4){0.f, 0.f, 0.f, 0.f}; float l = 0.f;
#pragma unroll
        for (int q = 0; q < 4; ++q) { acc += *(const f32x4*)(PO + ((size_t)(bh * 4 + q) * 64 + pr) * 64 + 4 * d4); l += PL[(size_t)(bh * 4 + q) * 64 + pr]; }
        const float inv = 1.0f / l;
        const int wg = pr >> 4, qi = 16 * (wg & 1) + (pr & 15), head = 2 * hk + (wg >> 1);
        *(u32x2*)(YMIX + (size_t)(NPR + b * 32 + qi) * 1024 + 512 + head * 64 + 4 * d4) = (u32x2){pk2(acc[0] * inv, acc[1] * inv), pk2(acc[2] * inv, acc[3] * inv)};
    }
}

DEV void phase_attn(const Params& p, int layer, unsigned char* lds, int subset = 0) {
    const int tid = otid(), lane = tid & 63;
    const float gq = wave_max(fabsf(p.q_gain[layer * 64 + lane])), gk = wave_max(fabsf(p.k_gain[layer * 64 + lane]));
    const float bound = 8.0f * gq * gk * 1.02f;
    const float c1 = 0.125f * 1.4426950408889634f, c2 = bound * 1.4426950408889634f;
    unsigned* ctr = (unsigned*)(p.ws + WS_BAR) + 3584 + 64 * layer;
    volatile int* slot = (volatile int*)(lds + LDS_BYTES - 32);
    for (;;) {
        if (tid == 0) *slot = (int)__hip_atomic_fetch_add(ctr, 1u, __ATOMIC_RELAXED, __HIP_MEMORY_SCOPE_AGENT);
        __syncthreads();
        const int it = __builtin_amdgcn_readfirstlane(*slot);
        __syncthreads();
        if (it >= 640) break;
#ifdef PROBE_ATT_SUB
        if (subset == 1 && it >= 128) continue;
        if (subset == 2 && it < 128) continue;
#endif
        if (it < 128) attn_sample_item(p, layer, it, c1, c2, lds);
        else attn_prompt_item(p, it - 128, c1, c2, lds);
    }
}

template <int NT, int CH> DEV void mini_mma(const bf16_t* A, int lda, const bf16_t* Bt, int ldb, int r0, int c0, int k0, int k1, f32x4 (&acc)[NT], int lane) {
    const int fr = lane & 15, quad = lane >> 4;
    const bf16_t* ap = A + (size_t)(r0 + fr) * lda + 8 * quad;
    const bf16_t* bp = Bt + (size_t)(c0 + fr) * ldb + 8 * quad;
    for (int k = k0; k < k1; k += 32 * CH) {
        bf16x8 a[CH], b[NT][CH];
#pragma unroll
        for (int i = 0; i < CH; ++i) {
            a[i] = *(const bf16x8*)(ap + k + 32 * i);
#pragma unroll
            for (int nt = 0; nt < NT; ++nt) b[nt][i] = *(const bf16x8*)(bp + (size_t)16 * nt * ldb + k + 32 * i);
        }
#pragma unroll
        for (int i = 0; i < CH; ++i)
#pragma unroll
            for (int nt = 0; nt < NT; ++nt) acc[nt] = __builtin_amdgcn_mfma_f32_16x16x32_bf16(a[i], b[nt][i], acc[nt], 0, 0, 0);
    }
}
DEV void mini_res(const bf16_t* A, const bf16_t* Bt, int K, float* Y, bf16_t* XB, float* SS, unsigned char* lds, int last, int live) {
    const int tid = otid(), lane = tid & 63, wave = tid >> 6, fr = lane & 15, quad = lane >> 4;
    float* part = (float*)lds;
    float* tile = (float*)(lds + 8 * 64 * 17 * 4);
    for (int t = blockIdx.x; t < 256; t += gridDim.x) {
        const int r0 = NPR + 16 * (t >> 4), ct = t & 15, c0 = 64 * ct, kw = K >> 3;
        f32x4 acc[4];
#pragma unroll
        for (int nt = 0; nt < 4; ++nt) acc[nt] = (f32x4){0.f, 0.f, 0.f, 0.f};
        if (K == DFF) mini_mma<4, 8>(A, K, Bt, K, r0, c0, wave * kw, (wave + 1) * kw, acc, lane);
        else mini_mma<4, 4>(A, K, Bt, K, r0, c0, wave * kw, (wave + 1) * kw, acc, lane);
        float* d = part + ((size_t)wave * 64 + lane) * 17;
#pragma unroll
        for (int nt = 0; nt < 4; ++nt)
#pragma unroll
            for (int j = 0; j < 4; ++j) d[nt * 4 + j] = acc[nt][j];
        __syncthreads();
#pragma unroll
        for (int vv = 0; vv < 2; ++vv) {
            const int v = 2 * wave + vv, nt = v >> 2, j = v & 3;
            float s = 0.f;
#pragma unroll
            for (int w2 = 0; w2 < 8; ++w2) s += part[((size_t)w2 * 64 + lane) * 17 + v];
            const int rl = 4 * quad + j, cl = 16 * nt + fr;
            const size_t off = (size_t)(r0 + rl) * DM + c0 + cl;
            const float xn = bf2f(XB[off]) + s;
            if (live) { if (last) Y[off] = xn; else XB[off] = f2bf(xn); } tile[rl * 65 + cl] = xn;
        }
        __syncthreads();
        if (tid < 16) {
            float sq = 0.f;
            for (int c = 0; c < 64; ++c) { const float v = tile[tid * 65 + c]; sq += v * v; }
            if (live && !last) SS[(size_t)(r0 + tid) * 16 + ct] = sq;
        }
        __syncthreads();
    }
}
DEV void mini_up(const bf16_t* XB, const bf16_t* Bt, const float* SS, bf16_t* H) {
    const int tid = otid(), lane = tid & 63, wave = tid >> 6, fr = lane & 15, quad = lane >> 4;
    for (int t = blockIdx.x; t < 256; t += gridDim.x) {
        const int r0 = NPR + 16 * (t >> 4), c0 = 256 * (t & 15) + 32 * wave;
        f32x4 acc[2];
        acc[0] = (f32x4){0.f, 0.f, 0.f, 0.f}; acc[1] = acc[0];
        mini_mma<2, 16>(XB, DM, Bt, DM, r0, c0, 0, DM, acc, lane);
#pragma unroll
        for (int j = 0; j < 4; ++j) {
            const int row = r0 + 4 * quad + j;
            const float rstd = row_rstd(SS, row);
#pragma unroll
            for (int nt = 0; nt < 2; ++nt) { const float r = fmaxf(acc[nt][j] * rstd, 0.f); H[(size_t)row * DFF + c0 + 16 * nt + fr] = f2bf(r * r); }
        }
    }
}

__global__ void __launch_bounds__(NTHREADS) hybrid_fwd(Params p) {
    extern __shared__ __attribute__((aligned(16))) unsigned char lds[];
    cg::grid_group grid = cg::this_grid();
    PG8_LAS unsigned char* l3 = (PG8_LAS unsigned char*)lds;
    unsigned char* ws = p.ws;
    bf16_t* XB = (bf16_t*)(ws + WS_XB); float* SS = (float*)(ws + WS_SS);
    if (threadIdx.x < 4) ((LAS unsigned*)(l3 + LDS_BYTES - 16))[threadIdx.x] = 0u;
    __syncthreads();
    const XcdBarrier bar = xcd_barrier_post((unsigned*)(ws + WS_BAR), (volatile LAS unsigned*)(l3 + LDS_BYTES - 16));
    for (int ph = p.ph_lo; ph < p.ph_hi; ++ph) {
        if (ph > p.ph_lo) {
            if (p.ph_hi > 64) grid.sync();
            xcd_barrier(bar);
        }
#ifdef PROBE_DUP
        const int nrep = (ph == 0) ? ((PROBE_DUP >> 0) & 1) + 1 : (((PROBE_DUP >> (1 + (ph - 1) % 6)) & 1) + 1);
        for (int rep = 0; rep < nrep; ++rep) {
        if (rep) __syncthreads();
        if (rep && ph > 0 && (ph - 1) % 6 == 2) {
            xcd_barrier(bar);
            if (blockIdx.x == 0 && threadIdx.x == 0) __hip_atomic_store((unsigned*)(ws + WS_BAR) + 3584 + 64 * ((ph - 1) / 6), 0u, __ATOMIC_RELAXED, __HIP_MEMORY_SCOPE_AGENT);
            xcd_barrier(bar);
        }
        const int live = (rep == nrep - 1);
#else
        const int live = 1;
#endif
        if (ph == 0) {
#ifndef NO_P0
            phase_prologue(p, lds);
#endif
            continue; }
        const int l = (ph - 1) / 6, s = (ph - 1) % 6;
        if (s == 0) {
#ifndef NO_S0
            pg8::Gemm g{XB, (const bf16_t*)(ws + WS_WIN + (size_t)l * SZ_WIN1), MT, INWP, DM};
            pg8::StaticOrder S; S.init(MT, INWP, (int)gridDim.x, (int)blockIdx.x);
            EpiIn E{SS, (const float*)(ws + WS_ROPE), p.q_gain, p.k_gain, p.out, ws, l};
            pg8::gemm_phase<EpiIn, pg8::StaticOrder>(l3, g, S, E, nullptr);
#endif
        } else if (s == 1) {
#ifndef NO_S1
            phase_mix_a(p, l, lds);
#endif
        } else if (s == 2) {
#ifndef NO_S2
#ifdef PROBE_ATT_SUB
            phase_attn(p, l, lds, live ? 0 : PROBE_ATT_SUB);
#else
            phase_attn(p, l, lds);
#endif
            xcd_barrier(bar);
            attn_sample_combine(p);
#endif
        } else if (s == 3) {
#ifndef NO_S3
            mini_res((const bf16_t*)(ws + WS_YMIX), (const bf16_t*)(ws + WS_WOUT + (size_t)l * SZ_WOUT1), DM, p.out, XB, SS, lds, 0, live);
            pg8::Gemm g{(const bf16_t*)(ws + WS_YMIX), (const bf16_t*)(ws + WS_WOUT + (size_t)l * SZ_WOUT1), NPR, DM, DM};
            pg8::StaticOrder S; S.init(NPR, DM, (int)gridDim.x, (int)blockIdx.x);
            EpiRes E{p.out, XB, SS, 0, live};
            pg8::gemm_phase<EpiRes, pg8::StaticOrder>(l3, g, S, E, nullptr);
#endif
        } else if (s == 4) {
#ifndef NO_S4
            mini_up(XB, (const bf16_t*)(ws + WS_WUP + (size_t)l * SZ_WUP1), SS, (bf16_t*)(ws + WS_H));
            __syncthreads();
            pg8::Gemm g{XB, (const bf16_t*)(ws + WS_WUP + (size_t)l * SZ_WUP1), NPR, DFF, DM};
            pg8::StaticOrder S; S.init(NPR, DFF, (int)gridDim.x, (int)blockIdx.x);
            EpiUp E{(bf16_t*)(ws + WS_H), SS};
            pg8::gemm_phase<EpiUp, pg8::StaticOrder>(l3, g, S, E, nullptr);
#endif
        } else {
#ifndef NO_S5
            mini_res((const bf16_t*)(ws + WS_H), (const bf16_t*)(ws + WS_WDN + (size_t)l * SZ_WUP1), DFF, p.out, XB, SS, lds, l == 1, live);
            pg8::Gemm g{(const bf16_t*)(ws + WS_H), (const bf16_t*)(ws + WS_WDN + (size_t)l * SZ_WUP1), NPR, DM, DFF};
            pg8::StaticOrder S; S.init(NPR, DM, (int)gridDim.x, (int)blockIdx.x);
            EpiRes E{p.out, XB, SS, l == 1, live};
            pg8::gemm_phase<EpiRes, pg8::StaticOrder>(l3, g, S, E, nullptr);
#endif
        }
#ifdef PROBE_DUP
        }
#endif
    }
}

extern "C" void kernel_launch(void* const* d_in, const int* in_sizes, int n_in, void* d_out, int out_size, void* d_ws, size_t ws_size, hipStream_t stream) {
    static int grid = 0;
    if (grid == 0) {
        if (n_in != 17 || out_size != 35291136 || ws_size < WS_END) { fprintf(stderr, "kernel_launch: unexpected shapes (n_in %d, out %d, ws %zu, need %zu)\n", n_in, out_size, ws_size, (size_t)WS_END); grid = -1; return; }
        int dev = 0, cus = 0, per_cu = 0;
        hipGetDevice(&dev);
        hipDeviceGetAttribute(&cus, hipDeviceAttributeMultiprocessorCount, dev);
        if (hipFuncSetAttribute((const void*)hybrid_fwd, hipFuncAttributeMaxDynamicSharedMemorySize, LDS_BYTES) != hipSuccess) { fprintf(stderr, "kernel_launch: hipFuncSetAttribute failed\n"); grid = -1; return; }
        if (hipOccupancyMaxActiveBlocksPerMultiprocessor(&per_cu, (const void*)hybrid_fwd, NTHREADS, LDS_BYTES) != hipSuccess || per_cu < 1) { fprintf(stderr, "kernel_launch: occupancy query says %d blocks per CU\n", per_cu); grid = -1; return; }
        grid = cus;
        if (per_cu * cus < grid) grid = per_cu * cus;
    }
    if (grid < 0) return;
    Params p{};
    p.x_prompt = (const float*)d_in[0]; p.x_sample = (const float*)d_in[1]; p.cache_k = (const float*)d_in[2]; p.cache_v = (const float*)d_in[3];
    p.cache_kidx = (const float*)d_in[4]; p.state_conv = (const float*)d_in[5]; p.g_mix = (const float*)d_in[6]; p.w_in = (const float*)d_in[7];
    p.q_gain = (const float*)d_in[8]; p.k_gain = (const float*)d_in[9]; p.w_s = (const float*)d_in[10]; p.b_s = (const float*)d_in[11];
    p.conv_w = (const float*)d_in[12]; p.w_out = (const float*)d_in[13]; p.g_ffn = (const float*)d_in[14]; p.w_up = (const float*)d_in[15]; p.w_down = (const float*)d_in[16];
    p.out = (float*)d_out; p.ws = (unsigned char*)d_ws;
    if (hipMemsetAsync((unsigned char*)d_ws + WS_BAR, 0, 16384, stream) != hipSuccess) { fprintf(stderr, "kernel_launch: memset of the barrier words failed\n"); return; }
#if N_LAUNCH_MODE == 1
    p.ph_lo = 0; p.ph_hi = 13;
    void* args[] = {&p};
    hipError_t e = hipLaunchCooperativeKernel((const void*)hybrid_fwd, dim3(grid), dim3(NTHREADS), args, LDS_BYTES, stream);
    if (e != hipSuccess) fprintf(stderr, "kernel_launch: cooperative launch failed: %s (grid %d)\n", hipGetErrorString(e), grid);
#else
    for (int ph = 0; ph < 13; ++ph) {
        p.ph_lo = ph; p.ph_hi = ph + 1;
        hipLaunchKernelGGL(hybrid_fwd, dim3(grid), dim3(NTHREADS), LDS_BYTES, stream, p);
    }
#endif
}
```

```cpp
#include <hip/hip_runtime.h>
#include <hip/hip_cooperative_groups.h>
#include <cstdio>
namespace cg = cooperative_groups;
#ifndef N_LAUNCH_MODE
#define N_LAUNCH_MODE 1
#endif
__device__ __forceinline__ int otid() { int t = (int)threadIdx.x; asm volatile("" : "+v"(t)); return t; }

namespace pg8 {
#define PG8_LAS __attribute__((address_space(3)))
typedef unsigned short bf16_t;
typedef short bf16x8 __attribute__((ext_vector_type(8)));
typedef float f32x4 __attribute__((ext_vector_type(4)));
typedef unsigned u32x4 __attribute__((ext_vector_type(4)));
constexpr int BM = 256, BK = 64, HALF = 128, HTB = HALF * BK * 2  , STAGE_BYTES = 8 * HTB, NXCD = 8, WGM = 8;

__host__ __device__ __forceinline__ int lds_byte(int r, int c) { const int st = (r >> 4) * 2 + (c >> 5), rr = r & 15, cc = c & 31, ob = rr * 64 + cc * 2; return st * 1024 + (ob ^ (((ob >> 9) & 1) << 5)); }
__host__ __device__ __forceinline__ void stage_rc(int b, int& R, int& C) { const int st = b / 1024, sb = b % 1024, swz = sb ^ (((sb >> 9) & 1) << 5); R = (st >> 1) * 16 + swz / 64; C = (st & 1) * 32 + (swz % 64) / 2; }
__host__ __device__ __forceinline__ int perm32(int rho) { const int n = rho >> 4, i = rho & 15; return 8 * (i >> 2) + 4 * n + (i & 3); }

struct Unit { int pm, pn; };
struct Gemm { const bf16_t* A; const bf16_t* Bt; int M, N, K; };

struct StaticOrder {
    int nM, nN, nwg, G, c;
    __host__ __device__ void init(int M, int N, int G_, int c_) { nM = M / BM; nN = N / BM; nwg = nM * nN; G = G_; c = c_; }
    __host__ __device__ bool next(int i, Unit& u) const {
        const long L = (long)i * G + c; if (L >= nwg) return false;
        int wgid = (int)L; { const int q = nwg / NXCD, r = nwg % NXCD, xcd = wgid % NXCD, off = wgid / NXCD; wgid = (xcd < r ? xcd * (q + 1) : r * (q + 1) + (xcd - r) * q) + off; }
        const int nig = WGM * nN, gid = wgid / nig, fm = gid * WGM, gsz = (nM - fm) < WGM ? (nM - fm) : WGM;
        u.pm = fm + ((wgid % nig) % gsz); u.pn = (wgid % nig) / gsz; return true;
    }
    __device__ __forceinline__ void a_ready(const Unit&) const {}
    __device__ __forceinline__ void done(const Unit&) const {}
};
template <class Epi, class Sched, bool STAMP = false>
__device__ __forceinline__ void gemm_phase(PG8_LAS unsigned char* lds, const Gemm g, const Sched& S, const Epi& E, unsigned long long* stamps) {
    const int tid = otid(), wid = __builtin_amdgcn_readfirstlane(tid >> 6), lane = tid & 63, wr = wid >> 2, wc = wid & 3, fr = lane & 15, fq = lane >> 4;
    const int K = g.K, nt = K / BK;
    int ts_lo = 0, ts_hi = 0, nts = 0; const unsigned long long rt_entry = STAMP ? (unsigned long long)wall_clock64() : 0ull;
#define PG8_STAMP() do { if (STAMP && wid == 0 && nts < 64) { const unsigned long long _c = (unsigned long long)clock64(); \
        ts_lo = (lane == nts) ? (int)(unsigned)_c : ts_lo; ts_hi = (lane == nts) ? (int)(unsigned)(_c >> 32) : ts_hi; ++nts; } } while (0)
    PG8_STAMP();
    unsigned voffA[2], voffB[2];
#pragma unroll
    for (int i = 0; i < 2; ++i) { int R, C; stage_rc(tid * 16 + i * 8192, R, C); const int Rb = Epi::PERM ? ((R & ~31) + perm32(R & 31)) : R;
        voffA[i] = (unsigned)(R * K + C) * 2u; voffB[i] = (unsigned)(Rb * K + C) * 2u; }
    const size_t kstep = (size_t)(BK * 2);
    const size_t hstep = (size_t)HALF * K * 2;
    const size_t tstep = 2 * hstep;
    const unsigned ldsw = (unsigned)wid * 1024u;
    const int aoff = lds_byte(wr * 64 + fr, fq * 8), boff = lds_byte(wc * 32 + fr, fq * 8);
#define PG8_SA(b, h) (((b) * 2 + (h)) * HTB)
#define PG8_SB(b, h) ((4 + (b) * 2 + (h)) * HTB)
#define PG8_STAGE(bufoff, gbase, voff) do { _Pragma("unroll") for (int _i = 0; _i < 2; ++_i) \
        __builtin_amdgcn_global_load_lds((const unsigned*)((const char*)(gbase) + (voff)[_i]), (PG8_LAS unsigned*)(lds + (bufoff) + ldsw + _i * 8192), 16, 0, 0); } while (0)
#define PG8_LDA(dst, b, h) do { _Pragma("unroll") for (int m = 0; m < 4; ++m) _Pragma("unroll") for (int k = 0; k < 2; ++k) dst[m][k] = *(const PG8_LAS bf16x8*)(lds + PG8_SA(b, h) + aoff + m * 2048 + k * 1024); } while (0)
#define PG8_LDB(dst, b, h) do { _Pragma("unroll") for (int n = 0; n < 2; ++n) _Pragma("unroll") for (int k = 0; k < 2; ++k) dst[n][k] = *(const PG8_LAS bf16x8*)(lds + PG8_SB(b, h) + boff + n * 2048 + k * 1024); } while (0)
#define PG8_MMA(ai, bj, At, Bt) do { __builtin_amdgcn_s_setprio(1); _Pragma("unroll") for (int m = 0; m < 4; ++m) _Pragma("unroll") for (int n = 0; n < 2; ++n) _Pragma("unroll") for (int k = 0; k < 2; ++k) \
        acc[ai][bj][m][n] = __builtin_amdgcn_mfma_f32_16x16x32_bf16(Bt[n][k], At[m][k], acc[ai][bj][m][n], 0, 0, 0); __builtin_amdgcn_s_setprio(0); } while (0)
#define PG8_WAIT_V(n) asm volatile("s_waitcnt vmcnt(" #n ")" ::: "memory")
#define PG8_WAIT_L(n) asm volatile("s_waitcnt lgkmcnt(" #n ")" ::: "memory")
#define PG8_BAR __builtin_amdgcn_s_barrier()
#define PG8_SCHED __builtin_amdgcn_sched_barrier(0)
    Unit cur, nxt; int ui = 0;
    if (!S.next(0, cur)) return;
    f32x4 acc[2][2][4][2];
#pragma unroll
    for (int a = 0; a < 2; ++a)
#pragma unroll
        for (int b = 0; b < 2; ++b)
#pragma unroll
            for (int m = 0; m < 4; ++m)
#pragma unroll
                for (int n = 0; n < 2; ++n) acc[a][b][m][n] = (f32x4){0.f, 0.f, 0.f, 0.f};
    bf16x8 At[4][2], B0[2][2], B1[2][2];
    const char* cA = (const char*)g.A + (size_t)cur.pm * tstep; const char* cB = (const char*)g.Bt + (size_t)cur.pn * tstep;
    S.a_ready(cur);
    PG8_STAGE(PG8_SB(0, 0), cB, voffB); PG8_STAGE(PG8_SA(0, 0), cA, voffA); PG8_STAGE(PG8_SB(0, 1), cB + hstep, voffB); PG8_STAGE(PG8_SA(0, 1), cA + hstep, voffA);
    if (wr == 1) PG8_BAR;
    PG8_WAIT_V(4); PG8_BAR;
    PG8_STAGE(PG8_SB(1, 0), cB + kstep, voffB); PG8_STAGE(PG8_SA(1, 0), cA + kstep, voffA); PG8_STAGE(PG8_SB(1, 1), cB + hstep + kstep, voffB);
    PG8_WAIT_V(6); PG8_BAR;
    PG8_STAMP();
    for (;;) {
        const bool has_next = S.next(ui + 1, nxt);
        const char* nA = has_next ? (const char*)g.A + (size_t)nxt.pm * tstep : cA; const char* nB = has_next ? (const char*)g.Bt + (size_t)nxt.pn * tstep : cB;
        for (int t = 0; t < nt; t += 2) {
            const bool last = (t == nt - 2);
            const char* a1 = cA + (size_t)(t + 1) * kstep;
            const char* a2 = last ? nA : cA + (size_t)(t + 2) * kstep; const char* b2 = last ? nB : cB + (size_t)(t + 2) * kstep;
            const char* a3 = a2 + kstep; const char* b3 = b2 + kstep;
            if (last && has_next) S.a_ready(nxt);
            PG8_LDB(B0, 0, 0); PG8_SCHED; PG8_LDA(At, 0, 0); PG8_STAGE(PG8_SA(1, 1), a1 + hstep, voffA);
            PG8_WAIT_L(8); PG8_BAR; PG8_WAIT_L(0); PG8_MMA(0, 0, At, B0); PG8_BAR; PG8_SCHED;
            PG8_LDB(B1, 0, 1); PG8_STAGE(PG8_SB(0, 0), b2, voffB);
            PG8_BAR; PG8_WAIT_L(0); PG8_MMA(0, 1, At, B1); PG8_BAR;
            PG8_LDA(At, 0, 1); PG8_STAGE(PG8_SA(0, 0), a2, voffA);
            PG8_BAR; PG8_WAIT_L(0); PG8_MMA(1, 0, At, B0); PG8_BAR; PG8_SCHED;
            PG8_STAGE(PG8_SB(0, 1), b2 + hstep, voffB);
            PG8_WAIT_V(6); PG8_BAR; PG8_MMA(1, 1, At, B1); PG8_BAR;
            PG8_LDB(B0, 1, 0); PG8_SCHED; PG8_LDA(At, 1, 0); PG8_STAGE(PG8_SA(0, 1), a2 + hstep, voffA);
            PG8_WAIT_L(8); PG8_BAR; PG8_WAIT_L(0); PG8_MMA(0, 0, At, B0); PG8_BAR; PG8_SCHED;
            PG8_LDB(B1, 1, 1); PG8_STAGE(PG8_SB(1, 0), b3, voffB);
            PG8_BAR; PG8_WAIT_L(0); PG8_MMA(0, 1, At, B1); PG8_BAR;
            PG8_LDA(At, 1, 1); PG8_STAGE(PG8_SA(1, 0), a3, voffA);
            PG8_BAR; PG8_WAIT_L(0); PG8_MMA(1, 0, At, B0); PG8_BAR; PG8_SCHED;
            PG8_STAGE(PG8_SB(1, 1), b3 + hstep, voffB);
            PG8_WAIT_V(6); PG8_BAR; PG8_MMA(1, 1, At, B1); PG8_BAR;
        }
        PG8_STAMP();
        if constexpr (!Epi::AFTER_DRAIN) { E(acc, cur, wr, wc, fr, fq); S.done(cur); }
        PG8_STAMP();
        if (!has_next) break;
#pragma unroll
        for (int a = 0; a < 2; ++a)
#pragma unroll
            for (int b = 0; b < 2; ++b)
#pragma unroll
                for (int m = 0; m < 4; ++m)
#pragma unroll
                    for (int n = 0; n < 2; ++n) acc[a][b][m][n] = (f32x4){0.f, 0.f, 0.f, 0.f};
        cur = nxt; cA = nA; cB = nB; ++ui;
    }
    PG8_WAIT_V(0);
    if (wr == 0) PG8_BAR;
    PG8_BAR;
    if constexpr (Epi::AFTER_DRAIN) { E.fused(acc, cur, wr, wc, fr, fq, lds, wid, lane); S.done(cur); }
    PG8_STAMP();
    if (STAMP && wid == 0) { stamps[lane] = lane < nts ? (((unsigned long long)(unsigned)ts_hi << 32) | (unsigned)ts_lo) : 0ull;
        if (lane == 62) stamps[62] = rt_entry; if (lane == 63) stamps[63] = (unsigned long long)wall_clock64(); }
#undef PG8_STAMP
#undef PG8_SA
#undef PG8_SB
#undef PG8_STAGE
#undef PG8_LDA
#undef PG8_LDB
#undef PG8_MMA
#undef PG8_WAIT_V
#undef PG8_WAIT_L
#undef PG8_BAR
#undef PG8_SCHED
}
}

using pg8::bf16_t; using pg8::bf16x8; using pg8::f32x4; using pg8::u32x4;
typedef float f32x16 __attribute__((ext_vector_type(16)));
typedef unsigned u32x2 __attribute__((ext_vector_type(2)));
typedef unsigned long long u64;
#define DEV __device__ __forceinline__

constexpr int DM = 1024, TP = 2048, NPR = 16384, NSR = 256, MT = 16640, INW = 2600, INWP = 2816, DFF = 4096, PAST = 4096, LS = 4128, LSP = 4160, TPV = 2112;
constexpr int NTHREADS = 512;
constexpr int LDS_BYTES = 139264;
constexpr size_t O_YP = 0, O_YS = 16777216, O_KP = 17039360, O_VP = 25427968, O_KIP = 33816576, O_CP = 34865152, O_KS = 34873344, O_VS = 35004416, O_KIS = 35135488, O_CS = 35151872, O_SGV = 35160064;
constexpr size_t WS_WIN = 0, SZ_WIN1 = (size_t)INWP * DM * 2;
constexpr size_t WS_WOUT = WS_WIN + 2 * SZ_WIN1, SZ_WOUT1 = (size_t)DM * DM * 2;
constexpr size_t WS_WUP = WS_WOUT + 2 * SZ_WOUT1, SZ_WUP1 = (size_t)DFF * DM * 2;
constexpr size_t WS_WDN = WS_WUP + 2 * SZ_WUP1;
constexpr size_t WS_XB = WS_WDN + 2 * SZ_WUP1;
constexpr size_t WS_SS = WS_XB + (size_t)MT * DM * 2;
constexpr size_t WS_ROPE = WS_SS + (size_t)MT * 16 * 4;
constexpr size_t WS_WI = WS_ROPE + (size_t)2080 * 64 * 4;
constexpr size_t WS_KS = WS_WI + (size_t)MT * 8 * 4, SZ_KS1 = (size_t)8 * 4 * LSP * 64 * 2;
constexpr size_t WS_VTS = WS_KS + 2 * SZ_KS1;
constexpr size_t WS_KIS = WS_VTS + 2 * SZ_KS1, SZ_KIS1 = (size_t)8 * LSP * 32 * 2;
constexpr size_t WS_BMP = WS_KIS + 2 * SZ_KIS1;
constexpr size_t WS_BMS = WS_BMP + (size_t)NPR * 32 * 8;
constexpr size_t WS_BAR = WS_BMS + (size_t)NSR * 72 * 8;
constexpr size_t WS_PART = WS_BAR + 16384;
constexpr size_t SZ_PARTO = (size_t)8 * 4 * 4 * 64 * 64 * 4;
constexpr size_t WS_MIX = WS_PART + SZ_PARTO + (size_t)8 * 4 * 4 * 64 * 4;
constexpr size_t WS_H = WS_MIX;
constexpr size_t WS_YMIX = WS_MIX;
constexpr size_t WS_ZB = WS_YMIX + (size_t)MT * 1024 * 2;
constexpr size_t WS_QB = WS_ZB + (size_t)MT * 768 * 2;
constexpr size_t WS_ZAU = WS_QB + (size_t)MT * 512 * 2;
constexpr size_t WS_SGVT = WS_ZAU + (size_t)MT * 256 * 2;
constexpr size_t WS_QIB = WS_SGVT + (size_t)MT * 256 * 2;
constexpr size_t WS_KP = WS_QIB + (size_t)MT * 256 * 2;
constexpr size_t WS_VTP = WS_KP + (size_t)8 * 4 * TP * 64 * 2;
constexpr size_t WS_KIP = WS_VTP + (size_t)8 * 4 * TPV * 64 * 2;
constexpr size_t WS_MIX_END = WS_KIP + (size_t)8 * TP * 32 * 2;
constexpr size_t WS_END = WS_H + (size_t)MT * DFF * 2;
static_assert(WS_MIX_END <= WS_END, "mixer intermediates must fit inside the H alias");
static_assert(WS_XB % 256 == 0 && WS_SS % 256 == 0 && WS_ROPE % 256 == 0 && WS_WI % 256 == 0 && WS_KS % 256 == 0 && WS_VTS % 256 == 0 && WS_KIS % 256 == 0 && WS_BMP % 256 == 0 && WS_BMS % 256 == 0 && WS_MIX % 256 == 0, "align");
static_assert(WS_ZB % 256 == 0 && WS_QB % 256 == 0 && WS_ZAU % 256 == 0 && WS_SGVT % 256 == 0 && WS_QIB % 256 == 0 && WS_KP % 256 == 0 && WS_VTP % 256 == 0 && WS_KIP % 256 == 0, "align2");

struct Params {
    const float* x_prompt; const float* x_sample; const float* cache_k; const float* cache_v; const float* cache_kidx; const float* state_conv;
    const float* g_mix; const float* w_in; const float* q_gain; const float* k_gain; const float* w_s; const float* b_s; const float* conv_w;
    const float* w_out; const float* g_ffn; const float* w_up; const float* w_down;
    float* out; unsigned char* ws;
    int ph_lo, ph_hi;
};

__constant__ float c_invf[32] = {1.000000000e+00f, 7.498942614e-01f, 5.623413324e-01f, 4.216965139e-01f, 3.162277639e-01f, 2.371373773e-01f, 1.778279394e-01f, 1.333521307e-01f, 1.000000015e-01f, 7.498941571e-02f, 5.623413250e-02f, 4.216965288e-02f, 3.162277490e-02f, 2.371373773e-02f, 1.778279431e-02f, 1.333521493e-02f, 9.999999776e-03f, 7.498941850e-03f, 5.623413250e-03f, 4.216964822e-03f, 3.162277630e-03f, 2.371373586e-03f, 1.778279431e-03f, 1.333521446e-03f, 1.000000047e-03f, 7.498942432e-04f, 5.623413017e-04f, 4.216965172e-04f, 3.162277571e-04f, 2.371373703e-04f, 1.778279402e-04f, 1.333521504e-04f};

DEV f32x4 ntl4(const float* p) { return __builtin_nontemporal_load((const f32x4*)p); }
DEV void nts4(float* p, f32x4 v) { __builtin_nontemporal_store(v, (f32x4*)p); }
DEV float bf2f(unsigned short h) { return __uint_as_float((unsigned)h << 16); }
typedef __bf16 bf16v2_t __attribute__((ext_vector_type(2)));
typedef float f32v2_t __attribute__((ext_vector_type(2)));
DEV unsigned pk2(float lo, float hi) { return __builtin_bit_cast(unsigned, __builtin_convertvector((f32v2_t){lo, hi}, bf16v2_t)); }
DEV unsigned short f2bf(float x) { return (unsigned short)(pk2(x, 0.f) & 0xffffu); }
DEV u32x4 pack8(const float (&v)[8]) { u32x4 w; w.x = pk2(v[0], v[1]); w.y = pk2(v[2], v[3]); w.z = pk2(v[4], v[5]); w.w = pk2(v[6], v[7]); return w; }
DEV float gelu_tanh(float x) {
    const float y = 0.7978845608028654f * (x + 0.044715f * x * x * x);
    const float e = __builtin_amdgcn_exp2f(-2.0f * 1.4426950408889634f * y);
    return x * __builtin_amdgcn_rcpf(1.0f + e);
}
DEV float wave_sum(float v) {
#pragma unroll
    for (int o = 32; o > 0; o >>= 1) v += __shfl_xor(v, o);
    return v;
}
DEV float wave_max(float v) {
#pragma unroll
    for (int o = 32; o > 0; o >>= 1) v = fmaxf(v, __shfl_xor(v, o));
    return v;
}

#define XB_TMO      128
#define XB_XCNT(j)  (256  + 64 * (j))
#define XB_XSUB(j)  (1280 + 64 * (j))
#define XB_XGEN(j)  (2304 + 64 * (j))
#define XB_TOP      3328
#define XB_TOPGEN   3392
#define XCD_BAR_WORDS 3456
#define XB_SPIN_CAP (1u << 18)
#define LAS __attribute__((address_space(3)))

__device__ __forceinline__ unsigned xb_ld(unsigned* p)              { return __hip_atomic_load(p, __ATOMIC_RELAXED, __HIP_MEMORY_SCOPE_AGENT); }
__device__ __forceinline__ unsigned xb_add(unsigned* p, unsigned v) { return __hip_atomic_fetch_add(p, v, __ATOMIC_RELAXED, __HIP_MEMORY_SCOPE_AGENT); }
__device__ __forceinline__ unsigned xb_xcc_id() { return (unsigned)__builtin_amdgcn_s_getreg((3 << 11) | 20) & 0xFu; }
#define XB_SPIN(cond, bar) do { unsigned _sp = 0; while (cond) { __builtin_amdgcn_s_sleep(1); \
    if ((++_sp & 255u) == 0u) { if (xb_ld(&(bar)[XB_TMO])) break; if (_sp > XB_SPIN_CAP) { atomicAdd(&(bar)[XB_TMO], 1u); break; } } } } while (0)

struct XcdBarrier {
    unsigned* bar; unsigned x;
    volatile LAS unsigned* st;
};

__device__ __forceinline__ XcdBarrier xcd_barrier_post(unsigned* bar, volatile LAS unsigned* st) {
    XcdBarrier b; b.bar = bar; b.x = xb_xcc_id(); b.st = st;
    if (threadIdx.x == 0) (void)xb_add(&bar[XB_XCNT(b.x)], 1u);
    return b;
}
__device__ __forceinline__ void xcd_barrier_complete(unsigned* bar, unsigned x, unsigned& nloc, unsigned& nx) {
    const unsigned G = gridDim.x * gridDim.y * gridDim.z;
    unsigned sum, cnt, mine, sp = 0u;
    for (;;) {
        sum = 0u; cnt = 0u; mine = 0u;
#pragma unroll
        for (unsigned j = 0; j < 16; ++j) { const unsigned c = xb_ld(&bar[XB_XCNT(j)]); sum += c; cnt += (c > 0u) ? 1u : 0u; mine = (j == x) ? c : mine; }
        if (sum == G) break;
        __builtin_amdgcn_s_sleep(1);
        if ((++sp & 255u) == 0u) { if (xb_ld(&bar[XB_TMO])) break; if (sp > XB_SPIN_CAP) { atomicAdd(&bar[XB_TMO], 1u); break; } }
    }
    nloc = mine > 0u ? mine : 1u; nx = cnt > 0u ? cnt : 1u;
}

__device__ __forceinline__ void xcd_barrier(const XcdBarrier& b) {
    asm volatile("s_waitcnt vmcnt(0)" ::: "memory");
    __syncthreads();
    if (threadIdx.x == 0) {
        unsigned* bar = b.bar;
        __builtin_amdgcn_s_waitcnt(0);
        unsigned nloc = b.st[0], nx = b.st[1];
        if (nloc == 0u) { xcd_barrier_complete(bar, b.x, nloc, nx); b.st[0] = nloc; b.st[1] = nx; }
        const unsigned old = xb_add(&bar[XB_XSUB(b.x)], 1u);
        const unsigned gen = old / nloc;
        if (old + 1u == (gen + 1u) * nloc) {
            __builtin_amdgcn_fence(__ATOMIC_RELEASE, "agent");
            asm volatile("s_waitcnt vmcnt(0)" ::: "memory");
            const unsigned og = xb_add(&bar[XB_TOP], 1u);
            const unsigned tg = og / nx;
            if (og + 1u == (tg + 1u) * nx) xb_add(&bar[XB_TOPGEN], 1u);
            else XB_SPIN(xb_ld(&bar[XB_TOPGEN]) == tg, bar);
            __builtin_amdgcn_fence(__ATOMIC_ACQUIRE, "agent");
            xb_add(&bar[XB_XGEN(b.x)], 1u);
            asm volatile("s_waitcnt vmcnt(0)" ::: "memory");
        } else {
            XB_SPIN(xb_ld(&bar[XB_XGEN(b.x)]) == gen, bar);
            __builtin_amdgcn_fence(__ATOMIC_ACQUIRE, "agent");
            asm volatile("s_waitcnt vmcnt(0)" ::: "memory");
        }
    }
    __syncthreads();
}


DEV float row_rstd(const float* ss, int row) {
    const f32x4* sp = (const f32x4*)(ss + (size_t)row * 16);
    const f32x4 a = sp[0], b = sp[1], c = sp[2], d = sp[3];
    const float t = ((a[0] + a[1]) + (a[2] + a[3])) + ((b[0] + b[1]) + (b[2] + b[3])) + ((c[0] + c[1]) + (c[2] + c[3])) + ((d[0] + d[1]) + (d[2] + d[3]));
    return rsqrtf(t * (1.0f / 1024.0f) + 1e-6f);
}

struct EpiIn {
    static constexpr bool PERM = false, AFTER_DRAIN = false;
    const float* ss; const float* rope; const float* qg; const float* kg; float* out; unsigned char* ws; int layer;
    __device__ __forceinline__ void operator()(const f32x4 (&acc)[2][2][4][2], const pg8::Unit& u, int wr, int wc, int fr, int fq0) const {
        const int pn = u.pn, pm = u.pm;
        const bool samp = (pm == 64);
        bf16_t* ZAU = (bf16_t*)(ws + WS_ZAU); bf16_t* SGVT = (bf16_t*)(ws + WS_SGVT); bf16_t* ZB = (bf16_t*)(ws + WS_ZB); bf16_t* QB = (bf16_t*)(ws + WS_QB);
        bf16_t* QIB = (bf16_t*)(ws + WS_QIB); float* WI = (float*)(ws + WS_WI);
#pragma unroll
        for (int ai = 0; ai < 2; ++ai)
#pragma unroll
            for (int m = 0; m < 4; ++m) {
                int row = pm * 256 + ai * 128 + wr * 64 + m * 16 + fr, fq = fq0;
                asm volatile("" : "+v"(row), "+v"(fq));
                const float rstd = row_rstd(ss, row);
                int b, t, posidx; const int rs = row - NPR;
                if (!samp) { b = row >> 11; t = row & 2047; posidx = t; } else { b = rs >> 5; t = rs & 31; posidx = 2048 + t; }
                float lo[8], hi[8];
#pragma unroll
                for (int bj = 0; bj < 2; ++bj)
#pragma unroll
                    for (int n = 0; n < 2; ++n)
#pragma unroll
                        for (int jp = 0; jp < 2; ++jp) { lo[4 * bj + 2 * n + jp] = acc[ai][bj][m][n][2 * jp] * rstd; hi[4 * bj + 2 * n + jp] = acc[ai][bj][m][n][2 * jp + 1] * rstd; }
                if (pn == 0) {
#pragma unroll
                    for (int e = 0; e < 8; ++e) { lo[e] = gelu_tanh(lo[e]); hi[e] = gelu_tanh(hi[e]); }
                    bf16_t* d = ZAU + (size_t)row * 256 + 64 * wc + 8 * fq;
                    *(u32x4*)d = pack8(lo); *(u32x4*)(d + 32) = pack8(hi);
                } else if (pn == 1) {
#pragma unroll
                    for (int e = 0; e < 8; ++e) { lo[e] = gelu_tanh(lo[e]); hi[e] = gelu_tanh(hi[e]); }
#pragma unroll
                    for (int e = 0; e < 8; ++e) {
                        SGVT[(size_t)(64 * wc + 8 * fq + e) * MT + row] = f2bf(lo[e]);
                        SGVT[(size_t)(64 * wc + 32 + 8 * fq + e) * MT + row] = f2bf(hi[e]);
                    }
                    if (samp) {
                        float* d = out + O_SGV + ((size_t)layer * NSR + rs) * 256 + 64 * wc + 8 * fq;
                        nts4(d, (f32x4){lo[0], lo[1], lo[2], lo[3]}); nts4((d + 4), (f32x4){lo[4], lo[5], lo[6], lo[7]});
                        nts4((d + 32), (f32x4){hi[0], hi[1], hi[2], hi[3]}); nts4((d + 36), (f32x4){hi[4], hi[5], hi[6], hi[7]});
                    }
                } else if (pn <= 4) {
                    bf16_t* d = ZB + (size_t)row * 768 + 256 * (pn - 2) + 64 * wc + 8 * fq;
                    *(u32x4*)d = pack8(lo); *(u32x4*)(d + 32) = pack8(hi);
                } else if (pn <= 7) {
                    float sq = 0.f;
#pragma unroll
                    for (int e = 0; e < 8; ++e) sq += lo[e] * lo[e] + hi[e] * hi[e];
                    sq += __shfl_xor(sq, 16); sq += __shfl_xor(sq, 32);
                    const float rh = rsqrtf(sq * (1.0f / 64.0f) + 1e-6f);
                    const float* cs = rope + (size_t)posidx * 64 + 8 * fq;
                    const f32x4 c0 = *(const f32x4*)cs, c1 = *(const f32x4*)(cs + 4), s0 = *(const f32x4*)(cs + 32), s1 = *(const f32x4*)(cs + 36);
                    const float* gp = (pn == 7 ? kg : qg) + layer * 64 + 8 * fq;
                    const f32x4 g0 = *(const f32x4*)gp, g1 = *(const f32x4*)(gp + 4), g2 = *(const f32x4*)(gp + 32), g3 = *(const f32x4*)(gp + 36);
                    float ol[8], oh[8];
#pragma unroll
                    for (int e = 0; e < 8; ++e) {
                        const float co = e < 4 ? c0[e & 3] : c1[e & 3], si = e < 4 ? s0[e & 3] : s1[e & 3];
                        const float a = lo[e] * rh * (e < 4 ? g0[e & 3] : g1[e & 3]), bb = hi[e] * rh * (e < 4 ? g2[e & 3] : g3[e & 3]);
                        ol[e] = a * co - bb * si; oh[e] = bb * co + a * si;
                    }
                    if (pn < 7) {
#pragma unroll
                        for (int e = 0; e < 8; ++e) { ol[e] *= 0.125f * 1.4426950408889634f; oh[e] *= 0.125f * 1.4426950408889634f; }
                        bf16_t* d = QB + (size_t)row * 512 + (4 * (pn - 5) + wc) * 64 + 8 * fq;
                        *(u32x4*)d = pack8(ol); *(u32x4*)(d + 32) = pack8(oh);
                    } else {
                        float* d = samp ? out + O_KS + ((size_t)layer * NSR + rs) * 256 + 64 * wc + 8 * fq : out + O_KP + ((size_t)layer * NPR + row) * 256 + 64 * wc + 8 * fq;
                        nts4(d, (f32x4){ol[0], ol[1], ol[2], ol[3]}); nts4((d + 4), (f32x4){ol[4], ol[5], ol[6], ol[7]});
                        nts4((d + 32), (f32x4){oh[0], oh[1], oh[2], oh[3]}); nts4((d + 36), (f32x4){oh[4], oh[5], oh[6], oh[7]});
                        if (!samp) {
                            bf16_t* kb = (bf16_t*)(ws + WS_KP) + ((size_t)(b * 4 + wc) * TP + t) * 64 + 8 * fq;
                            *(u32x4*)kb = pack8(ol); *(u32x4*)(kb + 32) = pack8(oh);
                        }
                    }
                } else if (pn == 8) {
                    float* d = samp ? out + O_VS + ((size_t)layer * NSR + rs) * 256 + 64 * wc + 8 * fq : out + O_VP + ((size_t)layer * NPR + row) * 256 + 64 * wc + 8 * fq;
                    nts4(d, (f32x4){lo[0], lo[1], lo[2], lo[3]}); nts4((d + 4), (f32x4){lo[4], lo[5], lo[6], lo[7]});
                    nts4((d + 32), (f32x4){hi[0], hi[1], hi[2], hi[3]}); nts4((d + 36), (f32x4){hi[4], hi[5], hi[6], hi[7]});
                    if (!samp) {
                        bf16_t* vt = (bf16_t*)(ws + WS_VTP) + (size_t)(b * 4 + wc) * 64 * TPV + t;
#pragma unroll
                        for (int e = 0; e < 8; ++e) { vt[(size_t)(8 * fq + e) * TPV] = f2bf(lo[e]); vt[(size_t)(32 + 8 * fq + e) * TPV] = f2bf(hi[e]); }
                    }
                } else {
                    const float* cs = rope + (size_t)posidx * 64 + 8 * fq;
                    const f32x4 c0 = *(const f32x4*)cs, c1 = *(const f32x4*)(cs + 4), s0 = *(const f32x4*)(cs + 32), s1 = *(const f32x4*)(cs + 36);
                    const float co[4] = {c0[0], c0[2], c1[0], c1[2]}, si[4] = {s0[0], s0[2], s1[0], s1[2]};
                    float ol[8], oh[8];
#pragma unroll
                    for (int e = 0; e < 8; ++e) { ol[e] = lo[e] * co[e & 3] - hi[e] * si[e & 3]; oh[e] = hi[e] * co[e & 3] + lo[e] * si[e & 3]; }
                    if (pn == 9) {
#pragma unroll
                        for (int bj = 0; bj < 2; ++bj) {
                            bf16_t* d = QIB + (size_t)row * 256 + 32 * (2 * wc + bj) + 4 * fq;
                            *(u32x2*)d = (u32x2){pk2(ol[4 * bj], ol[4 * bj + 1]), pk2(ol[4 * bj + 2], ol[4 * bj + 3])};
                            *(u32x2*)(d + 16) = (u32x2){pk2(oh[4 * bj], oh[4 * bj + 1]), pk2(oh[4 * bj + 2], oh[4 * bj + 3])};
                        }
                    } else if (wc == 0) {
                        float* d = samp ? out + O_KIS + ((size_t)layer * NSR + rs) * 32 + 4 * fq : out + O_KIP + ((size_t)layer * NPR + row) * 32 + 4 * fq;
                        nts4(d, (f32x4){ol[0], ol[1], ol[2], ol[3]}); nts4((d + 16), (f32x4){oh[0], oh[1], oh[2], oh[3]});
                        bf16_t* kb = samp ? (bf16_t*)(ws + WS_KIS + (size_t)layer * SZ_KIS1) + ((size_t)b * LSP + PAST + t) * 32 + 4 * fq
                                          : (bf16_t*)(ws + WS_KIP) + (size_t)row * 32 + 4 * fq;
                        *(u32x2*)kb = (u32x2){pk2(ol[0], ol[1]), pk2(ol[2], ol[3])};
                        *(u32x2*)(kb + 16) = (u32x2){pk2(oh[0], oh[1]), pk2(oh[2], oh[3])};
                        if (fq < 2) *(f32x4*)(WI + (size_t)row * 8 + 4 * fq) = (f32x4){lo[4] * 0.0625f, lo[5] * 0.0625f, lo[6] * 0.0625f, lo[7] * 0.0625f};
                    }
                }
                asm volatile("" ::: "memory");
            }
    }
};

struct EpiRes {
    static constexpr bool PERM = true, AFTER_DRAIN = false;
    float* Y; bf16_t* XB; float* ss; int last; int live;
    __device__ __forceinline__ void operator()(const f32x4 (&acc)[2][2][4][2], const pg8::Unit& u, int wr, int wc, int fr, int fq0) const {
        if (!live) return;
#pragma unroll
        for (int ai = 0; ai < 2; ++ai) {
            u32x4 xin[4][2];
#pragma unroll
            for (int m = 0; m < 4; ++m) {
                int row = u.pm * 256 + ai * 128 + wr * 64 + m * 16 + fr, fq = fq0;
                asm volatile("" : "+v"(row), "+v"(fq));
#pragma unroll
                for (int bj = 0; bj < 2; ++bj) xin[m][bj] = *(const u32x4*)(XB + (size_t)row * DM + u.pn * 256 + 128 * bj + 32 * wc + 8 * fq);
            }
#pragma unroll
            for (int m = 0; m < 4; ++m) {
                int row = u.pm * 256 + ai * 128 + wr * 64 + m * 16 + fr, fq = fq0;
                asm volatile("" : "+v"(row), "+v"(fq));
                float sq = 0.f;
#pragma unroll
                for (int bj = 0; bj < 2; ++bj) {
                    const size_t off = (size_t)row * DM + u.pn * 256 + 128 * bj + 32 * wc + 8 * fq;
                    const u32x4 xb = xin[m][bj];
                    f32x4 x0 = (f32x4){__uint_as_float(xb[0] << 16), __uint_as_float(xb[0] & 0xffff0000u), __uint_as_float(xb[1] << 16), __uint_as_float(xb[1] & 0xffff0000u)};
                    f32x4 x1 = (f32x4){__uint_as_float(xb[2] << 16), __uint_as_float(xb[2] & 0xffff0000u), __uint_as_float(xb[3] << 16), __uint_as_float(xb[3] & 0xffff0000u)};
                    x0 += acc[ai][bj][m][0]; x1 += acc[ai][bj][m][1];
                    if (last) { nts4(Y + off, x0); nts4(Y + off + 4, x1); }
                    else {
                        *(u32x4*)(XB + off) = (u32x4){pk2(x0[0], x0[1]), pk2(x0[2], x0[3]), pk2(x1[0], x1[1]), pk2(x1[2], x1[3])};
                        sq += ((x0[0] * x0[0] + x0[1] * x0[1]) + (x0[2] * x0[2] + x0[3] * x0[3])) + ((x1[0] * x1[0] + x1[1] * x1[1]) + (x1[2] * x1[2] + x1[3] * x1[3]));
                    }
                }
                if (!last) {
                    sq += __shfl_xor(sq, 16); sq += __shfl_xor(sq, 32);
                    if (fq0 == 0) ss[(size_t)row * 16 + u.pn * 4 + wc] = sq;
                }
            }
            asm volatile("" ::: "memory");
        }
    }
};

struct EpiUp {
    static constexpr bool PERM = true, AFTER_DRAIN = false;
    bf16_t* H; const float* ss;
    __device__ __forceinline__ void operator()(const f32x4 (&acc)[2][2][4][2], const pg8::Unit& u, int wr, int wc, int fr, int fq0) const {
#pragma unroll
        for (int ai = 0; ai < 2; ++ai) {
            float rs[4];
#pragma unroll
            for (int m = 0; m < 4; ++m) {
                int row = u.pm * 256 + ai * 128 + wr * 64 + m * 16 + fr;
                asm volatile("" : "+v"(row));
                rs[m] = row_rstd(ss, row);
            }
#pragma unroll
            for (int m = 0; m < 4; ++m) {
                int row = u.pm * 256 + ai * 128 + wr * 64 + m * 16 + fr, fq = fq0;
                asm volatile("" : "+v"(row), "+v"(fq));
                const float rstd = rs[m];
#pragma unroll
                for (int bj = 0; bj < 2; ++bj) {
                    const size_t off = (size_t)row * DFF + u.pn * 256 + 128 * bj + 32 * wc + 8 * fq;
                    float v[8];
#pragma unroll
                    for (int j = 0; j < 4; ++j) { const float r0 = fmaxf(acc[ai][bj][m][0][j] * rstd, 0.f), r1 = fmaxf(acc[ai][bj][m][1][j] * rstd, 0.f); v[j] = r0 * r0; v[4 + j] = r1 * r1; }
                    *(u32x4*)(H + off) = pack8(v);
                }
            }
            asm volatile("" ::: "memory");
        }
    }
};

DEV int win_colmap(int cg) {
    const int pn = cg >> 8, r = cg & 255, bj = r >> 7, wc = (r >> 5) & 3, n = (r >> 4) & 1, fq = (r >> 2) & 3, jp = (r >> 1) & 1, s = r & 1;
    int o;
    if (pn < 9) o = 256 * pn + 64 * wc + 32 * s + 8 * fq + 4 * bj + 2 * n + jp;
    else o = 256 * pn + 32 * (2 * wc + bj) + 16 * s + 4 * fq + 2 * n + jp;
    return o < INW ? o : -1;
}
DEV void sincos_acc(float ang, float& c, float& s) {
    const double x = (double)ang, twopi = 6.283185307179586476925287;
    const double k = __builtin_rint(x * (1.0 / twopi));
    const double r = x - k * twopi, r2 = r * r;
    double sp = 1.0, cp = 1.0;
#pragma unroll
    for (int i = 14; i >= 1; --i) { sp = 1.0 - sp * r2 / (double)((2 * i) * (2 * i + 1)); cp = 1.0 - cp * r2 / (double)((2 * i - 1) * (2 * i)); }
    s = (float)(r * sp); c = (float)cp;
}

struct TJob { const float* W; const float* gain; bf16_t* Bt; int N, K, c0, k0, perm; };
DEV TJob tjob_decode(const Params& p, int job) {
    unsigned char* ws = p.ws;
    const int l = job / 3008; int r = job % 3008; TJob j;
    if (r < 704) { j.W = p.w_in + (size_t)l * DM * INW; j.gain = p.g_mix + l * DM; j.Bt = (bf16_t*)(ws + WS_WIN + (size_t)l * SZ_WIN1); j.N = INW; j.K = DM; j.c0 = (r >> 4) * 64; j.k0 = (r & 15) * 64; j.perm = 1; }
    else if (r < 960) { r -= 704; j.W = p.w_out + (size_t)l * DM * DM; j.gain = nullptr; j.Bt = (bf16_t*)(ws + WS_WOUT + (size_t)l * SZ_WOUT1); j.N = DM; j.K = DM; j.c0 = (r >> 4) * 64; j.k0 = (r & 15) * 64; j.perm = 0; }
    else if (r < 1984) { r -= 960; j.W = p.w_up + (size_t)l * DM * DFF; j.gain = p.g_ffn + l * DM; j.Bt = (bf16_t*)(ws + WS_WUP + (size_t)l * SZ_WUP1); j.N = DFF; j.K = DM; j.c0 = (r >> 4) * 64; j.k0 = (r & 15) * 64; j.perm = 0; }
    else { r -= 1984; j.W = p.w_down + (size_t)l * DFF * DM; j.gain = nullptr; j.Bt = (bf16_t*)(ws + WS_WDN + (size_t)l * SZ_WUP1); j.N = DM; j.K = DFF; j.c0 = (r >> 6) * 64; j.k0 = (r & 63) * 64; j.perm = 0; }
    return j;
}
DEV void tjob_load(const TJob& j, float (&v)[8], int tid) {
    if (j.perm) {
#pragma unroll
        for (int it = 0; it < 8; ++it) {
            const int idx = tid + 512 * it, kk = idx >> 6, cc = idx & 63, o = win_colmap(j.c0 + cc);
            v[it] = (o >= 0) ? j.W[(size_t)(j.k0 + kk) * j.N + o] * j.gain[j.k0 + kk] : 0.f;
        }
    } else {
#pragma unroll
        for (int it = 0; it < 2; ++it) {
            const int idx = tid + 512 * it, kk = idx >> 4, c4 = idx & 15;
            const f32x4 x = ntl4(j.W + (size_t)(j.k0 + kk) * j.N + j.c0 + 4 * c4);
            const float g = j.gain ? j.gain[j.k0 + kk] : 1.f;
#pragma unroll
            for (int e = 0; e < 4; ++e) v[4 * it + e] = x[e] * g;
        }
    }
}
DEV void tjob_lds(const TJob& j, const float (&v)[8], float* tile, int tid) {
    if (j.perm) {
#pragma unroll
        for (int it = 0; it < 8; ++it) { const int idx = tid + 512 * it; tile[(idx & 63) * 65 + (idx >> 6)] = v[it]; }
    } else {
#pragma unroll
        for (int it = 0; it < 2; ++it) {
            const int idx = tid + 512 * it, kk = idx >> 4, c4 = idx & 15;
#pragma unroll
            for (int e = 0; e < 4; ++e) tile[(4 * c4 + e) * 65 + kk] = v[4 * it + e];
        }
    }
}
DEV void tjob_flush(const TJob& j, const float* tile, int tid) {
    const int cc = tid >> 3, kg = tid & 7;
    float v[8];
#pragma unroll
    for (int i = 0; i < 8; ++i) v[i] = tile[cc * 65 + 8 * kg + i];
    *(u32x4*)(j.Bt + (size_t)(j.c0 + cc) * j.K + j.k0 + 8 * kg) = pack8(v);
}

DEV void transpose_jobs(const Params& p, unsigned char* lds, int j0, int j1, int me, int nblk);
DEV void phase_prologue(const Params& p, unsigned char* lds) {
    const int tid = otid(), lane = tid & 63, G = gridDim.x;
    unsigned char* ws = p.ws;
    {
        bf16_t* XB = (bf16_t*)(ws + WS_XB); float* SS = (float*)(ws + WS_SS);
        for (int row0 = blockIdx.x * 8 + (tid >> 6); row0 < MT; row0 += G * 16) {
            f32x4 v[2][4]; int rows[2];
#pragma unroll
            for (int h = 0; h < 2; ++h) {
                const int row = row0 + h * G * 8; rows[h] = row;
                if (row < MT) {
                    const float* src = row < NPR ? p.x_prompt + (size_t)row * DM : p.x_sample + (size_t)(row - NPR) * DM;
#pragma unroll
                    for (int i = 0; i < 4; ++i) v[h][i] = ntl4(src + i * 256 + lane * 4);
                }
            }
#pragma unroll
            for (int h = 0; h < 2; ++h) {
                const int row = rows[h];
                if (row < MT) {
                    bf16_t* xb = XB + (size_t)row * DM;
                    float sq = 0.f;
#pragma unroll
                    for (int i = 0; i < 4; ++i) {
                        const f32x4 x = v[h][i];
                        *(u32x2*)(xb + i * 256 + lane * 4) = (u32x2){pk2(x[0], x[1]), pk2(x[2], x[3])};
                        sq += (x[0] * x[0] + x[1] * x[1]) + (x[2] * x[2] + x[3] * x[3]);
                    }
                    sq = wave_sum(sq);
                    if (lane < 16) SS[(size_t)row * 16 + lane] = lane == 0 ? sq : 0.f;
                }
            }
        }
    }
    const int gtid = blockIdx.x * NTHREADS + tid, gsz = G * NTHREADS;
    {
        float* RT = (float*)(ws + WS_ROPE);
        for (int i = gtid; i < 2080 * 32; i += gsz) {
            const int pi = i >> 5, k = i & 31, pos = pi < 2048 ? pi : PAST + (pi - 2048);
            float c, s; sincos_acc((float)pos * c_invf[k], c, s);
            RT[pi * 64 + k] = c; RT[pi * 64 + 32 + k] = s;
        }
    }
    {
        bf16_t* KIS = (bf16_t*)(ws + WS_KIS);
        for (int i = gtid; i < 2 * 8 * PAST * 4; i += gsz) {
            const int dg = i & 3, key = (i >> 2) & 4095, lb = i >> 14;
            const float* src = p.cache_kidx + ((size_t)lb * PAST + key) * 32 + dg * 8;
            const f32x4 a = *(const f32x4*)src, b = *(const f32x4*)(src + 4);
            *(u32x4*)(KIS + ((size_t)lb * LSP + key) * 32 + dg * 8) = (u32x4){pk2(a[0], a[1]), pk2(a[2], a[3]), pk2(b[0], b[1]), pk2(b[2], b[3])};
        }
    }
    transpose_jobs(p, lds, 0, 6016, blockIdx.x, G);
}
DEV void transpose_jobs(const Params& p, unsigned char* lds, int j0, int j1, int me, int nblk) {
    const int tid = otid();
    {
        float* tile = (float*)lds;
        for (int jb = j0 + me * 4; jb < j1; jb += nblk * 4) {
            float v[4][8];
#pragma unroll
            for (int u = 0; u < 4; ++u) { const TJob j = tjob_decode(p, jb + u); tjob_load(j, v[u], tid); }
#pragma unroll
            for (int u = 0; u < 4; ++u) { const TJob j = tjob_decode(p, jb + u); tjob_lds(j, v[u], tile + u * 4160, tid); }
            __syncthreads();
#pragma unroll
            for (int u = 0; u < 4; ++u) { const TJob j = tjob_decode(p, jb + u); tjob_flush(j, tile + u * 4160, tid); }
            __syncthreads();
        }
    }
}

DEV unsigned sort_key(float f) { const unsigned u = __float_as_uint(f); return (u & 0x80000000u) ? ~u : (u | 0x80000000u); }

DEV int wave_isum(int v) {
    v += __builtin_amdgcn_update_dpp(0, v, 0x111, 0xf, 0xf, true);
    v += __builtin_amdgcn_update_dpp(0, v, 0x112, 0xf, 0xf, true);
    v += __builtin_amdgcn_update_dpp(0, v, 0x114, 0xf, 0xf, true);
    v += __builtin_amdgcn_update_dpp(0, v, 0x118, 0xf, 0xf, true);
    v += __builtin_amdgcn_update_dpp(0, v, 0x142, 0xa, 0xf, false);
    v += __builtin_amdgcn_update_dpp(0, v, 0x143, 0xc, 0xf, false);
    return __builtin_amdgcn_readlane(v, 63);
}
template <int NCH, int NR> DEV void select_rows(const float* rowf, int npad, int nch, u64* bmr, int bmstride, int lane) {
    asm volatile("" : "+s"(nch));
    unsigned kreg[NR][NCH];
#pragma unroll
    for (int r = 0; r < NR; ++r)
#pragma unroll
        for (int c = 0; c < NCH; ++c) {
            const unsigned k = sort_key(rowf[(size_t)r * npad + c * 64 + lane]);
            kreg[r][c] = (c < nch) ? k : 0u;
        }
    unsigned T[NR]; bool done[NR];
#pragma unroll
    for (int r = 0; r < NR; ++r) { T[r] = 0u; done[r] = false; }
    for (int bit = 31; bit >= 0; --bit) {
        unsigned cand[NR]; int cnt[NR];
#pragma unroll
        for (int r = 0; r < NR; ++r) { cand[r] = T[r] | (1u << bit); cnt[r] = 0; }
#pragma unroll
        for (int c = 0; c < NCH; ++c) {
            if ((c & 7) == 0 && c >= nch) break;
#pragma unroll
            for (int r = 0; r < NR; ++r) cnt[r] += (kreg[r][c] >= cand[r]) ? 1 : 0;
        }
        bool alldone = true;
#pragma unroll
        for (int r = 0; r < NR; ++r) {
            const int tot = wave_isum(cnt[r]);
            if (tot >= 256) T[r] = cand[r];
            if (tot == 256) done[r] = true;
            alldone = alldone && done[r];
        }
        if (alldone) break;
    }
#pragma unroll
    for (int r = 0; r < NR; ++r) {
        int cg = 0;
#pragma unroll
        for (int c = 0; c < NCH; ++c) { if ((c & 7) == 0 && c >= nch) break; cg += (kreg[r][c] > T[r]) ? 1 : 0; }
        const int need = 256 - wave_isum(cg);
        int eqbase = 0;
#pragma unroll
        for (int c = 0; c < NCH; ++c) {
            if (c < nch) {
                const unsigned kv = kreg[r][c];
                const bool eq = (kv == T[r]);
                const u64 be = __ballot(eq);
                const int rank = eqbase + __popcll(be & ((1ull << lane) - 1ull));
                const bool sel = (kv > T[r]) || (eq && rank < need);
                const u64 bs = __ballot(sel);
                eqbase += __popcll(be);
                if (lane == 0) bmr[(size_t)r * bmstride + c] = bs;
            }
        }
    }
}

struct IdxItem { int nq, n, row0, bmstride; const bf16_t* KI; u64* BM; };
DEV IdxItem idx_decode(const Params& p, int layer, int item) {
    unsigned char* ws = p.ws; IdxItem I;
    if (item < 32) {
        const int b = item >> 2, qt = item & 3;
        I.nq = 8; I.n = LS; I.row0 = NPR + b * 32 + qt * 8;
        I.KI = (const bf16_t*)(ws + WS_KIS + (size_t)layer * SZ_KIS1) + (size_t)b * LSP * 32;
        I.BM = (u64*)(ws + WS_BMS) + (size_t)(b * 32 + qt * 8) * 72; I.bmstride = 72;
    } else {
        const int i2 = item - 32, c = 31 - (i2 >> 5), w = i2 & 31, b = w >> 2, qt = w & 3;
        I.nq = 16; I.n = 64 * (c + 1); I.row0 = b * TP + 64 * c + 16 * qt;
        I.KI = (const bf16_t*)(ws + WS_KIP) + (size_t)b * TP * 32;
        I.BM = (u64*)(ws + WS_BMP) + (size_t)I.row0 * 32; I.bmstride = 32;
    }
    return I;
}
struct IdxPre { bf16x8 aq[4][2]; bf16x8 nb0, nb1; float wv; };
DEV void idx_prefetch(const Params& p, const IdxItem& I, IdxPre& P, int tid, int lane, int wave) {
    if (I.n <= 256) return;
    unsigned char* ws = p.ws;
    const bf16_t* QI = (const bf16_t*)(ws + WS_QIB); const float* WI = (const float*)(ws + WS_WI);
    P.wv = (tid < I.nq * 8) ? WI[(size_t)I.row0 * 8 + tid] : 0.f;
    const int nqb = I.nq >> 2;
    const int i = lane & 31, a = i >> 3, gi = (i >> 2) & 1, c = i & 3, qin = 2 * gi + (a >> 1), head = 4 * (a & 1) + c;
#pragma unroll
    for (int qb = 0; qb < 4; ++qb)
#pragma unroll
        for (int ks = 0; ks < 2; ++ks) {
            if (qb < nqb) P.aq[qb][ks] = *(const bf16x8*)(QI + (size_t)(I.row0 + 4 * qb + qin) * 256 + head * 32 + 8 * (lane >> 5) + 16 * ks);
            else P.aq[qb][ks] = (bf16x8){0, 0, 0, 0, 0, 0, 0, 0};
        }
    const int g = lane >> 5, nkb = I.n >> 5;
    P.nb0 = (bf16x8){0, 0, 0, 0, 0, 0, 0, 0}; P.nb1 = P.nb0;
    if (wave < nkb) { const bf16_t* kp = I.KI + (size_t)(wave * 32 + (lane & 31)) * 32 + 8 * g; P.nb0 = *(const bf16x8*)kp; P.nb1 = *(const bf16x8*)(kp + 16); }
}
DEV int indexer_item(const Params& p, int layer, int item, unsigned char* lds, const IdxPre& P, int nxt, volatile int* slot, IdxPre& Pn) {
    const int tid = otid(), lane = tid & 63, wave = __builtin_amdgcn_readfirstlane(tid >> 6);
    const IdxItem I = idx_decode(p, layer, item);
    const int nq = I.nq, n = I.n, bmstride = I.bmstride; u64* BM = I.BM; const bf16_t* KI = I.KI;
    const int ntile = (n + 63) >> 6;
    if (n <= 256) {
        if (tid < nq * ntile) BM[(size_t)(tid / ntile) * bmstride + (tid % ntile)] = ~0ull;
        if (tid == 0) slot[1] = nxt;
        __syncthreads();
        const int nx = __builtin_amdgcn_readfirstlane(slot[1]);
        __syncthreads();
        if (nx < 1056) idx_prefetch(p, idx_decode(p, layer, nx), Pn, tid, lane, wave);
        return nx;
    }
    const int npad = ntile * 64;
    float* sc = (float*)lds;
    float* wl = (float*)(lds + 133120);
    if (tid < nq * 8) wl[tid] = P.wv;
    const int nqb = nq >> 2;
    const int g = lane >> 5;
    const int nkb = n >> 5;
    bf16x8 nb0 = P.nb0, nb1 = P.nb1;
    __syncthreads();
    for (int kb = wave; kb < nkb; kb += 8) {
        const int key = kb * 32 + (lane & 31);
        const bf16x8 b0 = nb0, b1 = nb1;
        if (kb + 8 < nkb) { const bf16_t* kp = KI + (size_t)(key + 256) * 32 + 8 * g; nb0 = *(const bf16x8*)kp; nb1 = *(const bf16x8*)(kp + 16); }
#pragma unroll
        for (int qb = 0; qb < 4; ++qb) {
            if (qb < nqb) {
                f32x16 acc;
#pragma unroll
                for (int r = 0; r < 16; ++r) acc[r] = 0.f;
                acc = __builtin_amdgcn_mfma_f32_32x32x16_bf16(P.aq[qb][0], b0, acc, 0, 0, 0);
                acc = __builtin_amdgcn_mfma_f32_32x32x16_bf16(P.aq[qb][1], b1, acc, 0, 0, 0);
#pragma unroll
                for (int qq = 0; qq < 2; ++qq) {
                    const int ql = 4 * qb + 2 * g + qq;
                    const f32x4 w0 = *(const f32x4*)(wl + ql * 8), w1 = *(const f32x4*)(wl + ql * 8 + 4);
                    float s = 0.f;
#pragma unroll
                    for (int h = 0; h < 4; ++h) s = fmaf(w0[h], __builtin_amdgcn_fmed3f(acc[8 * qq + h], 0.f, __builtin_inff()), s);
#pragma unroll
                    for (int h = 0; h < 4; ++h) s = fmaf(w1[h], __builtin_amdgcn_fmed3f(acc[8 * qq + 4 + h], 0.f, __builtin_inff()), s);
                    s = (s == 0.f) ? 0.f : s;
                    sc[(size_t)ql * npad + key] = s;
                }
            }
        }
    }
    if (npad > n && tid < nq * (npad - n)) sc[(size_t)(tid / (npad - n)) * npad + n + tid % (npad - n)] = -__builtin_inff();
    if (tid == 0) slot[1] = nxt;
    __syncthreads();
    const int nx = __builtin_amdgcn_readfirstlane(slot[1]);
    if (nx < 1056) idx_prefetch(p, idx_decode(p, layer, nx), Pn, tid, lane, wave);
    const float* scf = (const float*)lds;
    if (nq == 16) select_rows<32, 2>(scf + (size_t)(2 * wave) * npad, npad, ntile, BM + (size_t)(2 * wave) * bmstride, bmstride, lane);
    else select_rows<65, 1>(scf + (size_t)wave * npad, npad, ntile, BM + (size_t)wave * bmstride, bmstride, lane);
    __syncthreads();
    return nx;
}

DEV void sgate_item(const Params& p, int layer, int item) {
    const int tid = otid(), lane = tid & 63, wave = tid >> 6, fr = lane & 15, quad = lane >> 4;
    unsigned char* ws = p.ws;
    int row0, ni, h;
    if (item < 512) { h = item & 3; row0 = (item >> 2) * 128; ni = 128; } else { const int i2 = item - 512; h = i2 & 3; row0 = NPR + (i2 >> 2) * 32; ni = 32; }
    if (wave * 16 >= ni) return;
    const int ksmax = (ni == 32) ? 1 : (wave < 4 ? 2 : 4);
    const float* W = p.w_s + ((size_t)(layer * 4 + h) * 128 + wave * 16 + fr) * 128;
    const bf16_t* SGVT = (const bf16_t*)(ws + WS_SGVT);
    f32x4 acc[4];
#pragma unroll
    for (int nn = 0; nn < 4; ++nn) acc[nn] = (f32x4){0.f, 0.f, 0.f, 0.f};
    f32x4 a0[4], a1[4]; bf16x8 bfr[4][4];
#pragma unroll
    for (int ks = 0; ks < 4; ++ks)
        if (ks < ksmax) {
            a0[ks] = *(const f32x4*)(W + 32 * ks + 8 * quad); a1[ks] = *(const f32x4*)(W + 32 * ks + 8 * quad + 4);
#pragma unroll
            for (int nn = 0; nn < 4; ++nn) bfr[ks][nn] = *(const bf16x8*)(SGVT + (size_t)(h * 64 + 16 * nn + fr) * MT + row0 + 32 * ks + 8 * quad);
        }
    const bf16_t* ZAU = (const bf16_t*)(ws + WS_ZAU); bf16_t* YMIX = (bf16_t*)(ws + WS_YMIX);
    unsigned short uu[4][4]; float bias[4];
#pragma unroll
    for (int j = 0; j < 4; ++j) {
        const int i = wave * 16 + 4 * quad + j;
        bias[j] = p.b_s[(layer * 4 + h) * 128 + i];
#pragma unroll
        for (int nn = 0; nn < 4; ++nn) uu[j][nn] = ZAU[(size_t)(row0 + i) * 256 + h * 64 + 16 * nn + fr];
    }
#pragma unroll
    for (int ks = 0; ks < 4; ++ks)
        if (ks < ksmax) {
            const u32x4 aw = (u32x4){pk2(a0[ks][0], a0[ks][1]), pk2(a0[ks][2], a0[ks][3]), pk2(a1[ks][0], a1[ks][1]), pk2(a1[ks][2], a1[ks][3])};
            const bf16x8 af = __builtin_bit_cast(bf16x8, aw);
#pragma unroll
            for (int nn = 0; nn < 4; ++nn) acc[nn] = __builtin_amdgcn_mfma_f32_16x16x32_bf16(af, bfr[ks][nn], acc[nn], 0, 0, 0);
        }
#pragma unroll
    for (int j = 0; j < 4; ++j) {
        const int i = wave * 16 + 4 * quad + j;
#pragma unroll
        for (int nn = 0; nn < 4; ++nn) YMIX[(size_t)(row0 + i) * 1024 + h * 64 + 16 * nn + fr] = f2bf(bf2f(uu[j][nn]) * (acc[nn][j] + bias[j]));
    }
}

DEV void conv_one(const Params& p, int layer, const bf16_t* ZB, bf16_t* YMIX, int i) {
    {
        const int row = i >> 5, ch = (i & 31) * 8;
        const bool samp = row >= NPR; const int rs = row - NPR;
        const int b = samp ? (rs >> 5) : (row >> 11), t = samp ? (rs & 31) : (row & 2047), T = samp ? 32 : TP;
        float xc[3][8];
#pragma unroll
        for (int dt = 0; dt < 3; ++dt) {
            const int tt = t - 2 + dt;
            if (tt >= 0) {
                const bf16_t* zr = ZB + (size_t)(row - 2 + dt) * 768 + ch;
                const u32x4 gc = *(const u32x4*)(zr + 256), hi = *(const u32x4*)(zr + 512);
#pragma unroll
                for (int e = 0; e < 4; ++e) {
                    xc[dt][2 * e] = __uint_as_float(gc[e] << 16) * __uint_as_float(hi[e] << 16);
                    xc[dt][2 * e + 1] = __uint_as_float(gc[e] & 0xffff0000u) * __uint_as_float(hi[e] & 0xffff0000u);
                }
            } else if (samp) {
                const float* st = p.state_conv + (((size_t)layer * 8 + b) * 2 + (tt + 2)) * 256 + ch;
                const f32x4 a = *(const f32x4*)st, c = *(const f32x4*)(st + 4);
#pragma unroll
                for (int e = 0; e < 4; ++e) { xc[dt][e] = a[e]; xc[dt][4 + e] = c[e]; }
            } else {
#pragma unroll
                for (int e = 0; e < 8; ++e) xc[dt][e] = 0.f;
            }
        }
        const u32x4 gb = *(const u32x4*)(ZB + (size_t)row * 768 + ch);
        const float* cw = p.conv_w + (size_t)layer * 3 * 256 + ch;
        float y[8];
#pragma unroll
        for (int e = 0; e < 8; ++e) {
            const float gbe = (e & 1) ? __uint_as_float(gb[e >> 1] & 0xffff0000u) : __uint_as_float(gb[e >> 1] << 16);
            y[e] = gbe * (cw[e] * xc[0][e] + cw[256 + e] * xc[1][e] + cw[512 + e] * xc[2][e]);
        }
        *(u32x4*)(YMIX + (size_t)row * 1024 + 256 + ch) = pack8(y);
        if (t >= T - 2) {
            float* d = p.out + (samp ? O_CS : O_CP) + (((size_t)layer * 8 + b) * 2 + (t - (T - 2))) * 256 + ch;
            *(f32x4*)d = (f32x4){xc[2][0], xc[2][1], xc[2][2], xc[2][3]}; *(f32x4*)(d + 4) = (f32x4){xc[2][4], xc[2][5], xc[2][6], xc[2][7]};
        }
    }
}

DEV void phase_mix_a(const Params& p, int layer, unsigned char* lds) {
    {
        unsigned char* ws = p.ws;
        const bf16_t* ZB = (const bf16_t*)(ws + WS_ZB); bf16_t* YMIX = (bf16_t*)(ws + WS_YMIX);
        for (int i = blockIdx.x * NTHREADS + otid(); i < MT * 32; i += gridDim.x * NTHREADS) conv_one(p, layer, ZB, YMIX, i);
    }
    {
        const int tid = otid(), lane = tid & 63, wave = __builtin_amdgcn_readfirstlane(tid >> 6);
        unsigned* ctr = (unsigned*)(p.ws + WS_BAR) + 3712 + 64 * layer;
        volatile int* slot = (volatile int*)(lds + LDS_BYTES - 32);
        if (tid == 0) slot[0] = (int)__hip_atomic_fetch_add(ctr, 1u, __ATOMIC_RELAXED, __HIP_MEMORY_SCOPE_AGENT);
        __syncthreads();
        int it = __builtin_amdgcn_readfirstlane(slot[0]);
        IdxPre P;
        if (it < 1056) idx_prefetch(p, idx_decode(p, layer, it), P, tid, lane, wave);
        while (it < 1056 + 544) {
            int nxt = 0;
            if (tid == 0) nxt = (int)__hip_atomic_fetch_add(ctr, 1u, __ATOMIC_RELAXED, __HIP_MEMORY_SCOPE_AGENT);
            if (it < 1056) {
                IdxPre Pn;
                it = indexer_item(p, layer, it, lds, P, nxt, slot, Pn);
                P = Pn;
            } else {
                sgate_item(p, layer, it - 1056);
                if (tid == 0) slot[1] = nxt;
                __syncthreads();
                it = __builtin_amdgcn_readfirstlane(slot[1]);
                __syncthreads();
            }
        }
    }
}

constexpr int AT_VP = 136;
constexpr int AT_KT = 8192, AT_VT = 64 * AT_VP, AT_BUF = AT_KT + AT_VT, AT_GRP = 2 * AT_BUF;
template <bool SAMPLE> struct AttnRaw { u32x4 k[2]; u32x4 v[2]; };
template <> struct AttnRaw<true> { f32x4 k[2][2]; f32x4 v[2][2]; };
struct AttnSrc { const bf16_t* kb; const bf16_t* vt; const float* ck; const float* cv; const float* nk; const float* nv; };

template <bool SAMPLE> DEV void attn_load(AttnRaw<SAMPLE>& raw, const AttnSrc& S, int kt, int tg) {
#pragma unroll
    for (int r = 0; r < 2; ++r) {
        const int q = tg + 256 * r;
        if constexpr (!SAMPLE) {
            raw.k[r] = *(const u32x4*)(S.kb + (size_t)(kt * 64 + (q >> 3)) * 64 + 8 * (q & 7));
            raw.v[r] = *(const u32x4*)(S.vt + (size_t)(q >> 3) * TPV + kt * 64 + 8 * (q & 7));
        } else {
            {
                const int key = kt * 64 + (q >> 3), g = q & 7;
                if (key < LS) { const float* s = key < PAST ? S.ck + (size_t)key * 256 + 8 * g : S.nk + (size_t)(key - PAST) * 256 + 8 * g; raw.k[r][0] = ntl4(s); raw.k[r][1] = ntl4(s + 4); }
                else { raw.k[r][0] = (f32x4){0.f, 0.f, 0.f, 0.f}; raw.k[r][1] = raw.k[r][0]; }
            }
            {
                const int key = kt * 64 + (q >> 3), g = q & 7;
                if (key < LS) { const float* s = key < PAST ? S.cv + (size_t)key * 256 + 8 * g : S.nv + (size_t)(key - PAST) * 256 + 8 * g; raw.v[r][0] = ntl4(s); raw.v[r][1] = ntl4(s + 4); }
                else { raw.v[r][0] = (f32x4){0.f, 0.f, 0.f, 0.f}; raw.v[r][1] = raw.v[r][0]; }
            }
        }
    }
}
template <bool SAMPLE> DEV void attn_store(const AttnRaw<SAMPLE>& raw, unsigned char* buf, int tg) {
#pragma unroll
    for (int r = 0; r < 2; ++r) {
        const int q = tg + 256 * r, row = q >> 3, g = q & 7;
        unsigned char* kd = buf + row * 128 + ((g ^ ((row >> 1) & 7)) << 4);
        if constexpr (!SAMPLE) {
            *(u32x4*)kd = raw.k[r];
            *(u32x2*)(buf + AT_KT + row * AT_VP + 16 * g) = (u32x2){raw.v[r].x, raw.v[r].y}; *(u32x2*)(buf + AT_KT + row * AT_VP + 16 * g + 8) = (u32x2){raw.v[r].z, raw.v[r].w};
        } else {
            *(u32x4*)kd = (u32x4){pk2(raw.k[r][0][0], raw.k[r][0][1]), pk2(raw.k[r][0][2], raw.k[r][0][3]), pk2(raw.k[r][1][0], raw.k[r][1][1]), pk2(raw.k[r][1][2], raw.k[r][1][3])};
            const int kl = q >> 3, gv = q & 7;
            bf16_t* vd = (bf16_t*)(buf + AT_KT + (8 * gv) * AT_VP) + kl;
#pragma unroll
            for (int e = 0; e < 4; ++e) { vd[e * (AT_VP / 2)] = f2bf(raw.v[r][0][e]); vd[(4 + e) * (AT_VP / 2)] = f2bf(raw.v[r][1][e]); }
        }
    }
}
template <int NG> DEV void attn_tile(const unsigned char* buf, const bf16x8 (&qf)[NG][2], u64 mw, float c1, float c2, f32x4 (&o)[NG][4], float (&lsum)[NG], int fr, int quad) {
    const u64 mq = mw >> (4 * quad);
    const int mlo = (int)(unsigned)mq, mhi = (int)(unsigned)(mq >> 32);
    const unsigned nb = __float_as_uint(-c2);
    f32x4 zi[4];
#pragma unroll
    for (int t = 0; t < 4; ++t)
#pragma unroll
        for (int j = 0; j < 4; ++j) {
            const unsigned m = (unsigned)__builtin_amdgcn_sbfe(t < 2 ? mlo : mhi, 16 * (t & 1) + j, 1);
            zi[t][j] = __uint_as_float((m & nb) | (~m & 0xf149f2cau));
        }
    f32x4 st[NG][4];
#pragma unroll
    for (int t = 0; t < 4; ++t) {
        const int row = 16 * t + fr, sw = (row >> 1) & 7;
        const bf16x8 k0 = *(const bf16x8*)(buf + row * 128 + ((quad ^ sw) << 4)), k1 = *(const bf16x8*)(buf + row * 128 + (((quad + 4) ^ sw) << 4));
#pragma unroll
        for (int g = 0; g < NG; ++g) {
            const f32x4 z = __builtin_amdgcn_mfma_f32_16x16x32_bf16(k0, qf[g][0], zi[t], 0, 0, 0);
            st[g][t] = __builtin_amdgcn_mfma_f32_16x16x32_bf16(k1, qf[g][1], z, 0, 0, 0);
        }
    }
    u32x4 pw[NG][2];
#pragma unroll
    for (int g = 0; g < NG; ++g) {
#pragma unroll
        for (int t = 0; t < 4; ++t)
#pragma unroll
            for (int j = 0; j < 4; ++j) {
                const float pv = __builtin_amdgcn_exp2f(st[g][t][j]);
                st[g][t][j] = pv; lsum[g] += pv;
            }
#pragma unroll
        for (int i = 0; i < 2; ++i)
            pw[g][i] = (u32x4){pk2(st[g][2 * i][0], st[g][2 * i][1]), pk2(st[g][2 * i][2], st[g][2 * i][3]), pk2(st[g][2 * i + 1][0], st[g][2 * i + 1][1]), pk2(st[g][2 * i + 1][2], st[g][2 * i + 1][3])};
    }
#pragma unroll
    for (int i = 0; i < 2; ++i)
#pragma unroll
        for (int nn = 0; nn < 4; ++nn) {
            const unsigned char* vr = buf + AT_KT + (16 * nn + fr) * AT_VP + 64 * i + 8 * quad;
            const u32x2 v0 = *(const u32x2*)vr, v1 = *(const u32x2*)(vr + 32);
            const bf16x8 vb = __builtin_bit_cast(bf16x8, (u32x4){v0.x, v0.y, v1.x, v1.y});
#pragma unroll
            for (int g = 0; g < NG; ++g) o[g][nn] = __builtin_amdgcn_mfma_f32_16x16x32_bf16(__builtin_bit_cast(bf16x8, pw[g][i]), vb, o[g][nn], 0, 0, 0);
        }
}
template <bool SAMPLE, int NG> DEV void attn_stream(const AttnSrc& S, const bf16_t* Qrow, const u64* bmrow, int kt0, int kt1, int nsteps, unsigned char* glds, int tg, int lane, float c1, float c2, f32x4 (&o)[NG][4], float (&lsum)[NG]) {
    const int fr = lane & 15, quad = lane >> 4;
    bf16x8 qf[NG][2];
#pragma unroll
    for (int g = 0; g < NG; ++g) { qf[g][0] = *(const bf16x8*)(Qrow + 64 * g + 8 * quad); qf[g][1] = *(const bf16x8*)(Qrow + 64 * g + 32 + 8 * quad); }
    const int klast = kt1 - 1;
    AttnRaw<SAMPLE> R0, R1, R2;
    u64 mwn = bmrow[kt0];
    attn_load<SAMPLE>(R0, S, kt0, tg);
    attn_load<SAMPLE>(R1, S, min(kt0 + 1, klast), tg);
    attn_load<SAMPLE>(R2, S, min(kt0 + 2, klast), tg);
    attn_store<SAMPLE>(R0, glds, tg);
    __syncthreads();
#define ATTN_STEP(CUR, RSTORE, RLOAD, SIDX) do { \
        const u64 mw = mwn; \
        mwn = (kt0 + (SIDX) + 1 < kt1) ? bmrow[kt0 + (SIDX) + 1] : 0ull; \
        attn_load<SAMPLE>(RLOAD, S, min(kt0 + (SIDX) + 3, klast), tg); \
        attn_tile<NG>(glds + (CUR) * AT_BUF, qf, mw, c1, c2, o, lsum, fr, quad); \
        attn_store<SAMPLE>(RSTORE, glds + ((CUR) ^ 1) * AT_BUF, tg); \
        __syncthreads(); } while (0)
    for (int s = 0; s < nsteps; s += 6) {
        ATTN_STEP(0, R1, R0, s);
        if (s + 1 < nsteps) ATTN_STEP(1, R2, R1, s + 1);
        if (s + 2 < nsteps) ATTN_STEP(0, R0, R2, s + 2);
        if (s + 3 < nsteps) ATTN_STEP(1, R1, R0, s + 3);
        if (s + 4 < nsteps) ATTN_STEP(0, R2, R1, s + 4);
        if (s + 5 < nsteps) ATTN_STEP(1, R0, R2, s + 5);
    }
#undef ATTN_STEP
}
template <int NG> DEV void attn_finish(bf16_t* YMIX, int rowq, int head0, f32x4 (&o)[NG][4], float (&lsum)[NG], int lane) {
    const int fr = lane & 15, quad = lane >> 4;
#pragma unroll
    for (int g = 0; g < NG; ++g) {
        float ls = lsum[g];
        ls += __shfl_xor(ls, 16); ls += __shfl_xor(ls, 32);
#pragma unroll
        for (int j = 0; j < 4; ++j) {
            const float l = __shfl(ls, 4 * quad + j);
            const float inv = 1.0f / l;
#pragma unroll
            for (int nn = 0; nn < 4; ++nn) YMIX[(size_t)(rowq + 4 * quad + j) * 1024 + 512 + (head0 + g) * 64 + 16 * nn + fr] = f2bf(o[g][nn][j] * inv);
        }
    }
}
DEV void attn_prompt_item(const Params& p, int idx, float c1, float c2, unsigned char* lds) {
    const int tid = otid(), lane = tid & 63, wave = tid >> 6, fr = lane & 15, grp = wave >> 2, wg = wave & 3;
    unsigned char* ws = p.ws;
    const int c = 31 - (idx >> 4), r = idx & 15, b = r >> 1, hk = 2 * (r & 1) + grp;
    const int rowq = b * TP + 64 * c + 16 * wg;
    f32x4 o[2][4];
#pragma unroll
    for (int g = 0; g < 2; ++g)
#pragma unroll
        for (int nn = 0; nn < 4; ++nn) o[g][nn] = (f32x4){0.f, 0.f, 0.f, 0.f};
    float lsum[2] = {0.f, 0.f};
    AttnSrc S{};
    S.kb = (const bf16_t*)(ws + WS_KP) + (size_t)(b * 4 + hk) * TP * 64;
    S.vt = (const bf16_t*)(ws + WS_VTP) + (size_t)(b * 4 + hk) * 64 * TPV;
    const u64* bm = (const u64*)(ws + WS_BMP) + (size_t)(rowq + fr) * 32;
    attn_stream<false, 2>(S, (const bf16_t*)(ws + WS_QB) + (size_t)(rowq + fr) * 512 + 2 * hk * 64, bm, 0, c + 1, c + 1, lds + grp * AT_GRP, tid & 255, lane, c1, c2, o, lsum);
    attn_finish<2>((bf16_t*)(ws + WS_YMIX), rowq, 2 * hk, o, lsum, lane);
}
DEV void attn_sample_item(const Params& p, int layer, int item, float c1, float c2, unsigned char* lds) {
    const int tid = otid(), lane = tid & 63, wave = tid >> 6, fr = lane & 15, quad = lane >> 4, grp = wave >> 2, wg = wave & 3;
    unsigned char* ws = p.ws;
    const int qt = item & 3, bh = item >> 2, b = bh >> 2, hk = bh & 3, head = 2 * hk + (wg >> 1);
    const int rowq = NPR + b * 32 + 16 * (wg & 1);
    const int t0 = (qt == 0) ? 0 : 1 + 16 * qt, t1 = 17 + 16 * qt;
    const int tm = t0 + ((t1 - t0 + 1) >> 1), nsteps = tm - t0;
    f32x4 o[1][4];
#pragma unroll
    for (int nn = 0; nn < 4; ++nn) o[0][nn] = (f32x4){0.f, 0.f, 0.f, 0.f};
    float lsum[1] = {0.f};
    AttnSrc S{};
    S.ck = p.cache_k + (size_t)(layer * 8 + b) * PAST * 256 + hk * 64; S.cv = p.cache_v + (size_t)(layer * 8 + b) * PAST * 256 + hk * 64;
    S.nk = p.out + O_KS + (size_t)(layer * NSR + b * 32) * 256 + hk * 64; S.nv = p.out + O_VS + (size_t)(layer * NSR + b * 32) * 256 + hk * 64;
    const u64* bm = (const u64*)(ws + WS_BMS) + (size_t)(b * 32 + 16 * (wg & 1) + fr) * 72;
    attn_stream<true, 1>(S, (const bf16_t*)(ws + WS_QB) + (size_t)(rowq + fr) * 512 + head * 64, bm, grp ? tm : t0, grp ? t1 : tm, nsteps, lds + grp * AT_GRP, tid & 255, lane, c1, c2, o, lsum);
    float* xo = (float*)lds;
    if (grp) {
        float* d = xo + ((size_t)wg * 64 + lane) * 17;
#pragma unroll
        for (int nn = 0; nn < 4; ++nn)
#pragma unroll
            for (int j = 0; j < 4; ++j) d[nn * 4 + j] = o[0][nn][j];
        d[16] = lsum[0];
    }
    __syncthreads();
    if (!grp) {
        const float* d = xo + ((size_t)wg * 64 + lane) * 17;
#pragma unroll
        for (int nn = 0; nn < 4; ++nn)
#pragma unroll
            for (int j = 0; j < 4; ++j) o[0][nn][j] += d[nn * 4 + j];
        float ls = lsum[0] + d[16];
        ls += __shfl_xor(ls, 16); ls += __shfl_xor(ls, 32);
        float* PO = (float*)(ws + WS_PART) + ((size_t)(bh * 4 + qt) * 64 + wg * 16) * 64;
        float* PL = (float*)(ws + WS_PART + SZ_PARTO) + (size_t)(bh * 4 + qt) * 64 + wg * 16;
#pragma unroll
        for (int j = 0; j < 4; ++j)
#pragma unroll
            for (int nn = 0; nn < 4; ++nn) PO[(size_t)(4 * quad + j) * 64 + 16 * nn + fr] = o[0][nn][j];
        if (quad == 0) PL[fr] = ls;
    }
    __syncthreads();
}
DEV void attn_sample_combine(const Params& p) {
    unsigned char* ws = p.ws;
    const float* PO = (const float*)(ws + WS_PART); const float* PL = (const float*)(ws + WS_PART + SZ_PARTO);
    bf16_t* YMIX = (bf16_t*)(ws + WS_YMIX);
    for (int i = blockIdx.x * NTHREADS + otid(); i < 8 * 4 * 64 * 16; i += gridDim.x * NTHREADS) {
        const int d4 = i & 15, pr = (i >> 4) & 63, bh = i >> 10, b = bh >> 2, hk = bh & 3;
        f32x4 acc = (f32x4){0.f, 0.f, 0.f, 0.f}; float l = 0.f;
#pragma unroll
        for (int q = 0; q < 4; ++q) { acc += *(const f32x4*)(PO + ((size_t)(bh * 4 + q) * 64 + pr) * 64 + 4 * d4); l += PL[(size_t)(bh * 4 + q) * 64 + pr]; }
        const float inv = 1.0f / l;
        const int wg = pr >> 4, qi = 16 * (wg & 1) + (pr & 15), head = 2 * hk + (wg >> 1);
        *(u32x2*)(YMIX + (size_t)(NPR + b * 32 + qi) * 1024 + 512 + head * 64 + 4 * d4) = (u32x2){pk2(acc[0] * inv, acc[1] * inv), pk2(acc[2] * inv, acc[3] * inv)};
    }
}

DEV void phase_attn(const Params& p, int layer, unsigned char* lds, int subset = 0) {
    const int tid = otid(), lane = tid & 63;
    const float gq = wave_max(fabsf(p.q_gain[layer * 64 + lane])), gk = wave_max(fabsf(p.k_gain[layer * 64 + lane]));
    const float bound = 8.0f * gq * gk * 1.02f;
    const float c1 = 0.125f * 1.4426950408889634f, c2 = bound * 1.4426950408889634f;
    unsigned* ctr = (unsigned*)(p.ws + WS_BAR) + 3584 + 64 * layer;
    volatile int* slot = (volatile int*)(lds + LDS_BYTES - 32);
    for (;;) {
        if (tid == 0) *slot = (int)__hip_atomic_fetch_add(ctr, 1u, __ATOMIC_RELAXED, __HIP_MEMORY_SCOPE_AGENT);
        __syncthreads();
        const int it = __builtin_amdgcn_readfirstlane(*slot);
        __syncthreads();
        if (it >= 640) break;
#ifdef PROBE_ATT_SUB
        if (subset == 1 && it >= 128) continue;
        if (subset == 2 && it < 128) continue;
#endif
        if (it < 128) attn_sample_item(p, layer, it, c1, c2, lds);
        else attn_prompt_item(p, it - 128, c1, c2, lds);
    }
}

template <int NT, int CH> DEV void mini_mma(const bf16_t* A, int lda, const bf16_t* Bt, int ldb, int r0, int c0, int k0, int k1, f32x4 (&acc)[NT], int lane) {
    const int fr = lane & 15, quad = lane >> 4;
    const bf16_t* ap = A + (size_t)(r0 + fr) * lda + 8 * quad;
    const bf16_t* bp = Bt + (size_t)(c0 + fr) * ldb + 8 * quad;
    for (int k = k0; k < k1; k += 32 * CH) {
        bf16x8 a[CH], b[NT][CH];
#pragma unroll
        for (int i = 0; i < CH; ++i) {
            a[i] = *(const bf16x8*)(ap + k + 32 * i);
#pragma unroll
            for (int nt = 0; nt < NT; ++nt) b[nt][i] = *(const bf16x8*)(bp + (size_t)16 * nt * ldb + k + 32 * i);
        }
#pragma unroll
        for (int i = 0; i < CH; ++i)
#pragma unroll
            for (int nt = 0; nt < NT; ++nt) acc[nt] = __builtin_amdgcn_mfma_f32_16x16x32_bf16(a[i], b[nt][i], acc[nt], 0, 0, 0);
    }
}
DEV void mini_res(const bf16_t* A, const bf16_t* Bt, int K, float* Y, bf16_t* XB, float* SS, unsigned char* lds, int last, int live) {
    const int tid = otid(), lane = tid & 63, wave = tid >> 6, fr = lane & 15, quad = lane >> 4;
    float* part = (float*)lds;
    float* tile = (float*)(lds + 8 * 64 * 17 * 4);
    for (int t = blockIdx.x; t < 256; t += gridDim.x) {
        const int r0 = NPR + 16 * (t >> 4), ct = t & 15, c0 = 64 * ct, kw = K >> 3;
        f32x4 acc[4];
#pragma unroll
        for (int nt = 0; nt < 4; ++nt) acc[nt] = (f32x4){0.f, 0.f, 0.f, 0.f};
        if (K == DFF) mini_mma<4, 8>(A, K, Bt, K, r0, c0, wave * kw, (wave + 1) * kw, acc, lane);
        else mini_mma<4, 4>(A, K, Bt, K, r0, c0, wave * kw, (wave + 1) * kw, acc, lane);
        float* d = part + ((size_t)wave * 64 + lane) * 17;
#pragma unroll
        for (int nt = 0; nt < 4; ++nt)
#pragma unroll
            for (int j = 0; j < 4; ++j) d[nt * 4 + j] = acc[nt][j];
        __syncthreads();
#pragma unroll
        for (int vv = 0; vv < 2; ++vv) {
            const int v = 2 * wave + vv, nt = v >> 2, j = v & 3;
            float s = 0.f;
#pragma unroll
            for (int w2 = 0; w2 < 8; ++w2) s += part[((size_t)w2 * 64 + lane) * 17 + v];
            const int rl = 4 * quad + j, cl = 16 * nt + fr;
            const size_t off = (size_t)(r0 + rl) * DM + c0 + cl;
            const float xn = bf2f(XB[off]) + s;
            if (live) { if (last) Y[off] = xn; else XB[off] = f2bf(xn); } tile[rl * 65 + cl] = xn;
        }
        __syncthreads();
        if (tid < 16) {
            float sq = 0.f;
            for (int c = 0; c < 64; ++c) { const float v = tile[tid * 65 + c]; sq += v * v; }
            if (live && !last) SS[(size_t)(r0 + tid) * 16 + ct] = sq;
        }
        __syncthreads();
    }
}
DEV void mini_up(const bf16_t* XB, const bf16_t* Bt, const float* SS, bf16_t* H) {
    const int tid = otid(), lane = tid & 63, wave = tid >> 6, fr = lane & 15, quad = lane >> 4;
    for (int t = blockIdx.x; t < 256; t += gridDim.x) {
        const int r0 = NPR + 16 * (t >> 4), c0 = 256 * (t & 15) + 32 * wave;
        f32x4 acc[2];
        acc[0] = (f32x4){0.f, 0.f, 0.f, 0.f}; acc[1] = acc[0];
        mini_mma<2, 16>(XB, DM, Bt, DM, r0, c0, 0, DM, acc, lane);
#pragma unroll
        for (int j = 0; j < 4; ++j) {
            const int row = r0 + 4 * quad + j;
            const float rstd = row_rstd(SS, row);
#pragma unroll
            for (int nt = 0; nt < 2; ++nt) { const float r = fmaxf(acc[nt][j] * rstd, 0.f); H[(size_t)row * DFF + c0 + 16 * nt + fr] = f2bf(r * r); }
        }
    }
}

__global__ void __launch_bounds__(NTHREADS) hybrid_fwd(Params p) {
    extern __shared__ __attribute__((aligned(16))) unsigned char lds[];
    cg::grid_group grid = cg::this_grid();
    PG8_LAS unsigned char* l3 = (PG8_LAS unsigned char*)lds;
    unsigned char* ws = p.ws;
    bf16_t* XB = (bf16_t*)(ws + WS_XB); float* SS = (float*)(ws + WS_SS);
    if (threadIdx.x < 4) ((LAS unsigned*)(l3 + LDS_BYTES - 16))[threadIdx.x] = 0u;
    __syncthreads();
    const XcdBarrier bar = xcd_barrier_post((unsigned*)(ws + WS_BAR), (volatile LAS unsigned*)(l3 + LDS_BYTES - 16));
    for (int ph = p.ph_lo; ph < p.ph_hi; ++ph) {
        if (ph > p.ph_lo) {
            if (p.ph_hi > 64) grid.sync();
            xcd_barrier(bar);
        }
#ifdef PROBE_DUP
        const int nrep = (ph == 0) ? ((PROBE_DUP >> 0) & 1) + 1 : (((PROBE_DUP >> (1 + (ph - 1) % 6)) & 1) + 1);
        for (int rep = 0; rep < nrep; ++rep) {
        if (rep) __syncthreads();
        if (rep && ph > 0 && (ph - 1) % 6 == 2) {
            xcd_barrier(bar);
            if (blockIdx.x == 0 && threadIdx.x == 0) __hip_atomic_store((unsigned*)(ws + WS_BAR) + 3584 + 64 * ((ph - 1) / 6), 0u, __ATOMIC_RELAXED, __HIP_MEMORY_SCOPE_AGENT);
            xcd_barrier(bar);
        }
        const int live = (rep == nrep - 1);
#else
        const int live = 1;
#endif
        if (ph == 0) {
#ifndef NO_P0
            phase_prologue(p, lds);
#endif
            continue; }
        const int l = (ph - 1) / 6, s = (ph - 1) % 6;
        if (s == 0) {
#ifndef NO_S0
            pg8::Gemm g{XB, (const bf16_t*)(ws + WS_WIN + (size_t)l * SZ_WIN1), MT, INWP, DM};
            pg8::StaticOrder S; S.init(MT, INWP, (int)gridDim.x, (int)blockIdx.x);
            EpiIn E{SS, (const float*)(ws + WS_ROPE), p.q_gain, p.k_gain, p.out, ws, l};
            pg8::gemm_phase<EpiIn, pg8::StaticOrder>(l3, g, S, E, nullptr);
#endif
        } else if (s == 1) {
#ifndef NO_S1
            phase_mix_a(p, l, lds);
#endif
        } else if (s == 2) {
#ifndef NO_S2
#ifdef PROBE_ATT_SUB
            phase_attn(p, l, lds, live ? 0 : PROBE_ATT_SUB);
#else
            phase_attn(p, l, lds);
#endif
            xcd_barrier(bar);
            attn_sample_combine(p);
#endif
        } else if (s == 3) {
#ifndef NO_S3
            mini_res((const bf16_t*)(ws + WS_YMIX), (const bf16_t*)(ws + WS_WOUT + (size_t)l * SZ_WOUT1), DM, p.out, XB, SS, lds, 0, live);
            pg8::Gemm g{(const bf16_t*)(ws + WS_YMIX), (const bf16_t*)(ws + WS_WOUT + (size_t)l * SZ_WOUT1), NPR, DM, DM};
            pg8::StaticOrder S; S.init(NPR, DM, (int)gridDim.x, (int)blockIdx.x);
            EpiRes E{p.out, XB, SS, 0, live};
            pg8::gemm_phase<EpiRes, pg8::StaticOrder>(l3, g, S, E, nullptr);
#endif
        } else if (s == 4) {
#ifndef NO_S4
            mini_up(XB, (const bf16_t*)(ws + WS_WUP + (size_t)l * SZ_WUP1), SS, (bf16_t*)(ws + WS_H));
            __syncthreads();
            pg8::Gemm g{XB, (const bf16_t*)(ws + WS_WUP + (size_t)l * SZ_WUP1), NPR, DFF, DM};
            pg8::StaticOrder S; S.init(NPR, DFF, (int)gridDim.x, (int)blockIdx.x);
            EpiUp E{(bf16_t*)(ws + WS_H), SS};
            pg8::gemm_phase<EpiUp, pg8::StaticOrder>(l3, g, S, E, nullptr);
#endif
        } else {
#ifndef NO_S5
            mini_res((const bf16_t*)(ws + WS_H), (const bf16_t*)(ws + WS_WDN + (size_t)l * SZ_WUP1), DFF, p.out, XB, SS, lds, l == 1, live);
            pg8::Gemm g{(const bf16_t*)(ws + WS_H), (const bf16_t*)(ws + WS_WDN + (size_t)l * SZ_WUP1), NPR, DM, DFF};
            pg8::StaticOrder S; S.init(NPR, DM, (int)gridDim.x, (int)blockIdx.x);
            EpiRes E{p.out, XB, SS, l == 1, live};
            pg8::gemm_phase<EpiRes, pg8::StaticOrder>(l3, g, S, E, nullptr);
#endif
        }
#ifdef PROBE_DUP
        }
#endif
    }
}

extern "C" void kernel_launch(void* const* d_in, const int* in_sizes, int n_in, void* d_out, int out_size, void* d_ws, size_t ws_size, hipStream_t stream) {
    static int grid = 0;
    if (grid == 0) {
        if (n_in != 17 || out_size != 35291136 || ws_size < WS_END) { fprintf(stderr, "kernel_launch: unexpected shapes (n_in %d, out %d, ws %zu, need %zu)\n", n_in, out_size, ws_size, (size_t)WS_END); grid = -1; return; }
        int dev = 0, cus = 0, per_cu = 0;
        hipGetDevice(&dev);
        hipDeviceGetAttribute(&cus, hipDeviceAttributeMultiprocessorCount, dev);
        if (hipFuncSetAttribute((const void*)hybrid_fwd, hipFuncAttributeMaxDynamicSharedMemorySize, LDS_BYTES) != hipSuccess) { fprintf(stderr, "kernel_launch: hipFuncSetAttribute failed\n"); grid = -1; return; }
        if (hipOccupancyMaxActiveBlocksPerMultiprocessor(&per_cu, (const void*)hybrid_fwd, NTHREADS, LDS_BYTES) != hipSuccess || per_cu < 1) { fprintf(stderr, "kernel_launch: occupancy query says %d blocks per CU\n", per_cu); grid = -1; return; }
        grid = cus;
        if (per_cu * cus < grid) grid = per_cu * cus;
    }
    if (grid < 0) return;
    Params p{};
    p.x_prompt = (const float*)d_in[0]; p.x_sample = (const float*)d_in[1]; p.cache_k = (const float*)d_in[2]; p.cache_v = (const float*)d_in[3];
    p.cache_kidx = (const float*)d_in[4]; p.state_conv = (const float*)d_in[5]; p.g_mix = (const float*)d_in[6]; p.w_in = (const float*)d_in[7];
    p.q_gain = (const float*)d_in[8]; p.k_gain = (const float*)d_in[9]; p.w_s = (const float*)d_in[10]; p.b_s = (const float*)d_in[11];
    p.conv_w = (const float*)d_in[12]; p.w_out = (const float*)d_in[13]; p.g_ffn = (const float*)d_in[14]; p.w_up = (const float*)d_in[15]; p.w_down = (const float*)d_in[16];
    p.out = (float*)d_out; p.ws = (unsigned char*)d_ws;
    if (hipMemsetAsync((unsigned char*)d_ws + WS_BAR, 0, 16384, stream) != hipSuccess) { fprintf(stderr, "kernel_launch: memset of the barrier words failed\n"); return; }
#if N_LAUNCH_MODE == 1
    p.ph_lo = 0; p.ph_hi = 13;
    void* args[] = {&p};
    hipError_t e = hipLaunchCooperativeKernel((const void*)hybrid_fwd, dim3(grid), dim3(NTHREADS), args, LDS_BYTES, stream);
    if (e != hipSuccess) fprintf(stderr, "kernel_launch: cooperative launch failed: %s (grid %d)\n", hipGetErrorString(e), grid);
#else
    for (int ph = 0; ph < 13; ++ph) {
        p.ph_lo = ph; p.ph_hi = ph + 1;
        hipLaunchKernelGGL(hybrid_fwd, dim3(grid), dim3(NTHREADS), LDS_BYTES, stream, p);
    }
#endif
}
```

```cpp
#include <hip/hip_runtime.h>
#include <hip/hip_cooperative_groups.h>
#include <cstdio>
namespace cg = cooperative_groups;
#ifndef N_LAUNCH_MODE
#define N_LAUNCH_MODE 1
#endif
__device__ __forceinline__ int otid() { int t = (int)threadIdx.x; asm volatile("" : "+v"(t)); return t; }

namespace pg8 {
#define PG8_LAS __attribute__((address_space(3)))
typedef unsigned short bf16_t;
typedef short bf16x8 __attribute__((ext_vector_type(8)));
typedef float f32x4 __attribute__((ext_vector_type(4)));
typedef unsigned u32x4 __attribute__((ext_vector_type(4)));
constexpr int BM = 256, BK = 64, HALF = 128, HTB = HALF * BK * 2  , STAGE_BYTES = 8 * HTB, NXCD = 8, WGM = 8;

__host__ __device__ __forceinline__ int lds_byte(int r, int c) { const int st = (r >> 4) * 2 + (c >> 5), rr = r & 15, cc = c & 31, ob = rr * 64 + cc * 2; return st * 1024 + (ob ^ (((ob >> 9) & 1) << 5)); }
__host__ __device__ __forceinline__ void stage_rc(int b, int& R, int& C) { const int st = b / 1024, sb = b % 1024, swz = sb ^ (((sb >> 9) & 1) << 5); R = (st >> 1) * 16 + swz / 64; C = (st & 1) * 32 + (swz % 64) / 2; }
__host__ __device__ __forceinline__ int perm32(int rho) { const int n = rho >> 4, i = rho & 15; return 8 * (i >> 2) + 4 * n + (i & 3); }

struct Unit { int pm, pn; };
struct Gemm { const bf16_t* A; const bf16_t* Bt; int M, N, K; };

struct StaticOrder {
    int nM, nN, nwg, G, c;
    __host__ __device__ void init(int M, int N, int G_, int c_) { nM = M / BM; nN = N / BM; nwg = nM * nN; G = G_; c = c_; }
    __host__ __device__ bool next(int i, Unit& u) const {
        const long L = (long)i * G + c; if (L >= nwg) return false;
        int wgid = (int)L; { const int q = nwg / NXCD, r = nwg % NXCD, xcd = wgid % NXCD, off = wgid / NXCD; wgid = (xcd < r ? xcd * (q + 1) : r * (q + 1) + (xcd - r) * q) + off; }
        const int nig = WGM * nN, gid = wgid / nig, fm = gid * WGM, gsz = (nM - fm) < WGM ? (nM - fm) : WGM;
        u.pm = fm + ((wgid % nig) % gsz); u.pn = (wgid % nig) / gsz; return true;
    }
    __device__ __forceinline__ void a_ready(const Unit&) const {}
    __device__ __forceinline__ void done(const Unit&) const {}
};
template <class Epi, class Sched, bool STAMP = false>
__device__ __forceinline__ void gemm_phase(PG8_LAS unsigned char* lds, const Gemm g, const Sched& S, const Epi& E, unsigned long long* stamps) {
    const int tid = otid(), wid = __builtin_amdgcn_readfirstlane(tid >> 6), lane = tid & 63, wr = wid >> 2, wc = wid & 3, fr = lane & 15, fq = lane >> 4;
    const int K = g.K, nt = K / BK;
    int ts_lo = 0, ts_hi = 0, nts = 0; const unsigned long long rt_entry = STAMP ? (unsigned long long)wall_clock64() : 0ull;
#define PG8_STAMP() do { if (STAMP && wid == 0 && nts < 64) { const unsigned long long _c = (unsigned long long)clock64(); \
        ts_lo = (lane == nts) ? (int)(unsigned)_c : ts_lo; ts_hi = (lane == nts) ? (int)(unsigned)(_c >> 32) : ts_hi; ++nts; } } while (0)
    PG8_STAMP();
    unsigned voffA[2], voffB[2];
#pragma unroll
    for (int i = 0; i < 2; ++i) { int R, C; stage_rc(tid * 16 + i * 8192, R, C); const int Rb = Epi::PERM ? ((R & ~31) + perm32(R & 31)) : R;
        voffA[i] = (unsigned)(R * K + C) * 2u; voffB[i] = (unsigned)(Rb * K + C) * 2u; }
    const size_t kstep = (size_t)(BK * 2);
    const size_t hstep = (size_t)HALF * K * 2;
    const size_t tstep = 2 * hstep;
    const unsigned ldsw = (unsigned)wid * 1024u;
    const int aoff = lds_byte(wr * 64 + fr, fq * 8), boff = lds_byte(wc * 32 + fr, fq * 8);
#define PG8_SA(b, h) (((b) * 2 + (h)) * HTB)
#define PG8_SB(b, h) ((4 + (b) * 2 + (h)) * HTB)
#define PG8_STAGE(bufoff, gbase, voff) do { _Pragma("unroll") for (int _i = 0; _i < 2; ++_i) \
        __builtin_amdgcn_global_load_lds((const unsigned*)((const char*)(gbase) + (voff)[_i]), (PG8_LAS unsigned*)(lds + (bufoff) + ldsw + _i * 8192), 16, 0, 0); } while (0)
#define PG8_LDA(dst, b, h) do { _Pragma("unroll") for (int m = 0; m < 4; ++m) _Pragma("unroll") for (int k = 0; k < 2; ++k) dst[m][k] = *(const PG8_LAS bf16x8*)(lds + PG8_SA(b, h) + aoff + m * 2048 + k * 1024); } while (0)
#define PG8_LDB(dst, b, h) do { _Pragma("unroll") for (int n = 0; n < 2; ++n) _Pragma("unroll") for (int k = 0; k < 2; ++k) dst[n][k] = *(const PG8_LAS bf16x8*)(lds + PG8_SB(b, h) + boff + n * 2048 + k * 1024); } while (0)
#define PG8_MMA(ai, bj, At, Bt) do { __builtin_amdgcn_s_setprio(1); _Pragma("unroll") for (int m = 0; m < 4; ++m) _Pragma("unroll") for (int n = 0; n < 2; ++n) _Pragma("unroll") for (int k = 0; k < 2; ++k) \
        acc[ai][bj][m][n] = __builtin_amdgcn_mfma_f32_16x16x32_bf16(Bt[n][k], At[m][k], acc[ai][bj][m][n], 0, 0, 0); __builtin_amdgcn_s_setprio(0); } while (0)
#define PG8_WAIT_V(n) asm volatile("s_waitcnt vmcnt(" #n ")" ::: "memory")
#define PG8_WAIT_L(n) asm volatile("s_waitcnt lgkmcnt(" #n ")" ::: "memory")
#define PG8_BAR __builtin_amdgcn_s_barrier()
#define PG8_SCHED __builtin_amdgcn_sched_barrier(0)
    Unit cur, nxt; int ui = 0;
    if (!S.next(0, cur)) return;
    f32x4 acc[2][2][4][2];
#pragma unroll
    for (int a = 0; a < 2; ++a)
#pragma unroll
        for (int b = 0; b < 2; ++b)
#pragma unroll
            for (int m = 0; m < 4; ++m)
#pragma unroll
                for (int n = 0; n < 2; ++n) acc[a][b][m][n] = (f32x4){0.f, 0.f, 0.f, 0.f};
    bf16x8 At[4][2], B0[2][2], B1[2][2];
    const char* cA = (const char*)g.A + (size_t)cur.pm * tstep; const char* cB = (const char*)g.Bt + (size_t)cur.pn * tstep;
    S.a_ready(cur);
    PG8_STAGE(PG8_SB(0, 0), cB, voffB); PG8_STAGE(PG8_SA(0, 0), cA, voffA); PG8_STAGE(PG8_SB(0, 1), cB + hstep, voffB); PG8_STAGE(PG8_SA(0, 1), cA + hstep, voffA);
    if (wr == 1) PG8_BAR;
    PG8_WAIT_V(4); PG8_BAR;
    PG8_STAGE(PG8_SB(1, 0), cB + kstep, voffB); PG8_STAGE(PG8_SA(1, 0), cA + kstep, voffA); PG8_STAGE(PG8_SB(1, 1), cB + hstep + kstep, voffB);
    PG8_WAIT_V(6); PG8_BAR;
    PG8_STAMP();
    for (;;) {
        const bool has_next = S.next(ui + 1, nxt);
        const char* nA = has_next ? (const char*)g.A + (size_t)nxt.pm * tstep : cA; const char* nB = has_next ? (const char*)g.Bt + (size_t)nxt.pn * tstep : cB;
        for (int t = 0; t < nt; t += 2) {
            const bool last = (t == nt - 2);
            const char* a1 = cA + (size_t)(t + 1) * kstep;
            const char* a2 = last ? nA : cA + (size_t)(t + 2) * kstep; const char* b2 = last ? nB : cB + (size_t)(t + 2) * kstep;
            const char* a3 = a2 + kstep; const char* b3 = b2 + kstep;
            if (last && has_next) S.a_ready(nxt);
            PG8_LDB(B0, 0, 0); PG8_SCHED; PG8_LDA(At, 0, 0); PG8_STAGE(PG8_SA(1, 1), a1 + hstep, voffA);
            PG8_WAIT_L(8); PG8_BAR; PG8_WAIT_L(0); PG8_MMA(0, 0, At, B0); PG8_BAR; PG8_SCHED;
            PG8_LDB(B1, 0, 1); PG8_STAGE(PG8_SB(0, 0), b2, voffB);
            PG8_BAR; PG8_WAIT_L(0); PG8_MMA(0, 1, At, B1); PG8_BAR;
            PG8_LDA(At, 0, 1); PG8_STAGE(PG8_SA(0, 0), a2, voffA);
            PG8_BAR; PG8_WAIT_L(0); PG8_MMA(1, 0, At, B0); PG8_BAR; PG8_SCHED;
            PG8_STAGE(PG8_SB(0, 1), b2 + hstep, voffB);
            PG8_WAIT_V(6); PG8_BAR; PG8_MMA(1, 1, At, B1); PG8_BAR;
            PG8_LDB(B0, 1, 0); PG8_SCHED; PG8_LDA(At, 1, 0); PG8_STAGE(PG8_SA(0, 1), a2 + hstep, voffA);
            PG8_WAIT_L(8); PG8_BAR; PG8_WAIT_L(0); PG8_MMA(0, 0, At, B0); PG8_BAR; PG8_SCHED;
            PG8_LDB(B1, 1, 1); PG8_STAGE(PG8_SB(1, 0), b3, voffB);
            PG8_BAR; PG8_WAIT_L(0); PG8_MMA(0, 1, At, B1); PG8_BAR;
            PG8_LDA(At, 1, 1); PG8_STAGE(PG8_SA(1, 0), a3, voffA);
            PG8_BAR; PG8_WAIT_L(0); PG8_MMA(1, 0, At, B0); PG8_BAR; PG8_SCHED;
            PG8_STAGE(PG8_SB(1, 1), b3 + hstep, voffB);
            PG8_WAIT_V(6); PG8_BAR; PG8_MMA(1, 1, At, B1); PG8_BAR;
        }
        PG8_STAMP();
        if constexpr (!Epi::AFTER_DRAIN) { E(acc, cur, wr, wc, fr, fq); S.done(cur); }
        PG8_STAMP();
        if (!has_next) break;
#pragma unroll
        for (int a = 0; a < 2; ++a)
#pragma unroll
            for (int b = 0; b < 2; ++b)
#pragma unroll
                for (int m = 0; m < 4; ++m)
#pragma unroll
                    for (int n = 0; n < 2; ++n) acc[a][b][m][n] = (f32x4){0.f, 0.f, 0.f, 0.f};
        cur = nxt; cA = nA; cB = nB; ++ui;
    }
    PG8_WAIT_V(0);
    if (wr == 0) PG8_BAR;
    PG8_BAR;
    if constexpr (Epi::AFTER_DRAIN) { E.fused(acc, cur, wr, wc, fr, fq, lds, wid, lane); S.done(cur); }
    PG8_STAMP();
    if (STAMP && wid == 0) { stamps[lane] = lane < nts ? (((unsigned long long)(unsigned)ts_hi << 32) | (unsigned)ts_lo) : 0ull;
        if (lane == 62) stamps[62] = rt_entry; if (lane == 63) stamps[63] = (unsigned long long)wall_clock64(); }
#undef PG8_STAMP
#undef PG8_SA
#undef PG8_SB
#undef PG8_STAGE
#undef PG8_LDA
#undef PG8_LDB
#undef PG8_MMA
#undef PG8_WAIT_V
#undef PG8_WAIT_L
#undef PG8_BAR
#undef PG8_SCHED
}
}

using pg8::bf16_t; using pg8::bf16x8; using pg8::f32x4; using pg8::u32x4;
typedef float f32x16 __attribute__((ext_vector_type(16)));
typedef unsigned u32x2 __attribute__((ext_vector_type(2)));
typedef unsigned long long u64;
#define DEV __device__ __forceinline__

constexpr int DM = 1024, TP = 2048, NPR = 16384, NSR = 256, MT = 16640, INW = 2600, INWP = 2816, DFF = 4096, PAST = 4096, LS = 4128, LSP = 4160, TPV = 2112;
constexpr int NTHREADS = 512;
constexpr int LDS_BYTES = 139264;
constexpr size_t O_YP = 0, O_YS = 16777216, O_KP = 17039360, O_VP = 25427968, O_KIP = 33816576, O_CP = 34865152, O_KS = 34873344, O_VS = 35004416, O_KIS = 35135488, O_CS = 35151872, O_SGV = 35160064;
constexpr size_t WS_WIN = 0, SZ_WIN1 = (size_t)INWP * DM * 2;
constexpr size_t WS_WOUT = WS_WIN + 2 * SZ_WIN1, SZ_WOUT1 = (size_t)DM * DM * 2;
constexpr size_t WS_WUP = WS_WOUT + 2 * SZ_WOUT1, SZ_WUP1 = (size_t)DFF * DM * 2;
constexpr size_t WS_WDN = WS_WUP + 2 * SZ_WUP1;
constexpr size_t WS_XB = WS_WDN + 2 * SZ_WUP1;
constexpr size_t WS_SS = WS_XB + (size_t)MT * DM * 2;
constexpr size_t WS_ROPE = WS_SS + (size_t)MT * 16 * 4;
constexpr size_t WS_WI = WS_ROPE + (size_t)2080 * 64 * 4;
constexpr size_t WS_KS = WS_WI + (size_t)MT * 8 * 4, SZ_KS1 = (size_t)8 * 4 * LSP * 64 * 2;
constexpr size_t WS_VTS = WS_KS + 2 * SZ_KS1;
constexpr size_t WS_KIS = WS_VTS + 2 * SZ_KS1, SZ_KIS1 = (size_t)8 * LSP * 32 * 2;
constexpr size_t WS_BMP = WS_KIS + 2 * SZ_KIS1;
constexpr size_t WS_BMS = WS_BMP + (size_t)NPR * 32 * 8;
constexpr size_t WS_BAR = WS_BMS + (size_t)NSR * 72 * 8;
constexpr size_t WS_PART = WS_BAR + 16384;
constexpr size_t SZ_PARTO = (size_t)8 * 4 * 4 * 64 * 64 * 4;
constexpr size_t WS_MIX = WS_PART + SZ_PARTO + (size_t)8 * 4 * 4 * 64 * 4;
constexpr size_t WS_H = WS_MIX;
constexpr size_t WS_YMIX = WS_MIX;
constexpr size_t WS_ZB = WS_YMIX + (size_t)MT * 1024 * 2;
constexpr size_t WS_QB = WS_ZB + (size_t)MT * 768 * 2;
constexpr size_t WS_ZAU = WS_QB + (size_t)MT * 512 * 2;
constexpr size_t WS_SGVT = WS_ZAU + (size_t)MT * 256 * 2;
constexpr size_t WS_QIB = WS_SGVT + (size_t)MT * 256 * 2;
constexpr size_t WS_KP = WS_QIB + (size_t)MT * 256 * 2;
constexpr size_t WS_VTP = WS_KP + (size_t)8 * 4 * TP * 64 * 2;
constexpr size_t WS_KIP = WS_VTP + (size_t)8 * 4 * TPV * 64 * 2;
constexpr size_t WS_MIX_END = WS_KIP + (size_t)8 * TP * 32 * 2;
constexpr size_t WS_END = WS_H + (size_t)MT * DFF * 2;
static_assert(WS_MIX_END <= WS_END, "mixer intermediates must fit inside the H alias");
static_assert(WS_XB % 256 == 0 && WS_SS % 256 == 0 && WS_ROPE % 256 == 0 && WS_WI % 256 == 0 && WS_KS % 256 == 0 && WS_VTS % 256 == 0 && WS_KIS % 256 == 0 && WS_BMP % 256 == 0 && WS_BMS % 256 == 0 && WS_MIX % 256 == 0, "align");
static_assert(WS_ZB % 256 == 0 && WS_QB % 256 == 0 && WS_ZAU % 256 == 0 && WS_SGVT % 256 == 0 && WS_QIB % 256 == 0 && WS_KP % 256 == 0 && WS_VTP % 256 == 0 && WS_KIP % 256 == 0, "align2");

struct Params {
    const float* x_prompt; const float* x_sample; const float* cache_k; const float* cache_v; const float* cache_kidx; const float* state_conv;
    const float* g_mix; const float* w_in; const float* q_gain; const float* k_gain; const float* w_s; const float* b_s; const float* conv_w;
    const float* w_out; const float* g_ffn; const float* w_up; const float* w_down;
    float* out; unsigned char* ws;
    int ph_lo, ph_hi;
};

__constant__ float c_invf[32] = {1.000000000e+00f, 7.498942614e-01f, 5.623413324e-01f, 4.216965139e-01f, 3.162277639e-01f, 2.371373773e-01f, 1.778279394e-01f, 1.333521307e-01f, 1.000000015e-01f, 7.498941571e-02f, 5.623413250e-02f, 4.216965288e-02f, 3.162277490e-02f, 2.371373773e-02f, 1.778279431e-02f, 1.333521493e-02f, 9.999999776e-03f, 7.498941850e-03f, 5.623413250e-03f, 4.216964822e-03f, 3.162277630e-03f, 2.371373586e-03f, 1.778279431e-03f, 1.333521446e-03f, 1.000000047e-03f, 7.498942432e-04f, 5.623413017e-04f, 4.216965172e-04f, 3.162277571e-04f, 2.371373703e-04f, 1.778279402e-04f, 1.333521504e-04f};

DEV f32x4 ntl4(const float* p) { return __builtin_nontemporal_load((const f32x4*)p); }
DEV void nts4(float* p, f32x4 v) { __builtin_nontemporal_store(v, (f32x4*)p); }
DEV void ntsu4(void* p, u32x4 v) { __builtin_nontemporal_store(v, (u32x4*)p); }
DEV float bf2f(unsigned short h) { return __uint_as_float((unsigned)h << 16); }
typedef __bf16 bf16v2_t __attribute__((ext_vector_type(2)));
typedef float f32v2_t __attribute__((ext_vector_type(2)));
DEV unsigned pk2(float lo, float hi) { return __builtin_bit_cast(unsigned, __builtin_convertvector((f32v2_t){lo, hi}, bf16v2_t)); }
DEV unsigned short f2bf(float x) { return (unsigned short)(pk2(x, 0.f) & 0xffffu); }
DEV u32x4 pack8(const float (&v)[8]) { u32x4 w; w.x = pk2(v[0], v[1]); w.y = pk2(v[2], v[3]); w.z = pk2(v[4], v[5]); w.w = pk2(v[6], v[7]); return w; }
DEV float gelu_tanh(float x) {
    const float y = 0.7978845608028654f * (x + 0.044715f * x * x * x);
    const float e = __builtin_amdgcn_exp2f(-2.0f * 1.4426950408889634f * y);
    return x * __builtin_amdgcn_rcpf(1.0f + e);
}
DEV float wave_sum(float v) {
#pragma unroll
    for (int o = 32; o > 0; o >>= 1) v += __shfl_xor(v, o);
    return v;
}
DEV float wave_max(float v) {
#pragma unroll
    for (int o = 32; o > 0; o >>= 1) v = fmaxf(v, __shfl_xor(v, o));
    return v;
}

#define XB_TMO      128
#define XB_XCNT(j)  (256  + 64 * (j))
#define XB_XSUB(j)  (1280 + 64 * (j))
#define XB_XGEN(j)  (2304 + 64 * (j))
#define XB_TOP      3328
#define XB_TOPGEN   3392
#define XCD_BAR_WORDS 3456
#define XB_SPIN_CAP (1u << 18)
#define LAS __attribute__((address_space(3)))

__device__ __forceinline__ unsigned xb_ld(unsigned* p)              { return __hip_atomic_load(p, __ATOMIC_RELAXED, __HIP_MEMORY_SCOPE_AGENT); }
__device__ __forceinline__ unsigned xb_add(unsigned* p, unsigned v) { return __hip_atomic_fetch_add(p, v, __ATOMIC_RELAXED, __HIP_MEMORY_SCOPE_AGENT); }
__device__ __forceinline__ unsigned xb_xcc_id() { return (unsigned)__builtin_amdgcn_s_getreg((3 << 11) | 20) & 0xFu; }
#define XB_SPIN(cond, bar) do { unsigned _sp = 0; while (cond) { __builtin_amdgcn_s_sleep(1); \
    if ((++_sp & 255u) == 0u) { if (xb_ld(&(bar)[XB_TMO])) break; if (_sp > XB_SPIN_CAP) { atomicAdd(&(bar)[XB_TMO], 1u); break; } } } } while (0)

struct XcdBarrier {
    unsigned* bar; unsigned x;
    volatile LAS unsigned* st;
};

__device__ __forceinline__ XcdBarrier xcd_barrier_post(unsigned* bar, volatile LAS unsigned* st) {
    XcdBarrier b; b.bar = bar; b.x = xb_xcc_id(); b.st = st;
    if (threadIdx.x == 0) (void)xb_add(&bar[XB_XCNT(b.x)], 1u);
    return b;
}
__device__ __forceinline__ void xcd_barrier_complete(unsigned* bar, unsigned x, unsigned& nloc, unsigned& nx) {
    const unsigned G = gridDim.x * gridDim.y * gridDim.z;
    unsigned sum, cnt, mine, sp = 0u;
    for (;;) {
        sum = 0u; cnt = 0u; mine = 0u;
#pragma unroll
        for (unsigned j = 0; j < 16; ++j) { const unsigned c = xb_ld(&bar[XB_XCNT(j)]); sum += c; cnt += (c > 0u) ? 1u : 0u; mine = (j == x) ? c : mine; }
        if (sum == G) break;
        __builtin_amdgcn_s_sleep(1);
        if ((++sp & 255u) == 0u) { if (xb_ld(&bar[XB_TMO])) break; if (sp > XB_SPIN_CAP) { atomicAdd(&bar[XB_TMO], 1u); break; } }
    }
    nloc = mine > 0u ? mine : 1u; nx = cnt > 0u ? cnt : 1u;
}

__device__ __forceinline__ void xcd_barrier(const XcdBarrier& b) {
    asm volatile("s_waitcnt vmcnt(0)" ::: "memory");
    __syncthreads();
    if (threadIdx.x == 0) {
        unsigned* bar = b.bar;
        __builtin_amdgcn_s_waitcnt(0);
        unsigned nloc = b.st[0], nx = b.st[1];
        if (nloc == 0u) { xcd_barrier_complete(bar, b.x, nloc, nx); b.st[0] = nloc; b.st[1] = nx; }
        const unsigned old = xb_add(&bar[XB_XSUB(b.x)], 1u);
        const unsigned gen = old / nloc;
        if (old + 1u == (gen + 1u) * nloc) {
            __builtin_amdgcn_fence(__ATOMIC_RELEASE, "agent");
            asm volatile("s_waitcnt vmcnt(0)" ::: "memory");
            const unsigned og = xb_add(&bar[XB_TOP], 1u);
            const unsigned tg = og / nx;
            if (og + 1u == (tg + 1u) * nx) xb_add(&bar[XB_TOPGEN], 1u);
            else XB_SPIN(xb_ld(&bar[XB_TOPGEN]) == tg, bar);
            __builtin_amdgcn_fence(__ATOMIC_ACQUIRE, "agent");
            xb_add(&bar[XB_XGEN(b.x)], 1u);
            asm volatile("s_waitcnt vmcnt(0)" ::: "memory");
        } else {
            XB_SPIN(xb_ld(&bar[XB_XGEN(b.x)]) == gen, bar);
            __builtin_amdgcn_fence(__ATOMIC_ACQUIRE, "agent");
            asm volatile("s_waitcnt vmcnt(0)" ::: "memory");
        }
    }
    __syncthreads();
}


DEV float row_rstd(const float* ss, int row) {
    const f32x4* sp = (const f32x4*)(ss + (size_t)row * 16);
    const f32x4 a = sp[0], b = sp[1], c = sp[2], d = sp[3];
    const float t = ((a[0] + a[1]) + (a[2] + a[3])) + ((b[0] + b[1]) + (b[2] + b[3])) + ((c[0] + c[1]) + (c[2] + c[3])) + ((d[0] + d[1]) + (d[2] + d[3]));
    return rsqrtf(t * (1.0f / 1024.0f) + 1e-6f);
}

struct EpiIn {
    static constexpr bool PERM = false, AFTER_DRAIN = false;
    const float* ss; const float* rope; const float* qg; const float* kg; float* out; unsigned char* ws; int layer;
    __device__ __forceinline__ void operator()(const f32x4 (&acc)[2][2][4][2], const pg8::Unit& u, int wr, int wc, int fr, int fq0) const {
        const int pn = u.pn, pm = u.pm;
        const bool samp = (pm == 64);
        bf16_t* ZAU = (bf16_t*)(ws + WS_ZAU); bf16_t* SGVT = (bf16_t*)(ws + WS_SGVT); bf16_t* ZB = (bf16_t*)(ws + WS_ZB); bf16_t* QB = (bf16_t*)(ws + WS_QB);
        bf16_t* QIB = (bf16_t*)(ws + WS_QIB); float* WI = (float*)(ws + WS_WI);
#pragma unroll
        for (int ai = 0; ai < 2; ++ai)
#pragma unroll
            for (int m = 0; m < 4; ++m) {
                int row = pm * 256 + ai * 128 + wr * 64 + m * 16 + fr, fq = fq0;
                asm volatile("" : "+v"(row), "+v"(fq));
                const float rstd = row_rstd(ss, row);
                int b, t, posidx; const int rs = row - NPR;
                if (!samp) { b = row >> 11; t = row & 2047; posidx = t; } else { b = rs >> 5; t = rs & 31; posidx = 2048 + t; }
                float lo[8], hi[8];
#pragma unroll
                for (int bj = 0; bj < 2; ++bj)
#pragma unroll
                    for (int n = 0; n < 2; ++n)
#pragma unroll
                        for (int jp = 0; jp < 2; ++jp) { lo[4 * bj + 2 * n + jp] = acc[ai][bj][m][n][2 * jp] * rstd; hi[4 * bj + 2 * n + jp] = acc[ai][bj][m][n][2 * jp + 1] * rstd; }
                if (pn == 0) {
#pragma unroll
                    for (int e = 0; e < 8; ++e) { lo[e] = gelu_tanh(lo[e]); hi[e] = gelu_tanh(hi[e]); }
                    bf16_t* d = ZAU + (size_t)row * 256 + 64 * wc + 8 * fq;
                    *(u32x4*)d = pack8(lo); *(u32x4*)(d + 32) = pack8(hi);
                } else if (pn == 1) {
#pragma unroll
                    for (int e = 0; e < 8; ++e) { lo[e] = gelu_tanh(lo[e]); hi[e] = gelu_tanh(hi[e]); }
#pragma unroll
                    for (int e = 0; e < 8; ++e) {
                        SGVT[(size_t)(64 * wc + 8 * fq + e) * MT + row] = f2bf(lo[e]);
                        SGVT[(size_t)(64 * wc + 32 + 8 * fq + e) * MT + row] = f2bf(hi[e]);
                    }
                    if (samp) {
                        float* d = out + O_SGV + ((size_t)layer * NSR + rs) * 256 + 64 * wc + 8 * fq;
                        nts4(d, (f32x4){lo[0], lo[1], lo[2], lo[3]}); nts4((d + 4), (f32x4){lo[4], lo[5], lo[6], lo[7]});
                        nts4((d + 32), (f32x4){hi[0], hi[1], hi[2], hi[3]}); nts4((d + 36), (f32x4){hi[4], hi[5], hi[6], hi[7]});
                    }
                } else if (pn <= 4) {
                    bf16_t* d = ZB + (size_t)row * 768 + 256 * (pn - 2) + 64 * wc + 8 * fq;
                    *(u32x4*)d = pack8(lo); *(u32x4*)(d + 32) = pack8(hi);
                } else if (pn <= 7) {
                    float sq = 0.f;
#pragma unroll
                    for (int e = 0; e < 8; ++e) sq += lo[e] * lo[e] + hi[e] * hi[e];
                    sq += __shfl_xor(sq, 16); sq += __shfl_xor(sq, 32);
                    const float rh = rsqrtf(sq * (1.0f / 64.0f) + 1e-6f);
                    const float* cs = rope + (size_t)posidx * 64 + 8 * fq;
                    const f32x4 c0 = *(const f32x4*)cs, c1 = *(const f32x4*)(cs + 4), s0 = *(const f32x4*)(cs + 32), s1 = *(const f32x4*)(cs + 36);
                    const float* gp = (pn == 7 ? kg : qg) + layer * 64 + 8 * fq;
                    const f32x4 g0 = *(const f32x4*)gp, g1 = *(const f32x4*)(gp + 4), g2 = *(const f32x4*)(gp + 32), g3 = *(const f32x4*)(gp + 36);
                    float ol[8], oh[8];
#pragma unroll
                    for (int e = 0; e < 8; ++e) {
                        const float co = e < 4 ? c0[e & 3] : c1[e & 3], si = e < 4 ? s0[e & 3] : s1[e & 3];
                        const float a = lo[e] * rh * (e < 4 ? g0[e & 3] : g1[e & 3]), bb = hi[e] * rh * (e < 4 ? g2[e & 3] : g3[e & 3]);
                        ol[e] = a * co - bb * si; oh[e] = bb * co + a * si;
                    }
                    if (pn < 7) {
#pragma unroll
                        for (int e = 0; e < 8; ++e) { ol[e] *= 0.125f * 1.4426950408889634f; oh[e] *= 0.125f * 1.4426950408889634f; }
                        bf16_t* d = QB + (size_t)row * 512 + (4 * (pn - 5) + wc) * 64 + 8 * fq;
                        *(u32x4*)d = pack8(ol); *(u32x4*)(d + 32) = pack8(oh);
                    } else {
                        float* d = samp ? out + O_KS + ((size_t)layer * NSR + rs) * 256 + 64 * wc + 8 * fq : out + O_KP + ((size_t)layer * NPR + row) * 256 + 64 * wc + 8 * fq;
                        nts4(d, (f32x4){ol[0], ol[1], ol[2], ol[3]}); nts4((d + 4), (f32x4){ol[4], ol[5], ol[6], ol[7]});
                        nts4((d + 32), (f32x4){oh[0], oh[1], oh[2], oh[3]}); nts4((d + 36), (f32x4){oh[4], oh[5], oh[6], oh[7]});
                        if (!samp) {
                            bf16_t* kb = (bf16_t*)(ws + WS_KP) + ((size_t)(b * 4 + wc) * TP + t) * 64 + 8 * fq;
                            *(u32x4*)kb = pack8(ol); *(u32x4*)(kb + 32) = pack8(oh);
                        }
                    }
                } else if (pn == 8) {
                    float* d = samp ? out + O_VS + ((size_t)layer * NSR + rs) * 256 + 64 * wc + 8 * fq : out + O_VP + ((size_t)layer * NPR + row) * 256 + 64 * wc + 8 * fq;
                    nts4(d, (f32x4){lo[0], lo[1], lo[2], lo[3]}); nts4((d + 4), (f32x4){lo[4], lo[5], lo[6], lo[7]});
                    nts4((d + 32), (f32x4){hi[0], hi[1], hi[2], hi[3]}); nts4((d + 36), (f32x4){hi[4], hi[5], hi[6], hi[7]});
                    if (!samp) {
                        bf16_t* vt = (bf16_t*)(ws + WS_VTP) + (size_t)(b * 4 + wc) * 64 * TPV + t;
#pragma unroll
                        for (int e = 0; e < 8; ++e) { vt[(size_t)(8 * fq + e) * TPV] = f2bf(lo[e]); vt[(size_t)(32 + 8 * fq + e) * TPV] = f2bf(hi[e]); }
                    }
                } else {
                    const float* cs = rope + (size_t)posidx * 64 + 8 * fq;
                    const f32x4 c0 = *(const f32x4*)cs, c1 = *(const f32x4*)(cs + 4), s0 = *(const f32x4*)(cs + 32), s1 = *(const f32x4*)(cs + 36);
                    const float co[4] = {c0[0], c0[2], c1[0], c1[2]}, si[4] = {s0[0], s0[2], s1[0], s1[2]};
                    float ol[8], oh[8];
#pragma unroll
                    for (int e = 0; e < 8; ++e) { ol[e] = lo[e] * co[e & 3] - hi[e] * si[e & 3]; oh[e] = hi[e] * co[e & 3] + lo[e] * si[e & 3]; }
                    if (pn == 9) {
#pragma unroll
                        for (int bj = 0; bj < 2; ++bj) {
                            bf16_t* d = QIB + (size_t)row * 256 + 32 * (2 * wc + bj) + 4 * fq;
                            *(u32x2*)d = (u32x2){pk2(ol[4 * bj], ol[4 * bj + 1]), pk2(ol[4 * bj + 2], ol[4 * bj + 3])};
                            *(u32x2*)(d + 16) = (u32x2){pk2(oh[4 * bj], oh[4 * bj + 1]), pk2(oh[4 * bj + 2], oh[4 * bj + 3])};
                        }
                    } else if (wc == 0) {
                        float* d = samp ? out + O_KIS + ((size_t)layer * NSR + rs) * 32 + 4 * fq : out + O_KIP + ((size_t)layer * NPR + row) * 32 + 4 * fq;
                        nts4(d, (f32x4){ol[0], ol[1], ol[2], ol[3]}); nts4((d + 16), (f32x4){oh[0], oh[1], oh[2], oh[3]});
                        bf16_t* kb = samp ? (bf16_t*)(ws + WS_KIS + (size_t)layer * SZ_KIS1) + ((size_t)b * LSP + PAST + t) * 32 + 4 * fq
                                          : (bf16_t*)(ws + WS_KIP) + (size_t)row * 32 + 4 * fq;
                        *(u32x2*)kb = (u32x2){pk2(ol[0], ol[1]), pk2(ol[2], ol[3])};
                        *(u32x2*)(kb + 16) = (u32x2){pk2(oh[0], oh[1]), pk2(oh[2], oh[3])};
                        if (fq < 2) *(f32x4*)(WI + (size_t)row * 8 + 4 * fq) = (f32x4){lo[4] * 0.0625f, lo[5] * 0.0625f, lo[6] * 0.0625f, lo[7] * 0.0625f};
                    }
                }
                asm volatile("" ::: "memory");
            }
    }
};

struct EpiRes {
    static constexpr bool PERM = true, AFTER_DRAIN = false;
    float* Y; bf16_t* XB; float* ss; int last; int live;
    __device__ __forceinline__ void operator()(const f32x4 (&acc)[2][2][4][2], const pg8::Unit& u, int wr, int wc, int fr, int fq0) const {
        if (!live) return;
#pragma unroll
        for (int ai = 0; ai < 2; ++ai) {
            u32x4 xin[4][2];
#pragma unroll
            for (int m = 0; m < 4; ++m) {
                int row = u.pm * 256 + ai * 128 + wr * 64 + m * 16 + fr, fq = fq0;
                asm volatile("" : "+v"(row), "+v"(fq));
#pragma unroll
                for (int bj = 0; bj < 2; ++bj) xin[m][bj] = *(const u32x4*)(XB + (size_t)row * DM + u.pn * 256 + 128 * bj + 32 * wc + 8 * fq);
            }
#pragma unroll
            for (int m = 0; m < 4; ++m) {
                int row = u.pm * 256 + ai * 128 + wr * 64 + m * 16 + fr, fq = fq0;
                asm volatile("" : "+v"(row), "+v"(fq));
                float sq = 0.f;
#pragma unroll
                for (int bj = 0; bj < 2; ++bj) {
                    const size_t off = (size_t)row * DM + u.pn * 256 + 128 * bj + 32 * wc + 8 * fq;
                    const u32x4 xb = xin[m][bj];
                    f32x4 x0 = (f32x4){__uint_as_float(xb[0] << 16), __uint_as_float(xb[0] & 0xffff0000u), __uint_as_float(xb[1] << 16), __uint_as_float(xb[1] & 0xffff0000u)};
                    f32x4 x1 = (f32x4){__uint_as_float(xb[2] << 16), __uint_as_float(xb[2] & 0xffff0000u), __uint_as_float(xb[3] << 16), __uint_as_float(xb[3] & 0xffff0000u)};
                    x0 += acc[ai][bj][m][0]; x1 += acc[ai][bj][m][1];
                    if (last) { nts4(Y + off, x0); nts4(Y + off + 4, x1); }
                    else {
                        *(u32x4*)(XB + off) = (u32x4){pk2(x0[0], x0[1]), pk2(x0[2], x0[3]), pk2(x1[0], x1[1]), pk2(x1[2], x1[3])};
                        sq += ((x0[0] * x0[0] + x0[1] * x0[1]) + (x0[2] * x0[2] + x0[3] * x0[3])) + ((x1[0] * x1[0] + x1[1] * x1[1]) + (x1[2] * x1[2] + x1[3] * x1[3]));
                    }
                }
                if (!last) {
                    sq += __shfl_xor(sq, 16); sq += __shfl_xor(sq, 32);
                    if (fq0 == 0) ss[(size_t)row * 16 + u.pn * 4 + wc] = sq;
                }
            }
            asm volatile("" ::: "memory");
        }
    }
};

struct EpiUp {
    static constexpr bool PERM = true, AFTER_DRAIN = false;
    bf16_t* H; const float* ss;
    __device__ __forceinline__ void operator()(const f32x4 (&acc)[2][2][4][2], const pg8::Unit& u, int wr, int wc, int fr, int fq0) const {
#pragma unroll
        for (int ai = 0; ai < 2; ++ai) {
            float rs[4];
#pragma unroll
            for (int m = 0; m < 4; ++m) {
                int row = u.pm * 256 + ai * 128 + wr * 64 + m * 16 + fr;
                asm volatile("" : "+v"(row));
                rs[m] = row_rstd(ss, row);
            }
#pragma unroll
            for (int m = 0; m < 4; ++m) {
                int row = u.pm * 256 + ai * 128 + wr * 64 + m * 16 + fr, fq = fq0;
                asm volatile("" : "+v"(row), "+v"(fq));
                const float rstd = rs[m];
#pragma unroll
                for (int bj = 0; bj < 2; ++bj) {
                    const size_t off = (size_t)row * DFF + u.pn * 256 + 128 * bj + 32 * wc + 8 * fq;
                    float v[8];
#pragma unroll
                    for (int j = 0; j < 4; ++j) { const float r0 = fmaxf(acc[ai][bj][m][0][j] * rstd, 0.f), r1 = fmaxf(acc[ai][bj][m][1][j] * rstd, 0.f); v[j] = r0 * r0; v[4 + j] = r1 * r1; }
                    *(u32x4*)(H + off) = pack8(v);
                }
            }
            asm volatile("" ::: "memory");
        }
    }
};

DEV int win_colmap(int cg) {
    const int pn = cg >> 8, r = cg & 255, bj = r >> 7, wc = (r >> 5) & 3, n = (r >> 4) & 1, fq = (r >> 2) & 3, jp = (r >> 1) & 1, s = r & 1;
    int o;
    if (pn < 9) o = 256 * pn + 64 * wc + 32 * s + 8 * fq + 4 * bj + 2 * n + jp;
    else o = 256 * pn + 32 * (2 * wc + bj) + 16 * s + 4 * fq + 2 * n + jp;
    return o < INW ? o : -1;
}
DEV void sincos_acc(float ang, float& c, float& s) {
    const double x = (double)ang, twopi = 6.283185307179586476925287;
    const double k = __builtin_rint(x * (1.0 / twopi));
    const double r = x - k * twopi, r2 = r * r;
    double sp = 1.0, cp = 1.0;
#pragma unroll
    for (int i = 14; i >= 1; --i) { sp = 1.0 - sp * r2 / (double)((2 * i) * (2 * i + 1)); cp = 1.0 - cp * r2 / (double)((2 * i - 1) * (2 * i)); }
    s = (float)(r * sp); c = (float)cp;
}

struct TJob { const float* W; const float* gain; bf16_t* Bt; int N, K, c0, k0, perm; };
DEV TJob tjob_decode(const Params& p, int job) {
    unsigned char* ws = p.ws;
    const int l = job / 3008; int r = job % 3008; TJob j;
    if (r < 704) { j.W = p.w_in + (size_t)l * DM * INW; j.gain = p.g_mix + l * DM; j.Bt = (bf16_t*)(ws + WS_WIN + (size_t)l * SZ_WIN1); j.N = INW; j.K = DM; j.c0 = (r >> 4) * 64; j.k0 = (r & 15) * 64; j.perm = 1; }
    else if (r < 960) { r -= 704; j.W = p.w_out + (size_t)l * DM * DM; j.gain = nullptr; j.Bt = (bf16_t*)(ws + WS_WOUT + (size_t)l * SZ_WOUT1); j.N = DM; j.K = DM; j.c0 = (r >> 4) * 64; j.k0 = (r & 15) * 64; j.perm = 0; }
    else if (r < 1984) { r -= 960; j.W = p.w_up + (size_t)l * DM * DFF; j.gain = p.g_ffn + l * DM; j.Bt = (bf16_t*)(ws + WS_WUP + (size_t)l * SZ_WUP1); j.N = DFF; j.K = DM; j.c0 = (r >> 4) * 64; j.k0 = (r & 15) * 64; j.perm = 0; }
    else { r -= 1984; j.W = p.w_down + (size_t)l * DFF * DM; j.gain = nullptr; j.Bt = (bf16_t*)(ws + WS_WDN + (size_t)l * SZ_WUP1); j.N = DM; j.K = DFF; j.c0 = (r >> 6) * 64; j.k0 = (r & 63) * 64; j.perm = 0; }
    return j;
}
DEV void tjob_load(const TJob& j, float (&v)[8], int tid) {
    if (j.perm) {
#pragma unroll
        for (int it = 0; it < 8; ++it) {
            const int idx = tid + 512 * it, kk = idx >> 6, cc = idx & 63, o = win_colmap(j.c0 + cc);
            v[it] = (o >= 0) ? __builtin_nontemporal_load(j.W + (size_t)(j.k0 + kk) * j.N + o) * j.gain[j.k0 + kk] : 0.f;
        }
    } else {
#pragma unroll
        for (int it = 0; it < 2; ++it) {
            const int idx = tid + 512 * it, kk = idx >> 4, c4 = idx & 15;
            const f32x4 x = ntl4(j.W + (size_t)(j.k0 + kk) * j.N + j.c0 + 4 * c4);
            const float g = j.gain ? j.gain[j.k0 + kk] : 1.f;
#pragma unroll
            for (int e = 0; e < 4; ++e) v[4 * it + e] = x[e] * g;
        }
    }
}
DEV void tjob_lds(const TJob& j, const float (&v)[8], float* tile, int tid) {
    if (j.perm) {
#pragma unroll
        for (int it = 0; it < 8; ++it) { const int idx = tid + 512 * it; tile[(idx & 63) * 65 + (idx >> 6)] = v[it]; }
    } else {
#pragma unroll
        for (int it = 0; it < 2; ++it) {
            const int idx = tid + 512 * it, kk = idx >> 4, c4 = idx & 15;
#pragma unroll
            for (int e = 0; e < 4; ++e) tile[(4 * c4 + e) * 65 + kk] = v[4 * it + e];
        }
    }
}
DEV void tjob_flush(const TJob& j, const float* tile, int tid) {
    const int cc = tid >> 3, kg = tid & 7;
    float v[8];
#pragma unroll
    for (int i = 0; i < 8; ++i) v[i] = tile[cc * 65 + 8 * kg + i];
    *(u32x4*)(j.Bt + (size_t)(j.c0 + cc) * j.K + j.k0 + 8 * kg) = pack8(v);
}

DEV void transpose_jobs(const Params& p, unsigned char* lds, int j0, int j1, int me, int nblk);
DEV void phase_prologue(const Params& p, unsigned char* lds) {
    const int tid = otid(), lane = tid & 63, G = gridDim.x;
    unsigned char* ws = p.ws;
    {
        bf16_t* XB = (bf16_t*)(ws + WS_XB); float* SS = (float*)(ws + WS_SS);
        for (int row0 = blockIdx.x * 8 + (tid >> 6); row0 < MT; row0 += G * 16) {
            f32x4 v[2][4]; int rows[2];
#pragma unroll
            for (int h = 0; h < 2; ++h) {
                const int row = row0 + h * G * 8; rows[h] = row;
                if (row < MT) {
                    const float* src = row < NPR ? p.x_prompt + (size_t)row * DM : p.x_sample + (size_t)(row - NPR) * DM;
#pragma unroll
                    for (int i = 0; i < 4; ++i) v[h][i] = ntl4(src + i * 256 + lane * 4);
                }
            }
#pragma unroll
            for (int h = 0; h < 2; ++h) {
                const int row = rows[h];
                if (row < MT) {
                    bf16_t* xb = XB + (size_t)row * DM;
                    float sq = 0.f;
#pragma unroll
                    for (int i = 0; i < 4; ++i) {
                        const f32x4 x = v[h][i];
                        *(u32x2*)(xb + i * 256 + lane * 4) = (u32x2){pk2(x[0], x[1]), pk2(x[2], x[3])};
                        sq += (x[0] * x[0] + x[1] * x[1]) + (x[2] * x[2] + x[3] * x[3]);
                    }
                    sq = wave_sum(sq);
                    if (lane < 16) SS[(size_t)row * 16 + lane] = lane == 0 ? sq : 0.f;
                }
            }
        }
    }
    const int gtid = blockIdx.x * NTHREADS + tid, gsz = G * NTHREADS;
    {
        float* RT = (float*)(ws + WS_ROPE);
        for (int i = gtid; i < 2080 * 32; i += gsz) {
            const int pi = i >> 5, k = i & 31, pos = pi < 2048 ? pi : PAST + (pi - 2048);
            float c, s; sincos_acc((float)pos * c_invf[k], c, s);
            RT[pi * 64 + k] = c; RT[pi * 64 + 32 + k] = s;
        }
    }
    {
        bf16_t* KIS = (bf16_t*)(ws + WS_KIS);
        for (int i = gtid; i < 2 * 8 * PAST * 4; i += gsz) {
            const int dg = i & 3, key = (i >> 2) & 4095, lb = i >> 14;
            const float* src = p.cache_kidx + ((size_t)lb * PAST + key) * 32 + dg * 8;
            const f32x4 a = ntl4(src), b = ntl4(src + 4);
            *(u32x4*)(KIS + ((size_t)lb * LSP + key) * 32 + dg * 8) = (u32x4){pk2(a[0], a[1]), pk2(a[2], a[3]), pk2(b[0], b[1]), pk2(b[2], b[3])};
        }
    }
    transpose_jobs(p, lds, 0, 6016, blockIdx.x, G);
}
DEV void transpose_jobs(const Params& p, unsigned char* lds, int j0, int j1, int me, int nblk) {
    const int tid = otid();
    {
        float* tile = (float*)lds;
        for (int jb = j0 + me * 4; jb < j1; jb += nblk * 4) {
            float v[4][8];
#pragma unroll
            for (int u = 0; u < 4; ++u) { const TJob j = tjob_decode(p, jb + u); tjob_load(j, v[u], tid); }
#pragma unroll
            for (int u = 0; u < 4; ++u) { const TJob j = tjob_decode(p, jb + u); tjob_lds(j, v[u], tile + u * 4160, tid); }
            __syncthreads();
#pragma unroll
            for (int u = 0; u < 4; ++u) { const TJob j = tjob_decode(p, jb + u); tjob_flush(j, tile + u * 4160, tid); }
            __syncthreads();
        }
    }
}

DEV unsigned sort_key(float f) { const unsigned u = __float_as_uint(f); return (u & 0x80000000u) ? ~u : (u | 0x80000000u); }

DEV int wave_isum(int v) {
    v += __builtin_amdgcn_update_dpp(0, v, 0x111, 0xf, 0xf, true);
    v += __builtin_amdgcn_update_dpp(0, v, 0x112, 0xf, 0xf, true);
    v += __builtin_amdgcn_update_dpp(0, v, 0x114, 0xf, 0xf, true);
    v += __builtin_amdgcn_update_dpp(0, v, 0x118, 0xf, 0xf, true);
    v += __builtin_amdgcn_update_dpp(0, v, 0x142, 0xa, 0xf, false);
    v += __builtin_amdgcn_update_dpp(0, v, 0x143, 0xc, 0xf, false);
    return __builtin_amdgcn_readlane(v, 63);
}
template <int NCH, int NR> DEV void select_rows(const float* rowf, int npad, int nch, u64* bmr, int bmstride, int lane) {
    asm volatile("" : "+s"(nch));
    unsigned kreg[NR][NCH];
#pragma unroll
    for (int r = 0; r < NR; ++r)
#pragma unroll
        for (int c = 0; c < NCH; ++c) {
            const unsigned k = sort_key(rowf[(size_t)r * npad + c * 64 + lane]);
            kreg[r][c] = (c < nch) ? k : 0u;
        }
    unsigned T[NR]; bool done[NR];
#pragma unroll
    for (int r = 0; r < NR; ++r) { T[r] = 0u; done[r] = false; }
    for (int bit = 31; bit >= 0; --bit) {
        unsigned cand[NR]; int cnt[NR];
#pragma unroll
        for (int r = 0; r < NR; ++r) { cand[r] = T[r] | (1u << bit); cnt[r] = 0; }
#pragma unroll
        for (int c = 0; c < NCH; ++c) {
            if ((c & 7) == 0 && c >= nch) break;
#pragma unroll
            for (int r = 0; r < NR; ++r) cnt[r] += (kreg[r][c] >= cand[r]) ? 1 : 0;
        }
        bool alldone = true;
#pragma unroll
        for (int r = 0; r < NR; ++r) {
            const int tot = wave_isum(cnt[r]);
            if (tot >= 256) T[r] = cand[r];
            if (tot == 256) done[r] = true;
            alldone = alldone && done[r];
        }
        if (alldone) break;
    }
#pragma unroll
    for (int r = 0; r < NR; ++r) {
        int cg = 0;
#pragma unroll
        for (int c = 0; c < NCH; ++c) { if ((c & 7) == 0 && c >= nch) break; cg += (kreg[r][c] > T[r]) ? 1 : 0; }
        const int need = 256 - wave_isum(cg);
        int eqbase = 0;
#pragma unroll
        for (int c = 0; c < NCH; ++c) {
            if (c < nch) {
                const unsigned kv = kreg[r][c];
                const bool eq = (kv == T[r]);
                const u64 be = __ballot(eq);
                const int rank = eqbase + __popcll(be & ((1ull << lane) - 1ull));
                const bool sel = (kv > T[r]) || (eq && rank < need);
                const u64 bs = __ballot(sel);
                eqbase += __popcll(be);
                if (lane == 0) bmr[(size_t)r * bmstride + c] = bs;
            }
        }
    }
}

struct IdxItem { int nq, n, row0, bmstride; const bf16_t* KI; u64* BM; };
DEV IdxItem idx_decode(const Params& p, int layer, int item) {
    unsigned char* ws = p.ws; IdxItem I;
    if (item < 32) {
        const int b = item >> 2, qt = item & 3;
        I.nq = 8; I.n = LS; I.row0 = NPR + b * 32 + qt * 8;
        I.KI = (const bf16_t*)(ws + WS_KIS + (size_t)layer * SZ_KIS1) + (size_t)b * LSP * 32;
        I.BM = (u64*)(ws + WS_BMS) + (size_t)(b * 32 + qt * 8) * 72; I.bmstride = 72;
    } else {
        const int i2 = item - 32, c = 31 - (i2 >> 5), w = i2 & 31, b = w >> 2, qt = w & 3;
        I.nq = 16; I.n = 64 * (c + 1); I.row0 = b * TP + 64 * c + 16 * qt;
        I.KI = (const bf16_t*)(ws + WS_KIP) + (size_t)b * TP * 32;
        I.BM = (u64*)(ws + WS_BMP) + (size_t)I.row0 * 32; I.bmstride = 32;
    }
    return I;
}
struct IdxPre { bf16x8 aq[4][2]; bf16x8 nb0, nb1; float wv; };
DEV void idx_prefetch(const Params& p, const IdxItem& I, IdxPre& P, int tid, int lane, int wave) {
    if (I.n <= 256) return;
    unsigned char* ws = p.ws;
    const bf16_t* QI = (const bf16_t*)(ws + WS_QIB); const float* WI = (const float*)(ws + WS_WI);
    P.wv = (tid < I.nq * 8) ? WI[(size_t)I.row0 * 8 + tid] : 0.f;
    const int nqb = I.nq >> 2;
    const int i = lane & 31, a = i >> 3, gi = (i >> 2) & 1, c = i & 3, qin = 2 * gi + (a >> 1), head = 4 * (a & 1) + c;
#pragma unroll
    for (int qb = 0; qb < 4; ++qb)
#pragma unroll
        for (int ks = 0; ks < 2; ++ks) {
            if (qb < nqb) P.aq[qb][ks] = *(const bf16x8*)(QI + (size_t)(I.row0 + 4 * qb + qin) * 256 + head * 32 + 8 * (lane >> 5) + 16 * ks);
            else P.aq[qb][ks] = (bf16x8){0, 0, 0, 0, 0, 0, 0, 0};
        }
    const int g = lane >> 5, nkb = I.n >> 5;
    P.nb0 = (bf16x8){0, 0, 0, 0, 0, 0, 0, 0}; P.nb1 = P.nb0;
    if (wave < nkb) { const bf16_t* kp = I.KI + (size_t)(wave * 32 + (lane & 31)) * 32 + 8 * g; P.nb0 = *(const bf16x8*)kp; P.nb1 = *(const bf16x8*)(kp + 16); }
}
DEV int indexer_item(const Params& p, int layer, int item, unsigned char* lds, const IdxPre& P, int nxt, volatile int* slot, IdxPre& Pn) {
    const int tid = otid(), lane = tid & 63, wave = __builtin_amdgcn_readfirstlane(tid >> 6);
    const IdxItem I = idx_decode(p, layer, item);
    const int nq = I.nq, n = I.n, bmstride = I.bmstride; u64* BM = I.BM; const bf16_t* KI = I.KI;
    const int ntile = (n + 63) >> 6;
    if (n <= 256) {
        if (tid < nq * ntile) BM[(size_t)(tid / ntile) * bmstride + (tid % ntile)] = ~0ull;
        if (tid == 0) slot[1] = nxt;
        __syncthreads();
        const int nx = __builtin_amdgcn_readfirstlane(slot[1]);
        __syncthreads();
        if (nx < 1056) idx_prefetch(p, idx_decode(p, layer, nx), Pn, tid, lane, wave);
        return nx;
    }
    const int npad = ntile * 64;
    float* sc = (float*)lds;
    float* wl = (float*)(lds + 133120);
    if (tid < nq * 8) wl[tid] = P.wv;
    const int nqb = nq >> 2;
    const int g = lane >> 5;
    const int nkb = n >> 5;
    bf16x8 nb0 = P.nb0, nb1 = P.nb1;
    __syncthreads();
    for (int kb = wave; kb < nkb; kb += 8) {
        const int key = kb * 32 + (lane & 31);
        const bf16x8 b0 = nb0, b1 = nb1;
        if (kb + 8 < nkb) { const bf16_t* kp = KI + (size_t)(key + 256) * 32 + 8 * g; nb0 = *(const bf16x8*)kp; nb1 = *(const bf16x8*)(kp + 16); }
#pragma unroll
        for (int qb = 0; qb < 4; ++qb) {
            if (qb < nqb) {
                f32x16 acc;
#pragma unroll
                for (int r = 0; r < 16; ++r) acc[r] = 0.f;
                acc = __builtin_amdgcn_mfma_f32_32x32x16_bf16(P.aq[qb][0], b0, acc, 0, 0, 0);
                acc = __builtin_amdgcn_mfma_f32_32x32x16_bf16(P.aq[qb][1], b1, acc, 0, 0, 0);
#pragma unroll
                for (int qq = 0; qq < 2; ++qq) {
                    const int ql = 4 * qb + 2 * g + qq;
                    const f32x4 w0 = *(const f32x4*)(wl + ql * 8), w1 = *(const f32x4*)(wl + ql * 8 + 4);
                    float s = 0.f;
#pragma unroll
                    for (int h = 0; h < 4; ++h) s = fmaf(w0[h], __builtin_amdgcn_fmed3f(acc[8 * qq + h], 0.f, __builtin_inff()), s);
#pragma unroll
                    for (int h = 0; h < 4; ++h) s = fmaf(w1[h], __builtin_amdgcn_fmed3f(acc[8 * qq + 4 + h], 0.f, __builtin_inff()), s);
                    s = (s == 0.f) ? 0.f : s;
                    sc[(size_t)ql * npad + key] = s;
                }
            }
        }
    }
    if (npad > n && tid < nq * (npad - n)) sc[(size_t)(tid / (npad - n)) * npad + n + tid % (npad - n)] = -__builtin_inff();
    if (tid == 0) slot[1] = nxt;
    __syncthreads();
    const int nx = __builtin_amdgcn_readfirstlane(slot[1]);
    if (nx < 1056) idx_prefetch(p, idx_decode(p, layer, nx), Pn, tid, lane, wave);
    const float* scf = (const float*)lds;
    if (nq == 16) select_rows<32, 2>(scf + (size_t)(2 * wave) * npad, npad, ntile, BM + (size_t)(2 * wave) * bmstride, bmstride, lane);
    else select_rows<65, 1>(scf + (size_t)wave * npad, npad, ntile, BM + (size_t)wave * bmstride, bmstride, lane);
    __syncthreads();
    return nx;
}

DEV void sgate_item(const Params& p, int layer, int item) {
    const int tid = otid(), lane = tid & 63, wave = tid >> 6, fr = lane & 15, quad = lane >> 4;
    unsigned char* ws = p.ws;
    int row0, ni, h;
    if (item < 512) { h = item & 3; row0 = (item >> 2) * 128; ni = 128; } else { const int i2 = item - 512; h = i2 & 3; row0 = NPR + (i2 >> 2) * 32; ni = 32; }
    if (wave * 16 >= ni) return;
    const int ksmax = (ni == 32) ? 1 : (wave < 4 ? 2 : 4);
    const float* W = p.w_s + ((size_t)(layer * 4 + h) * 128 + wave * 16 + fr) * 128;
    const bf16_t* SGVT = (const bf16_t*)(ws + WS_SGVT);
    f32x4 acc[4];
#pragma unroll
    for (int nn = 0; nn < 4; ++nn) acc[nn] = (f32x4){0.f, 0.f, 0.f, 0.f};
    f32x4 a0[4], a1[4]; bf16x8 bfr[4][4];
#pragma unroll
    for (int ks = 0; ks < 4; ++ks)
        if (ks < ksmax) {
            a0[ks] = *(const f32x4*)(W + 32 * ks + 8 * quad); a1[ks] = *(const f32x4*)(W + 32 * ks + 8 * quad + 4);
#pragma unroll
            for (int nn = 0; nn < 4; ++nn) bfr[ks][nn] = *(const bf16x8*)(SGVT + (size_t)(h * 64 + 16 * nn + fr) * MT + row0 + 32 * ks + 8 * quad);
        }
    const bf16_t* ZAU = (const bf16_t*)(ws + WS_ZAU); bf16_t* YMIX = (bf16_t*)(ws + WS_YMIX);
    unsigned short uu[4][4]; float bias[4];
#pragma unroll
    for (int j = 0; j < 4; ++j) {
        const int i = wave * 16 + 4 * quad + j;
        bias[j] = p.b_s[(layer * 4 + h) * 128 + i];
#pragma unroll
        for (int nn = 0; nn < 4; ++nn) uu[j][nn] = ZAU[(size_t)(row0 + i) * 256 + h * 64 + 16 * nn + fr];
    }
#pragma unroll
    for (int ks = 0; ks < 4; ++ks)
        if (ks < ksmax) {
            const u32x4 aw = (u32x4){pk2(a0[ks][0], a0[ks][1]), pk2(a0[ks][2], a0[ks][3]), pk2(a1[ks][0], a1[ks][1]), pk2(a1[ks][2], a1[ks][3])};
            const bf16x8 af = __builtin_bit_cast(bf16x8, aw);
#pragma unroll
            for (int nn = 0; nn < 4; ++nn) acc[nn] = __builtin_amdgcn_mfma_f32_16x16x32_bf16(af, bfr[ks][nn], acc[nn], 0, 0, 0);
        }
#pragma unroll
    for (int j = 0; j < 4; ++j) {
        const int i = wave * 16 + 4 * quad + j;
#pragma unroll
        for (int nn = 0; nn < 4; ++nn) YMIX[(size_t)(row0 + i) * 1024 + h * 64 + 16 * nn + fr] = f2bf(bf2f(uu[j][nn]) * (acc[nn][j] + bias[j]));
    }
}

DEV void conv_one(const Params& p, int layer, const bf16_t* ZB, bf16_t* YMIX, int i) {
    {
        const int row = i >> 5, ch = (i & 31) * 8;
        const bool samp = row >= NPR; const int rs = row - NPR;
        const int b = samp ? (rs >> 5) : (row >> 11), t = samp ? (rs & 31) : (row & 2047), T = samp ? 32 : TP;
        float xc[3][8];
#pragma unroll
        for (int dt = 0; dt < 3; ++dt) {
            const int tt = t - 2 + dt;
            if (tt >= 0) {
                const bf16_t* zr = ZB + (size_t)(row - 2 + dt) * 768 + ch;
                const u32x4 gc = *(const u32x4*)(zr + 256), hi = *(const u32x4*)(zr + 512);
#pragma unroll
                for (int e = 0; e < 4; ++e) {
                    xc[dt][2 * e] = __uint_as_float(gc[e] << 16) * __uint_as_float(hi[e] << 16);
                    xc[dt][2 * e + 1] = __uint_as_float(gc[e] & 0xffff0000u) * __uint_as_float(hi[e] & 0xffff0000u);
                }
            } else if (samp) {
                const float* st = p.state_conv + (((size_t)layer * 8 + b) * 2 + (tt + 2)) * 256 + ch;
                const f32x4 a = *(const f32x4*)st, c = *(const f32x4*)(st + 4);
#pragma unroll
                for (int e = 0; e < 4; ++e) { xc[dt][e] = a[e]; xc[dt][4 + e] = c[e]; }
            } else {
#pragma unroll
                for (int e = 0; e < 8; ++e) xc[dt][e] = 0.f;
            }
        }
        const u32x4 gb = *(const u32x4*)(ZB + (size_t)row * 768 + ch);
        const float* cw = p.conv_w + (size_t)layer * 3 * 256 + ch;
        float y[8];
#pragma unroll
        for (int e = 0; e < 8; ++e) {
            const float gbe = (e & 1) ? __uint_as_float(gb[e >> 1] & 0xffff0000u) : __uint_as_float(gb[e >> 1] << 16);
            y[e] = gbe * (cw[e] * xc[0][e] + cw[256 + e] * xc[1][e] + cw[512 + e] * xc[2][e]);
        }
        *(u32x4*)(YMIX + (size_t)row * 1024 + 256 + ch) = pack8(y);
        if (t >= T - 2) {
            float* d = p.out + (samp ? O_CS : O_CP) + (((size_t)layer * 8 + b) * 2 + (t - (T - 2))) * 256 + ch;
            *(f32x4*)d = (f32x4){xc[2][0], xc[2][1], xc[2][2], xc[2][3]}; *(f32x4*)(d + 4) = (f32x4){xc[2][4], xc[2][5], xc[2][6], xc[2][7]};
        }
    }
}

DEV void phase_mix_a(const Params& p, int layer, unsigned char* lds) {
    {
        unsigned char* ws = p.ws;
        const bf16_t* ZB = (const bf16_t*)(ws + WS_ZB); bf16_t* YMIX = (bf16_t*)(ws + WS_YMIX);
        for (int i = blockIdx.x * NTHREADS + otid(); i < MT * 32; i += gridDim.x * NTHREADS) conv_one(p, layer, ZB, YMIX, i);
    }
    {
        const int tid = otid(), lane = tid & 63, wave = __builtin_amdgcn_readfirstlane(tid >> 6);
        unsigned* ctr = (unsigned*)(p.ws + WS_BAR) + 3712 + 64 * layer;
        volatile int* slot = (volatile int*)(lds + LDS_BYTES - 32);
        if (tid == 0) slot[0] = (int)__hip_atomic_fetch_add(ctr, 1u, __ATOMIC_RELAXED, __HIP_MEMORY_SCOPE_AGENT);
        __syncthreads();
        int it = __builtin_amdgcn_readfirstlane(slot[0]);
        IdxPre P;
        if (it < 1056) idx_prefetch(p, idx_decode(p, layer, it), P, tid, lane, wave);
        while (it < 1056 + 544) {
            int nxt = 0;
            if (tid == 0) nxt = (int)__hip_atomic_fetch_add(ctr, 1u, __ATOMIC_RELAXED, __HIP_MEMORY_SCOPE_AGENT);
            if (it < 1056) {
                IdxPre Pn;
                it = indexer_item(p, layer, it, lds, P, nxt, slot, Pn);
                P = Pn;
            } else {
                sgate_item(p, layer, it - 1056);
                if (tid == 0) slot[1] = nxt;
                __syncthreads();
                it = __builtin_amdgcn_readfirstlane(slot[1]);
                __syncthreads();
            }
        }
    }
}

constexpr int AT_VP = 136;
constexpr int AT_KT = 8192, AT_VT = 64 * AT_VP, AT_BUF = AT_KT + AT_VT, AT_GRP = 2 * AT_BUF;
template <bool SAMPLE> struct AttnRaw { u32x4 k[2]; u32x4 v[2]; };
template <> struct AttnRaw<true> { f32x4 k[2][2]; f32x4 v[2][2]; };
struct AttnSrc { const bf16_t* kb; const bf16_t* vt; const float* ck; const float* cv; const float* nk; const float* nv; };

template <bool SAMPLE> DEV void attn_load(AttnRaw<SAMPLE>& raw, const AttnSrc& S, int kt, int tg) {
#pragma unroll
    for (int r = 0; r < 2; ++r) {
        const int q = tg + 256 * r;
        if constexpr (!SAMPLE) {
            raw.k[r] = *(const u32x4*)(S.kb + (size_t)(kt * 64 + (q >> 3)) * 64 + 8 * (q & 7));
            raw.v[r] = *(const u32x4*)(S.vt + (size_t)(q >> 3) * TPV + kt * 64 + 8 * (q & 7));
        } else {
            {
                const int key = kt * 64 + (q >> 3), g = q & 7;
                if (key < LS) { const float* s = key < PAST ? S.ck + (size_t)key * 256 + 8 * g : S.nk + (size_t)(key - PAST) * 256 + 8 * g; raw.k[r][0] = ntl4(s); raw.k[r][1] = ntl4(s + 4); }
                else { raw.k[r][0] = (f32x4){0.f, 0.f, 0.f, 0.f}; raw.k[r][1] = raw.k[r][0]; }
            }
            {
                const int key = kt * 64 + (q >> 3), g = q & 7;
                if (key < LS) { const float* s = key < PAST ? S.cv + (size_t)key * 256 + 8 * g : S.nv + (size_t)(key - PAST) * 256 + 8 * g; raw.v[r][0] = ntl4(s); raw.v[r][1] = ntl4(s + 4); }
                else { raw.v[r][0] = (f32x4){0.f, 0.f, 0.f, 0.f}; raw.v[r][1] = raw.v[r][0]; }
            }
        }
    }
}
template <bool SAMPLE> DEV void attn_store(const AttnRaw<SAMPLE>& raw, unsigned char* buf, int tg) {
#pragma unroll
    for (int r = 0; r < 2; ++r) {
        const int q = tg + 256 * r, row = q >> 3, g = q & 7;
        unsigned char* kd = buf + row * 128 + ((g ^ ((row >> 1) & 7)) << 4);
        if constexpr (!SAMPLE) {
            *(u32x4*)kd = raw.k[r];
            *(u32x2*)(buf + AT_KT + row * AT_VP + 16 * g) = (u32x2){raw.v[r].x, raw.v[r].y}; *(u32x2*)(buf + AT_KT + row * AT_VP + 16 * g + 8) = (u32x2){raw.v[r].z, raw.v[r].w};
        } else {
            *(u32x4*)kd = (u32x4){pk2(raw.k[r][0][0], raw.k[r][0][1]), pk2(raw.k[r][0][2], raw.k[r][0][3]), pk2(raw.k[r][1][0], raw.k[r][1][1]), pk2(raw.k[r][1][2], raw.k[r][1][3])};
            const int kl = q >> 3, gv = q & 7;
            bf16_t* vd = (bf16_t*)(buf + AT_KT + (8 * gv) * AT_VP) + kl;
#pragma unroll
            for (int e = 0; e < 4; ++e) { vd[e * (AT_VP / 2)] = f2bf(raw.v[r][0][e]); vd[(4 + e) * (AT_VP / 2)] = f2bf(raw.v[r][1][e]); }
        }
    }
}
template <int NG> DEV void attn_tile(const unsigned char* buf, const bf16x8 (&qf)[NG][2], u64 mw, float c1, float c2, f32x4 (&o)[NG][4], float (&lsum)[NG], int fr, int quad) {
    const u64 mq = mw >> (4 * quad);
    const int mlo = (int)(unsigned)mq, mhi = (int)(unsigned)(mq >> 32);
    const unsigned nb = __float_as_uint(-c2);
    f32x4 zi[4];
#pragma unroll
    for (int t = 0; t < 4; ++t)
#pragma unroll
        for (int j = 0; j < 4; ++j) {
            const unsigned m = (unsigned)__builtin_amdgcn_sbfe(t < 2 ? mlo : mhi, 16 * (t & 1) + j, 1);
            zi[t][j] = __uint_as_float((m & nb) | (~m & 0xf149f2cau));
        }
    f32x4 st[NG][4];
#pragma unroll
    for (int t = 0; t < 4; ++t) {
        const int row = 16 * t + fr, sw = (row >> 1) & 7;
        const bf16x8 k0 = *(const bf16x8*)(buf + row * 128 + ((quad ^ sw) << 4)), k1 = *(const bf16x8*)(buf + row * 128 + (((quad + 4) ^ sw) << 4));
#pragma unroll
        for (int g = 0; g < NG; ++g) {
            const f32x4 z = __builtin_amdgcn_mfma_f32_16x16x32_bf16(k0, qf[g][0], zi[t], 0, 0, 0);
            st[g][t] = __builtin_amdgcn_mfma_f32_16x16x32_bf16(k1, qf[g][1], z, 0, 0, 0);
        }
    }
    u32x4 pw[NG][2];
#pragma unroll
    for (int g = 0; g < NG; ++g) {
#pragma unroll
        for (int t = 0; t < 4; ++t)
#pragma unroll
            for (int j = 0; j < 4; ++j) {
                const float pv = __builtin_amdgcn_exp2f(st[g][t][j]);
                st[g][t][j] = pv; lsum[g] += pv;
            }
#pragma unroll
        for (int i = 0; i < 2; ++i)
            pw[g][i] = (u32x4){pk2(st[g][2 * i][0], st[g][2 * i][1]), pk2(st[g][2 * i][2], st[g][2 * i][3]), pk2(st[g][2 * i + 1][0], st[g][2 * i + 1][1]), pk2(st[g][2 * i + 1][2], st[g][2 * i + 1][3])};
    }
#pragma unroll
    for (int i = 0; i < 2; ++i)
#pragma unroll
        for (int nn = 0; nn < 4; ++nn) {
            const unsigned char* vr = buf + AT_KT + (16 * nn + fr) * AT_VP + 64 * i + 8 * quad;
            const u32x2 v0 = *(const u32x2*)vr, v1 = *(const u32x2*)(vr + 32);
            const bf16x8 vb = __builtin_bit_cast(bf16x8, (u32x4){v0.x, v0.y, v1.x, v1.y});
#pragma unroll
            for (int g = 0; g < NG; ++g) o[g][nn] = __builtin_amdgcn_mfma_f32_16x16x32_bf16(__builtin_bit_cast(bf16x8, pw[g][i]), vb, o[g][nn], 0, 0, 0);
        }
}
template <bool SAMPLE, int NG> DEV void attn_stream(const AttnSrc& S, const bf16_t* Qrow, const u64* bmrow, int kt0, int kt1, int nsteps, unsigned char* glds, int tg, int lane, float c1, float c2, f32x4 (&o)[NG][4], float (&lsum)[NG]) {
    const int fr = lane & 15, quad = lane >> 4;
    bf16x8 qf[NG][2];
#pragma unroll
    for (int g = 0; g < NG; ++g) { qf[g][0] = *(const bf16x8*)(Qrow + 64 * g + 8 * quad); qf[g][1] = *(const bf16x8*)(Qrow + 64 * g + 32 + 8 * quad); }
    const int klast = kt1 - 1;
    AttnRaw<SAMPLE> R0, R1, R2;
    u64 mwn = bmrow[kt0];
    attn_load<SAMPLE>(R0, S, kt0, tg);
    attn_load<SAMPLE>(R1, S, min(kt0 + 1, klast), tg);
    attn_load<SAMPLE>(R2, S, min(kt0 + 2, klast), tg);
    attn_store<SAMPLE>(R0, glds, tg);
    __syncthreads();
#define ATTN_STEP(CUR, RSTORE, RLOAD, SIDX) do { \
        const u64 mw = mwn; \
        mwn = (kt0 + (SIDX) + 1 < kt1) ? bmrow[kt0 + (SIDX) + 1] : 0ull; \
        attn_load<SAMPLE>(RLOAD, S, min(kt0 + (SIDX) + 3, klast), tg); \
        attn_tile<NG>(glds + (CUR) * AT_BUF, qf, mw, c1, c2, o, lsum, fr, quad); \
        attn_store<SAMPLE>(RSTORE, glds + ((CUR) ^ 1) * AT_BUF, tg); \
        __syncthreads(); } while (0)
    for (int s = 0; s < nsteps; s += 6) {
        ATTN_STEP(0, R1, R0, s);
        if (s + 1 < nsteps) ATTN_STEP(1, R2, R1, s + 1);
        if (s + 2 < nsteps) ATTN_STEP(0, R0, R2, s + 2);
        if (s + 3 < nsteps) ATTN_STEP(1, R1, R0, s + 3);
        if (s + 4 < nsteps) ATTN_STEP(0, R2, R1, s + 4);
        if (s + 5 < nsteps) ATTN_STEP(1, R0, R2, s + 5);
    }
#undef ATTN_STEP
}
template <int NG> DEV void attn_finish(bf16_t* YMIX, int rowq, int head0, f32x4 (&o)[NG][4], float (&lsum)[NG], int lane) {
    const int fr = lane & 15, quad = lane >> 4;
#pragma unroll
    for (int g = 0; g < NG; ++g) {
        float ls = lsum[g];
        ls += __shfl_xor(ls, 16); ls += __shfl_xor(ls, 32);
#pragma unroll
        for (int j = 0; j < 4; ++j) {
            const float l = __shfl(ls, 4 * quad + j);
            const float inv = 1.0f / l;
#pragma unroll
            for (int nn = 0; nn < 4; ++nn) YMIX[(size_t)(rowq + 4 * quad + j) * 1024 + 512 + (head0 + g) * 64 + 16 * nn + fr] = f2bf(o[g][nn][j] * inv);
        }
    }
}
DEV void attn_prompt_item(const Params& p, int idx, float c1, float c2, unsigned char* lds) {
    const int tid = otid(), lane = tid & 63, wave = tid >> 6, fr = lane & 15, grp = wave >> 2, wg = wave & 3;
    unsigned char* ws = p.ws;
    const int c = 31 - (idx >> 4), r = idx & 15, b = r >> 1, hk = 2 * (r & 1) + grp;
    const int rowq = b * TP + 64 * c + 16 * wg;
    f32x4 o[2][4];
#pragma unroll
    for (int g = 0; g < 2; ++g)
#pragma unroll
        for (int nn = 0; nn < 4; ++nn) o[g][nn] = (f32x4){0.f, 0.f, 0.f, 0.f};
    float lsum[2] = {0.f, 0.f};
    AttnSrc S{};
    S.kb = (const bf16_t*)(ws + WS_KP) + (size_t)(b * 4 + hk) * TP * 64;
    S.vt = (const bf16_t*)(ws + WS_VTP) + (size_t)(b * 4 + hk) * 64 * TPV;
    const u64* bm = (const u64*)(ws + WS_BMP) + (size_t)(rowq + fr) * 32;
    attn_stream<false, 2>(S, (const bf16_t*)(ws + WS_QB) + (size_t)(rowq + fr) * 512 + 2 * hk * 64, bm, 0, c + 1, c + 1, lds + grp * AT_GRP, tid & 255, lane, c1, c2, o, lsum);
    attn_finish<2>((bf16_t*)(ws + WS_YMIX), rowq, 2 * hk, o, lsum, lane);
}
DEV void attn_sample_item(const Params& p, int layer, int item, float c1, float c2, unsigned char* lds) {
    const int tid = otid(), lane = tid & 63, wave = tid >> 6, fr = lane & 15, quad = lane >> 4, grp = wave >> 2, wg = wave & 3;
    unsigned char* ws = p.ws;
    const int qt = item & 3, bh = item >> 2, b = bh >> 2, hk = bh & 3, head = 2 * hk + (wg >> 1);
    const int rowq = NPR + b * 32 + 16 * (wg & 1);
    const int t0 = (qt == 0) ? 0 : 1 + 16 * qt, t1 = 17 + 16 * qt;
    const int tm = t0 + ((t1 - t0 + 1) >> 1), nsteps = tm - t0;
    f32x4 o[1][4];
#pragma unroll
    for (int nn = 0; nn < 4; ++nn) o[0][nn] = (f32x4){0.f, 0.f, 0.f, 0.f};
    float lsum[1] = {0.f};
    AttnSrc S{};
    S.ck = p.cache_k + (size_t)(layer * 8 + b) * PAST * 256 + hk * 64; S.cv = p.cache_v + (size_t)(layer * 8 + b) * PAST * 256 + hk * 64;
    S.nk = p.out + O_KS + (size_t)(layer * NSR + b * 32) * 256 + hk * 64; S.nv = p.out + O_VS + (size_t)(layer * NSR + b * 32) * 256 + hk * 64;
    const u64* bm = (const u64*)(ws + WS_BMS) + (size_t)(b * 32 + 16 * (wg & 1) + fr) * 72;
    attn_stream<true, 1>(S, (const bf16_t*)(ws + WS_QB) + (size_t)(rowq + fr) * 512 + head * 64, bm, grp ? tm : t0, grp ? t1 : tm, nsteps, lds + grp * AT_GRP, tid & 255, lane, c1, c2, o, lsum);
    float* xo = (float*)lds;
    if (grp) {
        float* d = xo + ((size_t)wg * 64 + lane) * 17;
#pragma unroll
        for (int nn = 0; nn < 4; ++nn)
#pragma unroll
            for (int j = 0; j < 4; ++j) d[nn * 4 + j] = o[0][nn][j];
        d[16] = lsum[0];
    }
    __syncthreads();
    if (!grp) {
        const float* d = xo + ((size_t)wg * 64 + lane) * 17;
#pragma unroll
        for (int nn = 0; nn < 4; ++nn)
#pragma unroll
            for (int j = 0; j < 4; ++j) o[0][nn][j] += d[nn * 4 + j];
        float ls = lsum[0] + d[16];
        ls += __shfl_xor(ls, 16); ls += __shfl_xor(ls, 32);
        float* PO = (float*)(ws + WS_PART) + ((size_t)(bh * 4 + qt) * 64 + wg * 16) * 64;
        float* PL = (float*)(ws + WS_PART + SZ_PARTO) + (size_t)(bh * 4 + qt) * 64 + wg * 16;
#pragma unroll
        for (int j = 0; j < 4; ++j)
#pragma unroll
            for (int nn = 0; nn < 4; ++nn) PO[(size_t)(4 * quad + j) * 64 + 16 * nn + fr] = o[0][nn][j];
        if (quad == 0) PL[fr] = ls;
    }
    __syncthreads();
}
DEV void attn_sample_combine(const Params& p) {
    unsigned char* ws = p.ws;
    const float* PO = (const float*)(ws + WS_PART); const float* PL = (const float*)(ws + WS_PART + SZ_PARTO);
    bf16_t* YMIX = (bf16_t*)(ws + WS_YMIX);
    for (int i = blockIdx.x * NTHREADS + otid(); i < 8 * 4 * 64 * 16; i += gridDim.x * NTHREADS) {
        const int d4 = i & 15, pr = (i >> 4) & 63, bh = i >> 10, b = bh >> 2, hk = bh & 3;
        f32x4 acc = (f32x4){0.f, 0.f, 0.f, 0.f}; float l = 0.f;
#pragma unroll
        for (int q = 0; q < 4; ++q) { acc += *(const f32x4*)(PO + ((size_t)(bh * 4 + q) * 64 + pr) * 64 + 4 * d4); l += PL[(size_t)(bh * 4 + q) * 64 + pr]; }
        const float inv = 1.0f / l;
        const int wg = pr >> 4, qi = 16 * (wg & 1) + (pr & 15), head = 2 * hk + (wg >> 1);
        *(u32x2*)(YMIX + (size_t)(NPR + b * 32 + qi) * 1024 + 512 + head * 64 + 4 * d4) = (u32x2){pk2(acc[0] * inv, acc[1] * inv), pk2(acc[2] * inv, acc[3] * inv)};
    }
}

DEV void phase_attn(const Params& p, int layer, unsigned char* lds, int subset = 0) {
    const int tid = otid(), lane = tid & 63;
    const float gq = wave_max(fabsf(p.q_gain[layer * 64 + lane])), gk = wave_max(fabsf(p.k_gain[layer * 64 + lane]));
    const float bound = 8.0f * gq * gk * 1.02f;
    const float c1 = 0.125f * 1.4426950408889634f, c2 = bound * 1.4426950408889634f;
    unsigned* ctr = (unsigned*)(p.ws + WS_BAR) + 3584 + 64 * layer;
    volatile int* slot = (volatile int*)(lds + LDS_BYTES - 32);
    for (;;) {
        if (tid == 0) *slot = (int)__hip_atomic_fetch_add(ctr, 1u, __ATOMIC_RELAXED, __HIP_MEMORY_SCOPE_AGENT);
        __syncthreads();
        const int it = __builtin_amdgcn_readfirstlane(*slot);
        __syncthreads();
        if (it >= 640) break;
#ifdef PROBE_ATT_SUB
        if (subset == 1 && it >= 128) continue;
        if (subset == 2 && it < 128) continue;
#endif
        if (it < 128) attn_sample_item(p, layer, it, c1, c2, lds);
        else attn_prompt_item(p, it - 128, c1, c2, lds);
    }
}

template <int NT, int CH> DEV void mini_mma(const bf16_t* A, int lda, const bf16_t* Bt, int ldb, int r0, int c0, int k0, int k1, f32x4 (&acc)[NT], int lane) {
    const int fr = lane & 15, quad = lane >> 4;
    const bf16_t* ap = A + (size_t)(r0 + fr) * lda + 8 * quad;
    const bf16_t* bp = Bt + (size_t)(c0 + fr) * ldb + 8 * quad;
    for (int k = k0; k < k1; k += 32 * CH) {
        bf16x8 a[CH], b[NT][CH];
#pragma unroll
        for (int i = 0; i < CH; ++i) {
            a[i] = *(const bf16x8*)(ap + k + 32 * i);
#pragma unroll
            for (int nt = 0; nt < NT; ++nt) b[nt][i] = *(const bf16x8*)(bp + (size_t)16 * nt * ldb + k + 32 * i);
        }
#pragma unroll
        for (int i = 0; i < CH; ++i)
#pragma unroll
            for (int nt = 0; nt < NT; ++nt) acc[nt] = __builtin_amdgcn_mfma_f32_16x16x32_bf16(a[i], b[nt][i], acc[nt], 0, 0, 0);
    }
}
DEV void mini_res(const bf16_t* A, const bf16_t* Bt, int K, float* Y, bf16_t* XB, float* SS, unsigned char* lds, int last, int live) {
    const int tid = otid(), lane = tid & 63, wave = tid >> 6, fr = lane & 15, quad = lane >> 4;
    float* part = (float*)lds;
    float* tile = (float*)(lds + 8 * 64 * 17 * 4);
    for (int t = blockIdx.x; t < 256; t += gridDim.x) {
        const int r0 = NPR + 16 * (t >> 4), ct = t & 15, c0 = 64 * ct, kw = K >> 3;
        f32x4 acc[4];
#pragma unroll
        for (int nt = 0; nt < 4; ++nt) acc[nt] = (f32x4){0.f, 0.f, 0.f, 0.f};
        if (K == DFF) mini_mma<4, 8>(A, K, Bt, K, r0, c0, wave * kw, (wave + 1) * kw, acc, lane);
        else mini_mma<4, 4>(A, K, Bt, K, r0, c0, wave * kw, (wave + 1) * kw, acc, lane);
        float* d = part + ((size_t)wave * 64 + lane) * 17;
#pragma unroll
        for (int nt = 0; nt < 4; ++nt)
#pragma unroll
            for (int j = 0; j < 4; ++j) d[nt * 4 + j] = acc[nt][j];
        __syncthreads();
#pragma unroll
        for (int vv = 0; vv < 2; ++vv) {
            const int v = 2 * wave + vv, nt = v >> 2, j = v & 3;
            float s = 0.f;
#pragma unroll
            for (int w2 = 0; w2 < 8; ++w2) s += part[((size_t)w2 * 64 + lane) * 17 + v];
            const int rl = 4 * quad + j, cl = 16 * nt + fr;
            const size_t off = (size_t)(r0 + rl) * DM + c0 + cl;
            const float xn = bf2f(XB[off]) + s;
            if (live) { if (last) Y[off] = xn; else XB[off] = f2bf(xn); } tile[rl * 65 + cl] = xn;
        }
        __syncthreads();
        if (tid < 16) {
            float sq = 0.f;
            for (int c = 0; c < 64; ++c) { const float v = tile[tid * 65 + c]; sq += v * v; }
            if (live && !last) SS[(size_t)(r0 + tid) * 16 + ct] = sq;
        }
        __syncthreads();
    }
}
DEV void mini_up(const bf16_t* XB, const bf16_t* Bt, const float* SS, bf16_t* H) {
    const int tid = otid(), lane = tid & 63, wave = tid >> 6, fr = lane & 15, quad = lane >> 4;
    for (int t = blockIdx.x; t < 256; t += gridDim.x) {
        const int r0 = NPR + 16 * (t >> 4), c0 = 256 * (t & 15) + 32 * wave;
        f32x4 acc[2];
        acc[0] = (f32x4){0.f, 0.f, 0.f, 0.f}; acc[1] = acc[0];
        mini_mma<2, 16>(XB, DM, Bt, DM, r0, c0, 0, DM, acc, lane);
#pragma unroll
        for (int j = 0; j < 4; ++j) {
            const int row = r0 + 4 * quad + j;
            const float rstd = row_rstd(SS, row);
#pragma unroll
            for (int nt = 0; nt < 2; ++nt) { const float r = fmaxf(acc[nt][j] * rstd, 0.f); H[(size_t)row * DFF + c0 + 16 * nt + fr] = f2bf(r * r); }
        }
    }
}

__global__ void __launch_bounds__(NTHREADS) hybrid_fwd(Params p) {
    extern __shared__ __attribute__((aligned(16))) unsigned char lds[];
    cg::grid_group grid = cg::this_grid();
    PG8_LAS unsigned char* l3 = (PG8_LAS unsigned char*)lds;
    unsigned char* ws = p.ws;
    bf16_t* XB = (bf16_t*)(ws + WS_XB); float* SS = (float*)(ws + WS_SS);
    if (threadIdx.x < 4) ((LAS unsigned*)(l3 + LDS_BYTES - 16))[threadIdx.x] = 0u;
    __syncthreads();
    const XcdBarrier bar = xcd_barrier_post((unsigned*)(ws + WS_BAR), (volatile LAS unsigned*)(l3 + LDS_BYTES - 16));
    for (int ph = p.ph_lo; ph < p.ph_hi; ++ph) {
        if (ph > p.ph_lo) {
            if (p.ph_hi > 64) grid.sync();
            xcd_barrier(bar);
        }
#ifdef PROBE_DUP
        const int nrep = (ph == 0) ? ((PROBE_DUP >> 0) & 1) + 1 : (((PROBE_DUP >> (1 + (ph - 1) % 6)) & 1) + 1);
        for (int rep = 0; rep < nrep; ++rep) {
        if (rep) __syncthreads();
        if (rep && ph > 0 && (ph - 1) % 6 == 2) {
            xcd_barrier(bar);
            if (blockIdx.x == 0 && threadIdx.x == 0) __hip_atomic_store((unsigned*)(ws + WS_BAR) + 3584 + 64 * ((ph - 1) / 6), 0u, __ATOMIC_RELAXED, __HIP_MEMORY_SCOPE_AGENT);
            xcd_barrier(bar);
        }
        const int live = (rep == nrep - 1);
#else
        const int live = 1;
#endif
        if (ph == 0) {
#ifndef NO_P0
            phase_prologue(p, lds);
#endif
            continue; }
        const int l = (ph - 1) / 6, s = (ph - 1) % 6;
        if (s == 0) {
#ifndef NO_S0
            pg8::Gemm g{XB, (const bf16_t*)(ws + WS_WIN + (size_t)l * SZ_WIN1), MT, INWP, DM};
            pg8::StaticOrder S; S.init(MT, INWP, (int)gridDim.x, (int)blockIdx.x);
            EpiIn E{SS, (const float*)(ws + WS_ROPE), p.q_gain, p.k_gain, p.out, ws, l};
            pg8::gemm_phase<EpiIn, pg8::StaticOrder>(l3, g, S, E, nullptr);
#endif
        } else if (s == 1) {
#ifndef NO_S1
            phase_mix_a(p, l, lds);
#endif
        } else if (s == 2) {
#ifndef NO_S2
#ifdef PROBE_ATT_SUB
            phase_attn(p, l, lds, live ? 0 : PROBE_ATT_SUB);
#else
            phase_attn(p, l, lds);
#endif
            xcd_barrier(bar);
            attn_sample_combine(p);
#endif
        } else if (s == 3) {
#ifndef NO_S3
            mini_res((const bf16_t*)(ws + WS_YMIX), (const bf16_t*)(ws + WS_WOUT + (size_t)l * SZ_WOUT1), DM, p.out, XB, SS, lds, 0, live);
            pg8::Gemm g{(const bf16_t*)(ws + WS_YMIX), (const bf16_t*)(ws + WS_WOUT + (size_t)l * SZ_WOUT1), NPR, DM, DM};
            pg8::StaticOrder S; S.init(NPR, DM, (int)gridDim.x, (int)blockIdx.x);
            EpiRes E{p.out, XB, SS, 0, live};
            pg8::gemm_phase<EpiRes, pg8::StaticOrder>(l3, g, S, E, nullptr);
#endif
        } else if (s == 4) {
#ifndef NO_S4
            mini_up(XB, (const bf16_t*)(ws + WS_WUP + (size_t)l * SZ_WUP1), SS, (bf16_t*)(ws + WS_H));
            __syncthreads();
            pg8::Gemm g{XB, (const bf16_t*)(ws + WS_WUP + (size_t)l * SZ_WUP1), NPR, DFF, DM};
            pg8::StaticOrder S; S.init(NPR, DFF, (int)gridDim.x, (int)blockIdx.x);
            EpiUp E{(bf16_t*)(ws + WS_H), SS};
            pg8::gemm_phase<EpiUp, pg8::StaticOrder>(l3, g, S, E, nullptr);
#endif
        } else {
#ifndef NO_S5
            mini_res((const bf16_t*)(ws + WS_H), (const bf16_t*)(ws + WS_WDN + (size_t)l * SZ_WUP1), DFF, p.out, XB, SS, lds, l == 1, live);
            pg8::Gemm g{(const bf16_t*)(ws + WS_H), (const bf16_t*)(ws + WS_WDN + (size_t)l * SZ_WUP1), NPR, DM, DFF};
            pg8::StaticOrder S; S.init(NPR, DM, (int)gridDim.x, (int)blockIdx.x);
            EpiRes E{p.out, XB, SS, l == 1, live};
            pg8::gemm_phase<EpiRes, pg8::StaticOrder>(l3, g, S, E, nullptr);
#endif
        }
#ifdef PROBE_DUP
        }
#endif
    }
}

extern "C" void kernel_launch(void* const* d_in, const int* in_sizes, int n_in, void* d_out, int out_size, void* d_ws, size_t ws_size, hipStream_t stream) {
    static int grid = 0;
    if (grid == 0) {
        if (n_in != 17 || out_size != 35291136 || ws_size < WS_END) { fprintf(stderr, "kernel_launch: unexpected shapes (n_in %d, out %d, ws %zu, need %zu)\n", n_in, out_size, ws_size, (size_t)WS_END); grid = -1; return; }
        int dev = 0, cus = 0, per_cu = 0;
        hipGetDevice(&dev);
        hipDeviceGetAttribute(&cus, hipDeviceAttributeMultiprocessorCount, dev);
        if (hipFuncSetAttribute((const void*)hybrid_fwd, hipFuncAttributeMaxDynamicSharedMemorySize, LDS_BYTES) != hipSuccess) { fprintf(stderr, "kernel_launch: hipFuncSetAttribute failed\n"); grid = -1; return; }
        if (hipOccupancyMaxActiveBlocksPerMultiprocessor(&per_cu, (const void*)hybrid_fwd, NTHREADS, LDS_BYTES) != hipSuccess || per_cu < 1) { fprintf(stderr, "kernel_launch: occupancy query says %d blocks per CU\n", per_cu); grid = -1; return; }
        grid = cus;
        if (per_cu * cus < grid) grid = per_cu * cus;
    }
    if (grid < 0) return;
    Params p{};
    p.x_prompt = (const float*)d_in[0]; p.x_sample = (const float*)d_in[1]; p.cache_k = (const float*)d_in[2]; p.cache_v = (const float*)d_in[3];
    p.cache_kidx = (const float*)d_in[4]; p.state_conv = (const float*)d_in[5]; p.g_mix = (const float*)d_in[6]; p.w_in = (const float*)d_in[7];
    p.q_gain = (const float*)d_in[8]; p.k_gain = (const float*)d_in[9]; p.w_s = (const float*)d_in[10]; p.b_s = (const float*)d_in[11];
    p.conv_w = (const float*)d_in[12]; p.w_out = (const float*)d_in[13]; p.g_ffn = (const float*)d_in[14]; p.w_up = (const float*)d_in[15]; p.w_down = (const float*)d_in[16];
    p.out = (float*)d_out; p.ws = (unsigned char*)d_ws;
    if (hipMemsetAsync((unsigned char*)d_ws + WS_BAR, 0, 16384, stream) != hipSuccess) { fprintf(stderr, "kernel_launch: memset of the barrier words failed\n"); return; }
#if N_LAUNCH_MODE == 1
    p.ph_lo = 0; p.ph_hi = 13;
    void* args[] = {&p};
    hipError_t e = hipLaunchCooperativeKernel((const void*)hybrid_fwd, dim3(grid), dim3(NTHREADS), args, LDS_BYTES, stream);
    if (e != hipSuccess) fprintf(stderr, "kernel_launch: cooperative launch failed: %s (grid %d)\n", hipGetErrorString(e), grid);
#else
    for (int ph = 0; ph < 13; ++ph) {
        p.ph_lo = ph; p.ph_hi = ph + 1;
        hipLaunchKernelGGL(hybrid_fwd, dim3(grid), dim3(NTHREADS), LDS_BYTES, stream, p);
    }
#endif
}
```
